# Optimizing an MI355X kernel written in HIP

```python
import jax
import jax.numpy as jnp
from jax import lax
import numpy as np

D_MODEL = 1024
BATCH = 8
SEQ = 4096
DEPTH = 4

GRID_W = 64
CTX_LEN = 256
N_MIXERS = 4
HEAD_DIM = 64
GROUP_WIDTH = D_MODEL // N_MIXERS
GROUP_HEADS = GROUP_WIDTH // HEAD_DIM

NA_HEADS = GROUP_HEADS
NA_WIN_ROWS = 8
NA_WIN_COLS = 16

GQA_HEADS = GROUP_HEADS
GQA_KV_HEADS = GROUP_HEADS // 2

MLA_HEADS = GROUP_HEADS
MLA_Q_RANK = D_MODEL // 4
MLA_KV_RANK = D_MODEL // 8
MLA_NOPE_DIM = HEAD_DIM
MLA_ROPE_DIM = HEAD_DIM // 2
MLA_V_DIM = HEAD_DIM

RWKV_HEADS = GROUP_HEADS
RWKV_HEAD_DIM = HEAD_DIM
RWKV_WIDTH = RWKV_HEADS * RWKV_HEAD_DIM
RWKV_DECAY_RANK = 64
RWKV_ICLR_RANK = 64
RWKV_GATE_RANK = 160
SHIFT_TAPS = 3

MLP_HIDDEN = 4 * D_MODEL

NA_COLS = 3 * NA_HEADS * HEAD_DIM
GQA_COLS = (GQA_HEADS + 2 * GQA_KV_HEADS) * HEAD_DIM
MLA_COLS = MLA_Q_RANK + MLA_KV_RANK + MLA_ROPE_DIM
RWKV_COLS = 3 * RWKV_WIDTH + 2 * RWKV_DECAY_RANK + 2 * RWKV_ICLR_RANK + RWKV_GATE_RANK
IN_COLS = NA_COLS + GQA_COLS + MLA_COLS + RWKV_COLS
MIX_WIDTH = NA_HEADS * HEAD_DIM + GQA_HEADS * HEAD_DIM + MLA_HEADS * MLA_V_DIM + RWKV_WIDTH

Q_BLOCK = 128
ROPE_THETA = 10000.0
RMS_EPS = 1e-6
GN_EPS = 64e-5
NEG_INF = -1e30
F32 = jnp.float32

kernel_name = 'hybrid_na_gqa_mla_rwkv7_dit'


def rms_norm(x, g, eps=RMS_EPS):
    xf = x.astype(F32)
    y = xf * lax.rsqrt(jnp.mean(xf * xf, axis=-1, keepdims=True) + eps)
    return (y * g.astype(F32)).astype(x.dtype)


def split_cols(u, sizes):
    return jnp.split(u, np.cumsum(sizes)[:-1].tolist(), axis=-1)


def to_heads(u, n_heads):
    return u.reshape(u.shape[:-1] + (n_heads, u.shape[-1] // n_heads))


def axial_rope_tables(n_tokens, rot_dim):
    t = jnp.arange(n_tokens, dtype=jnp.int32)
    rows = (t // GRID_W).astype(F32)
    cols = (t % GRID_W).astype(F32)
    per_axis = rot_dim // 2
    inv_freq = ROPE_THETA ** (-jnp.arange(0, per_axis, 2, dtype=F32) / per_axis)
    ang = jnp.concatenate([rows[:, None] * inv_freq, cols[:, None] * inv_freq], axis=-1)
    return jnp.cos(ang), jnp.sin(ang)


def apply_rope(x, cos, sin):
    c = cos[None, :, None, :]
    s = sin[None, :, None, :]
    xf = x.astype(F32)
    x1, x2 = xf[..., 0::2], xf[..., 1::2]
    y = jnp.stack([x1 * c - x2 * s, x1 * s + x2 * c], axis=-1)
    return y.reshape(x.shape).astype(x.dtype)


def block_attention(q, k, v):
    bsz, n_q, n_heads, dk = q.shape
    n_kv, dv = k.shape[2], v.shape[-1]
    grp = n_heads // n_kv
    scale = dk ** -0.5
    qb = q.reshape(bsz, n_q // Q_BLOCK, Q_BLOCK, n_kv, grp, dk).swapaxes(0, 1)

    def one_block(qi):
        s = jnp.einsum('bqhgd,bkhd->bhgqk', qi, k).astype(F32) * scale
        p = jax.nn.softmax(s, axis=-1).astype(v.dtype)
        return jnp.einsum('bhgqk,bkhd->bqhgd', p, v)

    o = lax.map(one_block, qb)
    return o.swapaxes(0, 1).reshape(bsz, n_q, n_heads * dv)


def neighbourhood_attention(q, k, v, k_ctx, v_ctx, rpb, rows):
    bsz, n_tok, n_heads, d = q.shape
    wr = min(NA_WIN_ROWS, rows)
    r_idx = np.arange(rows)
    key_rows = np.clip(r_idx - wr // 2, 0, rows - wr)[:, None] + np.arange(wr)[None, :]
    c_idx = np.arange(GRID_W)
    col_start = np.clip(c_idx - NA_WIN_COLS // 2, 0, GRID_W - NA_WIN_COLS)
    col_in_win = (c_idx[None, :] >= col_start[:, None]) & (c_idx[None, :] < col_start[:, None] + NA_WIN_COLS)
    dr = key_rows - r_idx[:, None] + NA_WIN_ROWS - 1
    dc = np.clip(c_idx[None, :] - c_idx[:, None] + NA_WIN_COLS - 1, 0, 2 * NA_WIN_COLS - 2)
    bias = rpb[:, dr[:, None, :, None], dc[None, :, None, :]].astype(F32)
    q_grid = q.reshape(bsz, rows, GRID_W, n_heads, d)
    k_strip = k.reshape(bsz, rows, GRID_W, n_heads, d)[:, key_rows]
    v_strip = v.reshape(bsz, rows, GRID_W, n_heads, d)[:, key_rows]
    scale = d ** -0.5
    s_win = jnp.einsum('brqhd,brjkhd->bhrqjk', q_grid, k_strip).astype(F32) * scale + bias[None]
    s_win = jnp.where(col_in_win[:, None, :], s_win, NEG_INF).reshape(bsz, n_heads, rows, GRID_W, wr * GRID_W)
    s_ctx = jnp.einsum('brqhd,bchd->bhrqc', q_grid, k_ctx).astype(F32) * scale
    p = jax.nn.softmax(jnp.concatenate([s_win, s_ctx], axis=-1), axis=-1).astype(v.dtype)
    p_win = p[..., :wr * GRID_W].reshape(bsz, n_heads, rows, GRID_W, wr, GRID_W)
    p_ctx = p[..., wr * GRID_W:]
    out = (jnp.einsum('bhrqjk,brjkhd->brqhd', p_win, v_strip)
           + jnp.einsum('bhrqc,bchd->brqhd', p_ctx, v_ctx))
    return out.reshape(bsz, n_tok, n_heads * d)


def gqa_queries(u, q_norm_g):
    return rms_norm(to_heads(u[..., :GQA_HEADS * HEAD_DIM], GQA_HEADS), q_norm_g)


def gqa_keys_values(u, k_norm_g):
    k, v = split_cols(u[..., GQA_HEADS * HEAD_DIM:], [GQA_KV_HEADS * HEAD_DIM] * 2)
    return rms_norm(to_heads(k, GQA_KV_HEADS), k_norm_g), to_heads(v, GQA_KV_HEADS)


def mla_queries(u, q_norm_g, w_uq):
    q = to_heads(rms_norm(u[..., :MLA_Q_RANK], q_norm_g) @ w_uq, MLA_HEADS)
    return q[..., :MLA_NOPE_DIM], q[..., MLA_NOPE_DIM:]


def mla_keys_values(u, kv_norm_g, w_ukv):
    c_kv = u[..., MLA_Q_RANK:MLA_Q_RANK + MLA_KV_RANK]
    k_rope = u[..., MLA_Q_RANK + MLA_KV_RANK:][:, :, None, :]
    kv = to_heads(rms_norm(c_kv, kv_norm_g) @ w_ukv, MLA_HEADS)
    return kv[..., :MLA_NOPE_DIM], k_rope, kv[..., MLA_NOPE_DIM:]


def mla_join_key(k_nope, k_rope):
    return jnp.concatenate([k_nope, jnp.broadcast_to(k_rope, k_nope.shape[:-1] + (MLA_ROPE_DIM,))], axis=-1)


def centred_token_shift(u, taps):
    up = jnp.pad(u, ((0, 0), (1, 1), (0, 0)))
    return up[:, :-2] * taps[0] + u * taps[1] + up[:, 2:] * taps[2]


def rwkv7_scan(r, decay, k, v, a_vec, b_vec, s0, reverse):
    seq_first = tuple(jnp.swapaxes(t, 0, 1) for t in (r, decay, k, v, a_vec, b_vec))

    def step(s, inp):
        r_t, w_t, k_t, v_t, a_t, b_t = inp
        sa = jnp.einsum('bhvk,bhk->bhv', s, a_t)
        s = s * w_t[:, :, None, :] + sa[..., None] * b_t[:, :, None, :] + v_t[..., None] * k_t[:, :, None, :]
        return s, jnp.einsum('bhvk,bhk->bhv', s, r_t)

    s_final, ys = lax.scan(step, s0, seq_first, reverse=reverse)
    return s_final, jnp.swapaxes(ys, 0, 1)


def rwkv7_time_mix(u, s0, params, want_out):
    w0, w2, a0, a2, k_k, k_a, r_k, g2, lnx_w, lnx_b = params
    uf = u.astype(F32)
    r, k, v, wl_f, wl_b, al_f, al_b, g_low = split_cols(
        uf, [RWKV_WIDTH] * 3 + [RWKV_DECAY_RANK] * 2 + [RWKV_ICLR_RANK] * 2 + [RWKV_GATE_RANK])
    bsz, n_tok = u.shape[0], u.shape[1]
    if s0 is None:
        zero = jnp.zeros((bsz, RWKV_HEADS, RWKV_HEAD_DIM, RWKV_HEAD_DIM), F32)
        s0 = (zero, zero)
    r_h, v_h = to_heads(r, RWKV_HEADS), to_heads(v, RWKV_HEADS)
    y_sum, keys_dir, finals = 0.0, [], []
    for d, (w_low, a_low) in enumerate(((wl_f, al_f), (wl_b, al_b))):
        w = -jax.nn.softplus(-(w0[d] + jnp.tanh(w_low) @ w2[d])) - 0.5
        decay = to_heads(jnp.exp(-jnp.exp(w)), RWKV_HEADS)
        a = jax.nn.sigmoid(a0[d] + a_low @ a2[d])
        kk = to_heads(k * k_k[d], RWKV_HEADS)
        kk = kk / jnp.maximum(jnp.sqrt(jnp.sum(kk * kk, axis=-1, keepdims=True)), 1e-12)
        k_d = to_heads(k * (1.0 + (a - 1.0) * k_a[d]), RWKV_HEADS)
        s_fin, y = rwkv7_scan(r_h, decay, k_d, v_h, -kk, kk * to_heads(a, RWKV_HEADS), s0[d], d == 1)
        y_sum = y_sum + y
        keys_dir.append(k_d)
        finals.append(s_fin)
    states = (finals[0], finals[1])
    if not want_out:
        return None, states
    mu = jnp.mean(y_sum, axis=-1, keepdims=True)
    var = jnp.mean(jnp.square(y_sum - mu), axis=-1, keepdims=True)
    y = ((y_sum - mu) * lax.rsqrt(var + GN_EPS)).reshape(bsz, n_tok, RWKV_WIDTH)
    bonus = (jnp.sum(r_h * keys_dir[0] * r_k[0], axis=-1, keepdims=True)
             + jnp.sum(r_h * keys_dir[1] * r_k[1], axis=-1, keepdims=True)) * v_h
    y = y * lnx_w + lnx_b + bonus.reshape(bsz, n_tok, RWKV_WIDTH)
    gate = jax.nn.sigmoid(g_low) @ g2
    return (y * gate).astype(u.dtype), states


def hybrid_token_mixer(h_lat, h_ctx, rows, w_in, shift_taps, na_rpb, gqa_q_norm, gqa_k_norm,
                       mla_q_norm, mla_kv_norm, mla_w_uq, mla_w_ukv, rwkv_params,
                       rope_head, rope_mla, want_ctx):
    p_lat, p_ctx = h_lat @ w_in, h_ctx @ w_in
    sizes = [NA_COLS, GQA_COLS, MLA_COLS, RWKV_COLS]
    na_l, gqa_l, mla_l, rw_l = split_cols(p_lat, sizes)
    na_c, gqa_c, mla_c, rw_c = split_cols(p_ctx, sizes)
    cos_h, sin_h = rope_head
    cos_m, sin_m = rope_mla

    a_q, a_k, a_v = [to_heads(t, NA_HEADS) for t in split_cols(na_l, [GROUP_WIDTH] * 3)]
    a_qc, a_kc, a_vc = [to_heads(t, NA_HEADS) for t in split_cols(na_c, [GROUP_WIDTH] * 3)]
    out_a = neighbourhood_attention(a_q, a_k, a_v, a_kc, a_vc, na_rpb, rows)

    b_k, b_v = gqa_keys_values(gqa_l, gqa_k_norm)
    b_kc, b_vc = gqa_keys_values(gqa_c, gqa_k_norm)
    b_q = apply_rope(gqa_queries(gqa_l, gqa_q_norm), cos_h, sin_h)
    b_k_all = jnp.concatenate([apply_rope(b_k, cos_h, sin_h), b_kc], axis=1)
    out_b = block_attention(b_q, b_k_all, jnp.concatenate([b_v, b_vc], axis=1))

    c_qn, c_qr = mla_queries(mla_l, mla_q_norm, mla_w_uq)
    c_kn, c_kr, c_v = mla_keys_values(mla_l, mla_kv_norm, mla_w_ukv)
    c_knc, c_krc, c_vc = mla_keys_values(mla_c, mla_kv_norm, mla_w_ukv)
    c_k_ctx = mla_join_key(c_knc, c_krc)
    c_q = jnp.concatenate([c_qn, apply_rope(c_qr, cos_m, sin_m)], axis=-1)
    c_k_all = jnp.concatenate([mla_join_key(c_kn, apply_rope(c_kr, cos_m, sin_m)), c_k_ctx], axis=1)
    out_c = block_attention(c_q, c_k_all, jnp.concatenate([c_v, c_vc], axis=1))

    out_dc, ctx_states = rwkv7_time_mix(centred_token_shift(rw_c, shift_taps), None, rwkv_params, want_ctx)
    out_d, _ = rwkv7_time_mix(centred_token_shift(rw_l, shift_taps), ctx_states, rwkv_params, True)

    mix_lat = jnp.concatenate([out_a, out_b, out_c, out_d], axis=-1)
    if not want_ctx:
        return mix_lat, None
    out_ac = block_attention(a_qc, a_kc, a_vc)
    out_bc = block_attention(gqa_queries(gqa_c, gqa_q_norm), b_kc, b_vc)
    c_qnc, c_qrc = mla_queries(mla_c, mla_q_norm, mla_w_uq)
    out_cc = block_attention(jnp.concatenate([c_qnc, c_qrc], axis=-1), c_k_ctx, c_vc)
    mix_ctx = jnp.concatenate([out_ac, out_bc, out_cc, out_dc], axis=-1)
    return mix_lat, mix_ctx


def squared_relu_mlp(h, w1, w2):
    return jnp.square(jax.nn.relu(h @ w1)) @ w2


def setup_inputs(seed: int = 0) -> dict:
    key = jax.random.key(seed)
    keys = iter(jax.random.split(key, 40))

    def normal(shape, scale):
        return scale * jax.random.normal(next(keys), shape, F32)

    def gain(shape):
        return 1.0 + normal(shape, 0.05)

    shift_base = jnp.array([0.25, 0.5, 0.25], F32)[None, :, None]
    return {
        'x': normal((BATCH, SEQ, D_MODEL), 1.0),
        'c': normal((BATCH, D_MODEL), 1.0),
        'ctx': normal((BATCH, CTX_LEN, D_MODEL), 1.0),
        'c_ctx': normal((D_MODEL,), 1.0),
        'w_mod': normal((DEPTH, D_MODEL, 6 * D_MODEL), 0.5 * D_MODEL ** -0.5),
        'b_mod': normal((DEPTH, 6 * D_MODEL), 0.01),
        'norm1_g': gain((DEPTH, D_MODEL)),
        'norm2_g': gain((DEPTH, D_MODEL)),
        'w_in': normal((DEPTH, D_MODEL, IN_COLS), D_MODEL ** -0.5),
        'rwkv_shift': shift_base + normal((DEPTH, SHIFT_TAPS, RWKV_COLS), 0.05),
        'na_rpb': normal((DEPTH, NA_HEADS, 2 * NA_WIN_ROWS - 1, 2 * NA_WIN_COLS - 1), 0.3),
        'gqa_q_norm': gain((DEPTH, HEAD_DIM)),
        'gqa_k_norm': gain((DEPTH, HEAD_DIM)),
        'mla_q_norm': gain((DEPTH, MLA_Q_RANK)),
        'mla_kv_norm': gain((DEPTH, MLA_KV_RANK)),
        'mla_w_uq': normal((DEPTH, MLA_Q_RANK, MLA_HEADS * (MLA_NOPE_DIM + MLA_ROPE_DIM)), MLA_Q_RANK ** -0.5),
        'mla_w_ukv': normal((DEPTH, MLA_KV_RANK, MLA_HEADS * (MLA_NOPE_DIM + MLA_V_DIM)), MLA_KV_RANK ** -0.5),
        'rwkv_w0': jax.random.uniform(next(keys), (DEPTH, 2, RWKV_WIDTH), F32, -6.0, -1.0),
        'rwkv_w2': normal((DEPTH, 2, RWKV_DECAY_RANK, RWKV_WIDTH), 0.5 * RWKV_DECAY_RANK ** -0.5),
        'rwkv_a0': normal((DEPTH, 2, RWKV_WIDTH), 0.5),
        'rwkv_a2': normal((DEPTH, 2, RWKV_ICLR_RANK, RWKV_WIDTH), 0.5 * RWKV_ICLR_RANK ** -0.5),
        'rwkv_k_k': 0.85 + normal((DEPTH, 2, RWKV_WIDTH), 0.05),
        'rwkv_k_a': gain((DEPTH, 2, RWKV_WIDTH)),
        'rwkv_r_k': normal((DEPTH, 2, RWKV_HEADS, RWKV_HEAD_DIM), 0.1),
        'rwkv_g2': normal((DEPTH, RWKV_GATE_RANK, RWKV_WIDTH), RWKV_GATE_RANK ** -0.5),
        'rwkv_lnx_w': gain((DEPTH, RWKV_WIDTH)),
        'rwkv_lnx_b': normal((DEPTH, RWKV_WIDTH), 0.01),
        'w_out': normal((DEPTH, MIX_WIDTH, D_MODEL), MIX_WIDTH ** -0.5),
        'w_fc1': normal((DEPTH, D_MODEL, MLP_HIDDEN), D_MODEL ** -0.5),
        'w_fc2': normal((DEPTH, MLP_HIDDEN, D_MODEL), MLP_HIDDEN ** -0.5),
        'final_norm_g': gain((D_MODEL,)),
    }


def reference(x, c, ctx, c_ctx, w_mod, b_mod, norm1_g, norm2_g, w_in, rwkv_shift, na_rpb,
              gqa_q_norm, gqa_k_norm, mla_q_norm, mla_kv_norm, mla_w_uq, mla_w_ukv,
              rwkv_w0, rwkv_w2, rwkv_a0, rwkv_a2, rwkv_k_k, rwkv_k_a, rwkv_r_k, rwkv_g2,
              rwkv_lnx_w, rwkv_lnx_b, w_out, w_fc1, w_fc2, final_norm_g):
    n_lat = x.shape[1]
    rows = n_lat // GRID_W
    rope_head = axial_rope_tables(n_lat, HEAD_DIM)
    rope_mla = axial_rope_tables(n_lat, MLA_ROPE_DIM)
    silu_c = jax.nn.silu(c)
    silu_c_ctx = jax.nn.silu(c_ctx)
    xc = ctx
    for layer in range(DEPTH):
        want_ctx = layer < DEPTH - 1
        mod = silu_c @ w_mod[layer] + b_mod[layer]
        sh1, sc1, g1, sh2, sc2, g2 = jnp.split(mod[:, None, :], 6, axis=-1)
        mod_c = silu_c_ctx @ w_mod[layer] + b_mod[layer]
        csh1, csc1, cg1, csh2, csc2, cg2 = jnp.split(mod_c, 6, axis=-1)
        h_lat = rms_norm(x, norm1_g[layer]) * (1.0 + sc1) + sh1
        h_ctx = rms_norm(xc, norm1_g[layer]) * (1.0 + csc1) + csh1
        rwkv_params = (rwkv_w0[layer], rwkv_w2[layer], rwkv_a0[layer], rwkv_a2[layer],
                       rwkv_k_k[layer], rwkv_k_a[layer], rwkv_r_k[layer], rwkv_g2[layer],
                       rwkv_lnx_w[layer], rwkv_lnx_b[layer])
        mix_lat, mix_ctx = hybrid_token_mixer(
            h_lat, h_ctx, rows, w_in[layer], rwkv_shift[layer], na_rpb[layer],
            gqa_q_norm[layer], gqa_k_norm[layer], mla_q_norm[layer], mla_kv_norm[layer],
            mla_w_uq[layer], mla_w_ukv[layer], rwkv_params, rope_head, rope_mla, want_ctx)
        x = x + g1 * (mix_lat @ w_out[layer])
        h2 = rms_norm(x, norm2_g[layer]) * (1.0 + sc2) + sh2
        x = x + g2 * squared_relu_mlp(h2, w_fc1[layer], w_fc2[layer])
        if want_ctx:
            xc = xc + cg1 * (mix_ctx @ w_out[layer])
            h2c = rms_norm(xc, norm2_g[layer]) * (1.0 + csc2) + csh2
            xc = xc + cg2 * squared_relu_mlp(h2c, w_fc1[layer], w_fc2[layer])
    return rms_norm(x, final_norm_g)
```

```cpp
#include <hip/hip_runtime.h>
#include <hip/hip_cooperative_groups.h>
#include <stdint.h>
#include <stdio.h>
namespace cg = cooperative_groups;
#ifndef REP_GEMM
#define REP_GEMM 1
#endif
#ifndef REP_ATTN
#define REP_ATTN 1
#endif
#ifndef REP_EW
#define REP_EW 1
#endif
#ifndef REP_SYNC
#define REP_SYNC 1
#endif
#ifndef REP_EWA
#define REP_EWA 1
#endif
#ifndef REP_SCAN
#define REP_SCAN 1
#endif

#define DI __device__ __forceinline__
typedef unsigned short bf16_t;
typedef short bf16x8 __attribute__((ext_vector_type(8)));
typedef short bf16x4 __attribute__((ext_vector_type(4)));
typedef float f32x4 __attribute__((ext_vector_type(4)));
typedef unsigned u32x4 __attribute__((ext_vector_type(4)));

constexpr int NB = 8, TPB = 4352, NT = NB * TPB;
constexpr int INC = 2880, INP = 2944;
constexpr int LDH = 1088, LDHID = 4160, LDW1 = 1088, LDW4 = 4160, LDNA = 576;
constexpr float LOG2E = 1.4426950408889634f;
constexpr float QS64 = 0.125f * LOG2E;
constexpr float QS96 = 0.10206207261596577f * LOG2E;
constexpr float ROPE_L2T = 13.287712379549449f;

constexpr size_t al(size_t x) { return (x + 255) & ~size_t(255); }
constexpr size_t O_CTL = 0;
constexpr size_t O_MOD = 16384;
constexpr size_t O_XC = O_MOD + al((size_t)4 * 9 * 6144 * 4);
constexpr size_t O_WIN = O_XC + al((size_t)2048 * 1024 * 4);
constexpr size_t O_WOUT = O_WIN + al((size_t)INP * LDW1 * 2);
constexpr size_t O_WFC1 = O_WOUT + al((size_t)1024 * LDW1 * 2);
constexpr size_t O_WFC2 = O_WFC1 + al((size_t)4096 * LDW1 * 2);
constexpr size_t O_WUQ = O_WFC2 + al((size_t)1024 * LDW4 * 2);
constexpr size_t O_WUKV = O_WUQ + al((size_t)384 * 256 * 2);
constexpr size_t O_WAUX = O_WUKV + al((size_t)512 * 128 * 2);
constexpr size_t O_WG2 = O_WAUX + al((size_t)4 * 256 * 64 * 2);
constexpr size_t O_HBUF = O_WG2 + al((size_t)256 * 192 * 2);
constexpr size_t O_BIG = O_HBUF + al((size_t)NT * LDH * 2);
constexpr size_t O_NAQK = O_BIG;
constexpr size_t O_VTA = O_NAQK + al((size_t)NT * LDNA * 2);
constexpr size_t O_GQ = O_VTA + al((size_t)NB * 256 * TPB * 2);
constexpr size_t O_VTB = O_GQ + al((size_t)NT * 384 * 2);
constexpr size_t O_MLAR = O_VTB + al((size_t)NB * 128 * TPB * 2);
constexpr size_t O_RWR = O_MLAR + al((size_t)NT * 416 * 2);
constexpr size_t O_QC = O_RWR + al((size_t)NT * 1184 * 2);
constexpr size_t O_KC = O_QC + al((size_t)NT * 384 * 2);
constexpr size_t O_VTC = O_KC + al((size_t)NT * 384 * 2);
constexpr size_t O_RKV = O_VTC + al((size_t)NB * 256 * TPB * 2);
constexpr size_t O_DEC = O_RKV + al((size_t)NT * 768 * 2);
constexpr size_t O_GATE = O_DEC + al((size_t)NT * 1024 * 2);
constexpr size_t O_INVN = O_GATE + al((size_t)NT * 256 * 2);
constexpr size_t O_RSM = O_INVN + al((size_t)NT * 8 * 4);
constexpr size_t O_END = O_RSM + al((size_t)NT * 2 * 4);
constexpr size_t O_HID = O_BIG;
constexpr size_t O_Y = O_RWR;
static_assert(O_HID + (size_t)NT * LDHID * 2 <= O_END, "hidden overlay");
static_assert(O_END <= (size_t)512 * 1024 * 1024, "workspace");
static_assert((size_t)2 * NT * 256 * 4 <= (size_t)NT * 1184 * 2, "y overlay");

struct Params {
    const float* in[31];
    float* out;
    char* ws;
};

enum { I_X = 0, I_C, I_CTX, I_CCTX, I_WMOD, I_BMOD, I_N1G, I_N2G, I_WIN, I_SHIFT, I_RPB, I_GQN, I_GKN, I_MQN, I_MKVN, I_WUQ, I_WUKV,
       I_W0, I_W2, I_A0, I_A2, I_KK, I_KA, I_RK, I_G2, I_LNW, I_LNB, I_WOUT, I_FC1, I_FC2, I_FNG };

typedef __bf16 hwbf16x2 __attribute__((ext_vector_type(2)));
typedef float f32x2 __attribute__((ext_vector_type(2)));
DI unsigned pk2(float a, float b) { f32x2 v = {a, b}; hwbf16x2 r = __builtin_convertvector(v, hwbf16x2); return __builtin_bit_cast(unsigned, r); }
DI bf16_t f2bf(float x) { return (bf16_t)(pk2(x, x) & 0xffffu); }
DI float bf2f(bf16_t b) { return __uint_as_float(((unsigned)b) << 16); }
DI float lo2f(unsigned u) { return __uint_as_float(u << 16); }
DI float hi2f(unsigned u) { return __uint_as_float(u & 0xffff0000u); }
DI void st4(bf16_t* p, float a, float b, float c, float d) { uint2 u; u.x = pk2(a, b); u.y = pk2(c, d); *(uint2*)p = u; }
template <int CTRL> DI float dppf(float v) { return __int_as_float(__builtin_amdgcn_update_dpp(0, __float_as_int(v), CTRL, 0xF, 0xF, true)); }
DI float sum16(float v) { v += dppf<0xB1>(v); v += dppf<0x4E>(v); v += dppf<0x141>(v); v += dppf<0x140>(v); return v; }
DI float wsum64(float v) { v = sum16(v); v += __shfl_xor(v, 16); v += __shfl_xor(v, 32); return v; }
DI float sigm(float x) { return 1.f / (1.f + __expf(-x)); }
DI int gtid() { int t = threadIdx.x; asm volatile("" : "+v"(t)); return t; }
DI int clampi(int v, int lo, int hi) { return v < lo ? lo : (v > hi ? hi : v); }

template <class Epi>
DI void gemm_tile(const bf16_t* __restrict__ A, int lda, const bf16_t* __restrict__ Bt, int ldb, int K, int m0, int n0, char* smem, const Epi& epi) {
    char* sA = smem;
    char* sB = smem + 16384;
    const int tid = gtid(), lane = tid & 63, wave = tid >> 6;
    const int wm = wave >> 1, wn = wave & 1, l15 = lane & 15, quad = lane >> 4;
    f32x4 acc[4][4];
#pragma unroll
    for (int i = 0; i < 4; ++i)
#pragma unroll
        for (int j = 0; j < 4; ++j) acc[i][j] = (f32x4){0.f, 0.f, 0.f, 0.f};
    const int srow = lane >> 3, skc = (lane & 7) ^ (lane >> 3);
    const bf16_t* Ag = A + (size_t)(m0 + wave * 8 + srow) * lda + skc * 8;
    const bf16_t* Bg = Bt + (size_t)(n0 + wave * 8 + srow) * ldb + skc * 8;
    const size_t a32 = (size_t)32 * lda, b32 = (size_t)32 * ldb;
    const int sw = l15 & 7;
    for (int k0 = 0; k0 < K; k0 += 64) {
        __syncthreads();
#pragma unroll
        for (int i = 0; i < 4; ++i) {
            __builtin_amdgcn_global_load_lds((const unsigned*)(Ag + i * a32 + k0), (__attribute__((address_space(3))) unsigned*)(sA + (i * 4 + wave) * 1024), 16, 0, 0);
            __builtin_amdgcn_global_load_lds((const unsigned*)(Bg + i * b32 + k0), (__attribute__((address_space(3))) unsigned*)(sB + (i * 4 + wave) * 1024), 16, 0, 0);
        }
        asm volatile("s_waitcnt vmcnt(0)" ::: "memory");
        __syncthreads();
#pragma unroll
        for (int ks = 0; ks < 2; ++ks) {
            bf16x8 wf[4], xf[4];
            const int co = ((ks * 4 + quad) ^ sw) * 16;
#pragma unroll
            for (int t = 0; t < 4; ++t) {
                wf[t] = *(const bf16x8*)(sB + (wn * 64 + t * 16 + l15) * 128 + co);
                xf[t] = *(const bf16x8*)(sA + (wm * 64 + t * 16 + l15) * 128 + co);
            }
#pragma unroll
            for (int nt = 0; nt < 4; ++nt)
#pragma unroll
                for (int mt = 0; mt < 4; ++mt) acc[nt][mt] = __builtin_amdgcn_mfma_f32_16x16x32_bf16(wf[nt], xf[mt], acc[nt][mt], 0, 0, 0);
        }
    }
#pragma unroll
    for (int nt = 0; nt < 4; ++nt)
#pragma unroll
        for (int mt = 0; mt < 4; ++mt) epi(m0 + wm * 64 + mt * 16 + l15, n0 + wn * 64 + nt * 16 + quad * 4, acc[nt][mt]);
}

DI void tile_mn(int t, int nn, int& mt, int& nt) { const int sup = t / (8 * nn), tin = t - sup * 8 * nn; mt = sup * 8 + (tin & 7); nt = tin >> 3; }

struct EpiIn {
    bf16_t *naqk, *vta, *gq, *vtb, *mlar, *rwr;
    DI void operator()(int m, int n, f32x4 v) const {
        if (n >= INC) return;
        if (n < 512) {
            const float s = (n < 256) ? QS64 : 1.f;
            st4(naqk + (size_t)m * LDNA + n, v[0] * s, v[1] * s, v[2] * s, v[3] * s);
        } else if (n < 768) {
            const int b = m / TPB, tib = m - b * TPB;
            bf16_t* d = vta + ((size_t)b * 256 + (n - 512)) * TPB + tib;
            d[0] = f2bf(v[0]); d[TPB] = f2bf(v[1]); d[2 * TPB] = f2bf(v[2]); d[3 * TPB] = f2bf(v[3]);
        } else if (n < 1152) {
            st4(gq + (size_t)m * 384 + (n - 768), v[0], v[1], v[2], v[3]);
        } else if (n < 1280) {
            const int b = m / TPB, tib = m - b * TPB;
            bf16_t* d = vtb + ((size_t)b * 128 + (n - 1152)) * TPB + tib;
            d[0] = f2bf(v[0]); d[TPB] = f2bf(v[1]); d[2 * TPB] = f2bf(v[2]); d[3 * TPB] = f2bf(v[3]);
        } else if (n < 1696) {
            st4(mlar + (size_t)m * 416 + (n - 1280), v[0], v[1], v[2], v[3]);
        } else {
            st4(rwr + (size_t)m * 1184 + (n - 1696), v[0], v[1], v[2], v[3]);
        }
    }
};

DI void rope_rot(float& a, float& b, int pos, float fidx, float fscale) {
    const float ang = (float)pos * __builtin_amdgcn_exp2f(-fidx * fscale);
    const float c = __cosf(ang), s = __sinf(ang);
    const float a2 = a * c - b * s, b2 = a * s + b * c;
    a = a2; b = b2;
}

struct EpiUQ {
    bf16_t* qc; const float* rsm;
    DI void operator()(int m, int n, f32x4 v) const {
        const float rs = rsm[m * 2] * QS96;
        float a = v[0] * rs, b = v[1] * rs, c = v[2] * rs, d = v[3] * rs;
        const int h = n / 96, dd = n - h * 96;
        const int bb = m / TPB, tib = m - bb * TPB;
        if (dd >= 64 && tib >= 256) {
            const int t = tib - 256, row = t >> 6, col = t & 63;
            const int i0 = (dd - 64) >> 1, i1 = i0 + 1;
            rope_rot(a, b, i0 < 8 ? row : col, (float)(i0 & 7), ROPE_L2T / 8.f);
            rope_rot(c, d, i1 < 8 ? row : col, (float)(i1 & 7), ROPE_L2T / 8.f);
        }
        st4(qc + (size_t)m * 384 + n, a, b, c, d);
    }
};
struct EpiUKV {
    bf16_t *kc, *vtc; const float* rsm;
    DI void operator()(int m, int n, f32x4 v) const {
        const float rs = rsm[m * 2 + 1];
        const int h = n >> 7, dd = n & 127;
        if (dd < 64) {
            st4(kc + (size_t)m * 384 + h * 96 + dd, v[0] * rs, v[1] * rs, v[2] * rs, v[3] * rs);
        } else {
            const int b = m / TPB, tib = m - b * TPB;
            bf16_t* d = vtc + ((size_t)b * 256 + h * 64 + (dd - 64)) * TPB + tib;
            d[0] = f2bf(v[0] * rs); d[TPB] = f2bf(v[1] * rs); d[2 * TPB] = f2bf(v[2] * rs); d[3 * TPB] = f2bf(v[3] * rs);
        }
    }
};
struct EpiAux {
    bf16_t *dec, *gate; const float *w0, *a0;
    DI void operator()(int m, int n, f32x4 v) const {
        const int j = n >> 8, c = n & 255;
        float o[4];
        if (j < 2) {
#pragma unroll
            for (int r = 0; r < 4; ++r) {
                const float u = w0[j * 256 + c + r] + v[r];
                const float z = -u;
                const float sp = fmaxf(z, 0.f) + __logf(1.f + __expf(-fabsf(z)));
                const float w = -sp - 0.5f;
                const float e = __expf(w);
                o[r] = 1.f - __expf(-e);
            }
            st4(dec + (size_t)m * 1024 + j * 256 + c, o[0], o[1], o[2], o[3]);
        } else if (j < 4) {
#pragma unroll
            for (int r = 0; r < 4; ++r) o[r] = sigm(a0[(j - 2) * 256 + c + r] + v[r]);
            st4(dec + (size_t)m * 1024 + 512 + (j - 2) * 256 + c, o[0], o[1], o[2], o[3]);
        } else {
            st4(gate + (size_t)m * 256 + c, v[0], v[1], v[2], v[3]);
        }
    }
};
struct EpiRes {
    const float *srcl, *srcc; float *dstl, *dstc; const float* modg;
    DI void operator()(int m, int n, f32x4 v) const {
        const int b = m / TPB, tib = m - b * TPB;
        const float* s; float* d; int mr;
        if (tib < 256) { const size_t o = ((size_t)b * 256 + tib) * 1024 + n; s = srcc + o; d = dstc + o; mr = 8; }
        else { const size_t o = ((size_t)b * 4096 + (tib - 256)) * 1024 + n; s = srcl + o; d = dstl + o; mr = b; }
        const float4 g = *(const float4*)(modg + mr * 6144 + n);
        const float4 x = *(const float4*)s;
        float4 r; r.x = x.x + g.x * v[0]; r.y = x.y + g.y * v[1]; r.z = x.z + g.z * v[2]; r.w = x.w + g.w * v[3];
        *(float4*)d = r;
    }
};
struct EpiFc1 {
    bf16_t* hid;
    DI void operator()(int m, int n, f32x4 v) const {
        float a = fmaxf(v[0], 0.f), b = fmaxf(v[1], 0.f), c = fmaxf(v[2], 0.f), d = fmaxf(v[3], 0.f);
        st4(hid + (size_t)m * LDHID + n, a * a, b * b, c * c, d * d);
    }
};

DI void phase_mod(const Params& p, char* smem) {
    float* sc = (float*)smem;
    float* red = sc + 9 * 1024;
    const int tid = gtid(), lane = tid & 63, wave = tid >> 6;
    for (int i = tid; i < 9 * 1024; i += 256) { const float v = (i < 8192) ? p.in[I_C][i] : p.in[I_CCTX][i - 8192]; sc[i] = v / (1.f + __expf(-v)); }
    __syncthreads();
    float* mod = (float*)(p.ws + O_MOD);
    for (int item = blockIdx.x; item < 4 * 96; item += gridDim.x) {
        const int l = item / 96, nb = (item % 96) * 64;
        const float* w = p.in[I_WMOD] + (size_t)l * 1024 * 6144 + nb + lane;
        float acc[9];
#pragma unroll
        for (int r = 0; r < 9; ++r) acc[r] = 0.f;
#pragma unroll 8
        for (int k = wave * 256; k < wave * 256 + 256; ++k) {
            const float wv = w[(size_t)k * 6144];
#pragma unroll
            for (int r = 0; r < 9; ++r) acc[r] += sc[r * 1024 + k] * wv;
        }
#pragma unroll
        for (int r = 0; r < 9; ++r) red[(wave * 9 + r) * 64 + lane] = acc[r];
        __syncthreads();
        for (int i = tid; i < 9 * 64; i += 256) {
            const int r = i >> 6, ln = i & 63;
            const float s = red[(0 * 9 + r) * 64 + ln] + red[(1 * 9 + r) * 64 + ln] + red[(2 * 9 + r) * 64 + ln] + red[(3 * 9 + r) * 64 + ln];
            mod[((size_t)l * 9 + r) * 6144 + nb + ln] = s + p.in[I_BMOD][l * 6144 + nb + ln];
        }
        __syncthreads();
    }
}

DI void wconv_tile(const float* src, const float* g, int K, int N, bf16_t* dst, int nkt, int ldd, int t, char* smem) {
    float* tile = (float*)smem;
    const int tid = gtid();
    const int kt = t % nkt, nt = t / nkt, k0 = kt * 64, n0 = nt * 64;
    __syncthreads();
#pragma unroll 4
    for (int i = 0; i < 16; ++i) {
        const int kl = (tid >> 6) + 4 * i, nl = tid & 63, k = k0 + kl, n = n0 + nl;
        float v = 0.f;
        if (k < K && n < N) { v = src[(size_t)k * N + n]; if (g) v *= g[k]; }
        tile[kl * 65 + nl] = v;
    }
    __syncthreads();
#pragma unroll 4
    for (int i = 0; i < 8; ++i) {
        const int nl = (tid >> 5) + 8 * i, kl = (tid & 31) * 2;
        *(unsigned*)(dst + (size_t)(n0 + nl) * ldd + k0 + kl) = pk2(tile[kl * 65 + nl], tile[(kl + 1) * 65 + nl]);
    }
}
DI void wconv(const float* src, const float* g, int K, int N, bf16_t* dst, int Kp, int Np, int ldd, int rot, char* smem) {
    const int nkt = Kp / 64, nnt = Np / 64, G = gridDim.x;
    for (int t = (blockIdx.x + G - (rot % G)) % G; t < nkt * nnt; t += G) wconv_tile(src, g, K, N, dst, nkt, ldd, t, smem);
}
DI void wconv_late(const Params& p, int l, int u, char* smem) {
    char* ws = p.ws;
    if (u < 1024) wconv_tile(p.in[I_FC1] + (size_t)l * 1024 * 4096, nullptr, 1024, 4096, (bf16_t*)(ws + O_WFC1), 16, LDW1, u, smem);
    else if (u < 2048) wconv_tile(p.in[I_FC2] + (size_t)l * 4096 * 1024, nullptr, 4096, 1024, (bf16_t*)(ws + O_WFC2), 64, LDW4, u - 1024, smem);
    else wconv_tile(p.in[I_WOUT] + (size_t)l * 1024 * 1024, nullptr, 1024, 1024, (bf16_t*)(ws + O_WOUT), 16, LDW1, u - 2048, smem);
}
DI void wconv_early(const Params& p, int l, int u, char* smem) {
    char* ws = p.ws;
    if (u < 736) wconv_tile(p.in[I_WIN] + (size_t)l * 1024 * INC, nullptr, 1024, INC, (bf16_t*)(ws + O_WIN), 16, LDW1, u, smem);
    else if (u < 760) wconv_tile(p.in[I_WUQ] + (size_t)l * 256 * 384, p.in[I_MQN] + l * 256, 256, 384, (bf16_t*)(ws + O_WUQ), 4, 256, u - 736, smem);
    else if (u < 776) wconv_tile(p.in[I_WUKV] + (size_t)l * 128 * 512, p.in[I_MKVN] + l * 128, 128, 512, (bf16_t*)(ws + O_WUKV), 2, 128, u - 760, smem);
    else if (u < 792) {
        const int v = u - 776, j = v >> 2, d = j & 1;
        const float* src = (j < 2 ? p.in[I_W2] : p.in[I_A2]) + (size_t)(l * 2 + d) * 64 * 256;
        wconv_tile(src, nullptr, 64, 256, (bf16_t*)(ws + O_WAUX) + (size_t)j * 256 * 64, 1, 64, v & 3, smem);
    } else wconv_tile(p.in[I_G2] + (size_t)l * 160 * 256, nullptr, 160, 256, (bf16_t*)(ws + O_WG2), 3, 192, u - 792, smem);
}

DI void phase_wconv(const Params& p, int l, char* smem) {
    char* ws = p.ws;
    wconv(p.in[I_WIN] + (size_t)l * 1024 * INC, nullptr, 1024, INC, (bf16_t*)(ws + O_WIN), 1024, INP, LDW1, 0, smem);
    wconv(p.in[I_WUQ] + (size_t)l * 256 * 384, p.in[I_MQN] + l * 256, 256, 384, (bf16_t*)(ws + O_WUQ), 256, 384, 256, 3040, smem);
    wconv(p.in[I_WUKV] + (size_t)l * 128 * 512, p.in[I_MKVN] + l * 128, 128, 512, (bf16_t*)(ws + O_WUKV), 128, 512, 128, 3064, smem);
    for (int d = 0; d < 2; ++d) {
        wconv(p.in[I_W2] + (size_t)(l * 2 + d) * 64 * 256, nullptr, 64, 256, (bf16_t*)(ws + O_WAUX) + d * 256 * 64, 64, 256, 64, 3080 + d * 4, smem);
        wconv(p.in[I_A2] + (size_t)(l * 2 + d) * 64 * 256, nullptr, 64, 256, (bf16_t*)(ws + O_WAUX) + (2 + d) * 256 * 64, 64, 256, 64, 3088 + d * 4, smem);
    }
    wconv(p.in[I_G2] + (size_t)l * 160 * 256, nullptr, 160, 256, (bf16_t*)(ws + O_WG2), 192, 256, 192, 3096, smem);
}

DI void phase_norm(const float* xl, const float* xc, const float* g, const float* modl, int shi, int sci, bf16_t* dst) {
    const int tid = gtid(), lane = tid & 63, wave = tid >> 6;
    for (int tok = blockIdx.x * 4 + wave; tok < NT; tok += gridDim.x * 4) {
        const int b = tok / TPB, tib = tok - b * TPB;
        const float* row; int mr;
        if (tib < 256) { row = xc + ((size_t)b * 256 + tib) * 1024; mr = 8; } else { row = xl + ((size_t)b * 4096 + tib - 256) * 1024; mr = b; }
        const float* sh = modl + mr * 6144 + shi * 1024;
        const float* sc = modl + mr * 6144 + sci * 1024;
        f32x4 v[4]; float ss = 0.f;
#pragma unroll
        for (int i = 0; i < 4; ++i) { v[i] = ((const f32x4*)row)[lane + 64 * i]; ss += v[i].x * v[i].x + v[i].y * v[i].y + v[i].z * v[i].z + v[i].w * v[i].w; }
        ss = wsum64(ss);
        const float rs = rsqrtf(ss * (1.f / 1024.f) + 1e-6f);
#pragma unroll
        for (int i = 0; i < 4; ++i) {
            const int c = (lane + 64 * i) * 4;
            const float4 g4 = *(const float4*)(g + c), s4 = *(const float4*)(sc + c), h4 = *(const float4*)(sh + c);
            st4(dst + (size_t)tok * LDH + c, v[i].x * rs * g4.x * (1.f + s4.x) + h4.x, v[i].y * rs * g4.y * (1.f + s4.y) + h4.y,
                v[i].z * rs * g4.z * (1.f + s4.z) + h4.z, v[i].w * rs * g4.w * (1.f + s4.w) + h4.w);
        }
    }
}

DI void phase_post(const Params& p, int l) {
    const int tid = gtid(), lane = tid & 63, wave = tid >> 6;
    char* ws = p.ws;
    bf16_t* gq = (bf16_t*)(ws + O_GQ);
    const bf16_t* mlar = (const bf16_t*)(ws + O_MLAR);
    bf16_t* kc = (bf16_t*)(ws + O_KC);
    float* rsm = (float*)(ws + O_RSM);
    const bf16_t* rwr = (const bf16_t*)(ws + O_RWR);
    bf16_t* rkv = (bf16_t*)(ws + O_RKV);
    bf16_t* acat = (bf16_t*)(ws + O_HBUF);
    float* invn = (float*)(ws + O_INVN);
    const float* gqn = p.in[I_GQN] + l * 64;
    const float* gkn = p.in[I_GKN] + l * 64;
    const float* taps = p.in[I_SHIFT] + (size_t)l * 3 * 1184;
    const float* kkw = p.in[I_KK] + (size_t)l * 512;
    for (int tok = blockIdx.x * 4 + wave; tok < NT; tok += gridDim.x * 4) {
        const int b = tok / TPB, tib = tok - b * TPB;
        const bool lat = tib >= 256;
        const int t = tib - 256, prow = t >> 6, pcol = t & 63;
        unsigned gqu[3];
#pragma unroll
        for (int it = 0; it < 3; ++it) gqu[it] = *(const unsigned*)(gq + (size_t)tok * 384 + (it * 2 + (lane >> 5)) * 64 + (lane & 31) * 2);
        const bf16_t* mr = mlar + (size_t)tok * 416;
        const uint2 uq = *(const uint2*)(mr + lane * 4);
        const unsigned ukv = *(const unsigned*)(mr + 256 + lane * 2);
        const unsigned ukr = *(const unsigned*)(mr + 384 + (lane & 15) * 2);
        const bool hasp = (tib != 0) && (tib != 256);
        const bool hasn = (tib != 255) && (tib != TPB - 1);
        const bf16_t* r0 = rwr + (size_t)tok * 1184;
#define SHIFT_LOADB(hbv, Y0, Y1, Y2)                                                   \
        _Pragma("unroll") for (int ii = 0; ii < 2; ++ii) {                             \
            const int c = (lane + 64 * ((hbv) * 2 + ii)) * 2;                          \
            Y0[ii] = 0u; Y1[ii] = 0u; Y2[ii] = 0u;                                     \
            if (c < 1184) {                                                            \
                Y1[ii] = *(const unsigned*)(r0 + c);                                   \
                if (hasp) Y0[ii] = *(const unsigned*)(r0 + c - 1184);                  \
                if (hasn) Y2[ii] = *(const unsigned*)(r0 + c + 1184);                  \
            }                                                                          \
        }
        unsigned X0[2], X1[2], X2[2];
        SHIFT_LOADB(0, X0, X1, X2)
        {
            const int pair = lane & 31;
#pragma unroll
            for (int it = 0; it < 3; ++it) {
                const int head = it * 2 + (lane >> 5);
                unsigned* ptr = (unsigned*)(gq + (size_t)tok * 384 + head * 64 + pair * 2);
                const unsigned u = gqu[it];
                float x1 = lo2f(u), x2 = hi2f(u);
                float ss = x1 * x1 + x2 * x2;
                ss += __shfl_xor(ss, 1); ss += __shfl_xor(ss, 2); ss += __shfl_xor(ss, 4); ss += __shfl_xor(ss, 8); ss += __shfl_xor(ss, 16);
                const float rs = rsqrtf(ss * (1.f / 64.f) + 1e-6f);
                const float* gg = head < 4 ? gqn : gkn;
                x1 *= rs * gg[pair * 2]; x2 *= rs * gg[pair * 2 + 1];
                if (lat) rope_rot(x1, x2, pair < 16 ? prow : pcol, (float)(pair & 15), ROPE_L2T / 16.f);
                if (head < 4) { x1 *= QS64; x2 *= QS64; }
                *ptr = pk2(x1, x2);
            }
        }
        {
            float a0 = lo2f(uq.x), a1 = hi2f(uq.x), a2 = lo2f(uq.y), a3 = hi2f(uq.y);
            float sq = wsum64(a0 * a0 + a1 * a1 + a2 * a2 + a3 * a3);
            float c0 = lo2f(ukv), c1 = hi2f(ukv);
            float sk = wsum64(c0 * c0 + c1 * c1);
            if (lane == 0) { rsm[tok * 2] = rsqrtf(sq * (1.f / 256.f) + 1e-6f); rsm[tok * 2 + 1] = rsqrtf(sk * (1.f / 128.f) + 1e-6f); }
            if (lane < 16) {
                const unsigned u = ukr;
                float x1 = lo2f(u), x2 = hi2f(u);
                if (lat) rope_rot(x1, x2, lane < 8 ? prow : pcol, (float)(lane & 7), ROPE_L2T / 8.f);
                const unsigned o = pk2(x1, x2);
#pragma unroll
                for (int h = 0; h < 4; ++h) *(unsigned*)(kc + (size_t)tok * 384 + h * 96 + 64 + lane * 2) = o;
            }
        }
        {
#pragma unroll
            for (int hb = 0; hb < 5; ++hb) {
            unsigned N0[2] = {0u, 0u}, N1[2] = {0u, 0u}, N2[2] = {0u, 0u};
            if (hb < 4) { SHIFT_LOADB(hb + 1, N0, N1, N2) }
#pragma unroll
            for (int ii = 0; ii < 2; ++ii) {
                const int i = hb * 2 + ii;
                const int c = (lane + 64 * i) * 2;
                float u0 = 0.f, u1 = 0.f;
                if (c < 1184) {
                    const float2 t1 = *(const float2*)(taps + 1184 + c);
                    u0 = lo2f(X1[ii]) * t1.x; u1 = hi2f(X1[ii]) * t1.y;
                    if (hasp) { const float2 t0 = *(const float2*)(taps + c); u0 += lo2f(X0[ii]) * t0.x; u1 += hi2f(X0[ii]) * t0.y; }
                    if (hasn) { const float2 t2 = *(const float2*)(taps + 2 * 1184 + c); u0 += lo2f(X2[ii]) * t2.x; u1 += hi2f(X2[ii]) * t2.y; }
                }
                if (i < 6) {
                    const unsigned pk = pk2(u0, u1);
                    *(unsigned*)(rkv + (size_t)tok * 768 + c) = pk;
                    if (i == 2 || i == 3) {
                        const float k0 = lo2f(pk), k1 = hi2f(pk);
                        const float2 f0 = *(const float2*)(kkw + c - 256), f1 = *(const float2*)(kkw + 256 + c - 256);
                        float s0 = (k0 * f0.x) * (k0 * f0.x) + (k1 * f0.y) * (k1 * f0.y);
                        float s1 = (k0 * f1.x) * (k0 * f1.x) + (k1 * f1.y) * (k1 * f1.y);
                        s0 = sum16(s0); s1 = sum16(s1);
                        s0 += __shfl_xor(s0, 16); s1 += __shfl_xor(s1, 16);
                        if ((lane & 31) == 0) {
                            const int hd = (i - 2) * 2 + (lane >> 5);
                            invn[tok * 8 + hd] = 1.f / fmaxf(sqrtf(s0), 1e-12f);
                            invn[tok * 8 + 4 + hd] = 1.f / fmaxf(sqrtf(s1), 1e-12f);
                        }
                    }
                } else if (i == 6) {
                    *(unsigned*)(acat + (size_t)tok * 448 + (c - 768)) = pk2(tanhf(u0), tanhf(u1));
                } else if (i == 7) {
                    *(unsigned*)(acat + (size_t)tok * 448 + 128 + (c - 896)) = pk2(u0, u1);
                } else {
                    const int cc = c - 1024;
                    if (cc < 192) *(unsigned*)(acat + (size_t)tok * 448 + 256 + cc) = (cc < 160) ? pk2(sigm(u0), sigm(u1)) : 0u;
                }
            }
            X0[0] = N0[0]; X0[1] = N0[1]; X1[0] = N1[0]; X1[1] = N1[1]; X2[0] = N2[0]; X2[1] = N2[1];
            }
#undef SHIFT_LOADB
        }
    }
}

template <int DK, bool NAM>
DI void attn_item(const bf16_t* __restrict__ Q, int ldq, const bf16_t* __restrict__ Kb, int ldk, const bf16_t* __restrict__ Vt,
                          int s0, int nt0, int s1, int nt1, bf16_t* __restrict__ O, int qr0, const float* rpb_g, char* smem) {
    constexpr int KS = DK + 16, KCH = DK / 8, NKC = 64 * KCH / 256;
    bf16_t* sK = (bf16_t*)smem;
    bf16_t* sV = sK + 64 * 112;
    float* sR = (float*)(sV + 64 * 72);
    const int tid = gtid(), lane = tid & 63, wave = tid >> 6, l15 = lane & 15, quad = lane >> 4;
    const int ntot = nt0 + nt1;
    if (NAM) {
        __syncthreads();
        for (int i = tid; i < 465; i += 256) sR[i] = rpb_g[i] * LOG2E;
    }
    bf16x8 qf[2][DK / 32];
#pragma unroll
    for (int qt = 0; qt < 2; ++qt)
#pragma unroll
        for (int ks = 0; ks < DK / 32; ++ks) qf[qt][ks] = *(const bf16x8*)(Q + (size_t)(wave * 32 + qt * 16 + l15) * ldq + ks * 32 + quad * 8);
    f32x4 Oa[4][2];
#pragma unroll
    for (int i = 0; i < 4; ++i) { Oa[i][0] = (f32x4){0.f, 0.f, 0.f, 0.f}; Oa[i][1] = (f32x4){0.f, 0.f, 0.f, 0.f}; }
    float mrun[2] = {-1e30f, -1e30f}, lrun[2] = {0.f, 0.f};
    u32x4 rk[NKC], rv[2];
    {
        const int key0 = (0 < nt0) ? s0 : s1;
#pragma unroll
        for (int i = 0; i < NKC; ++i) { const int c = tid + 256 * i, row = c / KCH, kc = c % KCH; rk[i] = *(const u32x4*)(Kb + (size_t)(key0 + row) * ldk + kc * 8); }
#pragma unroll
        for (int i = 0; i < 2; ++i) { const int c = tid + 256 * i, row = c >> 3, kc = c & 7; rv[i] = *(const u32x4*)(Vt + (size_t)row * TPB + key0 + kc * 8); }
    }
    for (int j = 0; j < ntot; ++j) {
        __syncthreads();
#pragma unroll
        for (int i = 0; i < NKC; ++i) { const int c = tid + 256 * i, row = c / KCH, kc = c % KCH; *(u32x4*)(sK + row * KS + kc * 8) = rk[i]; }
#pragma unroll
        for (int i = 0; i < 2; ++i) { const int c = tid + 256 * i, row = c >> 3, kc = c & 7; *(u32x4*)(sV + row * 72 + kc * 8) = rv[i]; }
        __syncthreads();
        if (j + 1 < ntot) {
            const int jn = j + 1;
            const int key0 = (jn < nt0) ? (s0 + 64 * jn) : (s1 + 64 * (jn - nt0));
#pragma unroll
            for (int i = 0; i < NKC; ++i) { const int c = tid + 256 * i, row = c / KCH, kc = c % KCH; rk[i] = *(const u32x4*)(Kb + (size_t)(key0 + row) * ldk + kc * 8); }
#pragma unroll
            for (int i = 0; i < 2; ++i) { const int c = tid + 256 * i, row = c >> 3, kc = c & 7; rv[i] = *(const u32x4*)(Vt + (size_t)row * TPB + key0 + kc * 8); }
        }
        f32x4 S[4][2];
#pragma unroll
        for (int kt = 0; kt < 4; ++kt) { S[kt][0] = (f32x4){0.f, 0.f, 0.f, 0.f}; S[kt][1] = (f32x4){0.f, 0.f, 0.f, 0.f}; }
#pragma unroll
        for (int ks = 0; ks < DK / 32; ++ks)
#pragma unroll
            for (int kt = 0; kt < 4; ++kt) {
                const bf16x8 kf = *(const bf16x8*)(sK + (kt * 16 + l15) * KS + ks * 32 + quad * 8);
                S[kt][0] = __builtin_amdgcn_mfma_f32_16x16x32_bf16(kf, qf[0][ks], S[kt][0], 0, 0, 0);
                S[kt][1] = __builtin_amdgcn_mfma_f32_16x16x32_bf16(kf, qf[1][ks], S[kt][1], 0, 0, 0);
            }
        if (NAM) {
            if (j >= nt0) {
                const int kr = (s1 - 256) / 64 + (j - nt0);
#pragma unroll
                for (int qt = 0; qt < 2; ++qt) {
                    const int qi = wave * 32 + qt * 16 + l15, qrow = qr0 + (qi >> 6), qc = qi & 63;
                    const int st = clampi(qrow - 4, 0, 56), cs = clampi(qc - 8, 0, 48);
                    const bool rowok = (kr >= st) && (kr < st + 8);
                    const int rbase = (kr - qrow + 7) * 31 - qc + 15;
#pragma unroll
                    for (int kt = 0; kt < 4; ++kt)
#pragma unroll
                        for (int r = 0; r < 4; ++r) {
                            const int kcx = kt * 16 + quad * 4 + r;
                            const bool ok = rowok && (kcx >= cs) && (kcx < cs + 16);
                            const float bias = sR[ok ? (rbase + kcx) : 0];
                            S[kt][qt][r] = ok ? (S[kt][qt][r] + bias) : -1e30f;
                        }
                }
            }
        }
        bf16x8 pf[2][2];
#pragma unroll
        for (int qt = 0; qt < 2; ++qt) {
            float mx = -1e30f;
#pragma unroll
            for (int kt = 0; kt < 4; ++kt)
#pragma unroll
                for (int r = 0; r < 4; ++r) mx = fmaxf(mx, S[kt][qt][r]);
            mx = fmaxf(mx, __shfl_xor(mx, 16));
            mx = fmaxf(mx, __shfl_xor(mx, 32));
            const float mnew = fmaxf(mrun[qt], mx);
            const float alpha = __builtin_amdgcn_exp2f(mrun[qt] - mnew);
            mrun[qt] = mnew;
            float ps = 0.f;
#pragma unroll
            for (int kt = 0; kt < 4; ++kt)
#pragma unroll
                for (int r = 0; r < 4; ++r) { const float pv = __builtin_amdgcn_exp2f(S[kt][qt][r] - mnew); S[kt][qt][r] = pv; ps += pv; }
            lrun[qt] = lrun[qt] * alpha + ps;
            if (__any(alpha != 1.f)) {
#pragma unroll
                for (int dt = 0; dt < 4; ++dt) { Oa[dt][qt][0] *= alpha; Oa[dt][qt][1] *= alpha; Oa[dt][qt][2] *= alpha; Oa[dt][qt][3] *= alpha; }
            }
#pragma unroll
            for (int s = 0; s < 2; ++s) {
                u32x4 f;
                f[0] = pk2(S[2 * s][qt][0], S[2 * s][qt][1]); f[1] = pk2(S[2 * s][qt][2], S[2 * s][qt][3]);
                f[2] = pk2(S[2 * s + 1][qt][0], S[2 * s + 1][qt][1]); f[3] = pk2(S[2 * s + 1][qt][2], S[2 * s + 1][qt][3]);
                pf[qt][s] = __builtin_bit_cast(bf16x8, f);
            }
        }
#pragma unroll
        for (int s = 0; s < 2; ++s)
#pragma unroll
            for (int dt = 0; dt < 4; ++dt) {
                const bf16x4 v0 = *(const bf16x4*)(sV + (dt * 16 + l15) * 72 + (2 * s) * 16 + quad * 4);
                const bf16x4 v1 = *(const bf16x4*)(sV + (dt * 16 + l15) * 72 + (2 * s + 1) * 16 + quad * 4);
                const bf16x8 vf = __builtin_shufflevector(v0, v1, 0, 1, 2, 3, 4, 5, 6, 7);
                Oa[dt][0] = __builtin_amdgcn_mfma_f32_16x16x32_bf16(vf, pf[0][s], Oa[dt][0], 0, 0, 0);
                Oa[dt][1] = __builtin_amdgcn_mfma_f32_16x16x32_bf16(vf, pf[1][s], Oa[dt][1], 0, 0, 0);
            }
    }
#pragma unroll
    for (int qt = 0; qt < 2; ++qt) {
        float lt = lrun[qt];
        lt += __shfl_xor(lt, 16); lt += __shfl_xor(lt, 32);
        const float inv = 1.f / lt;
#pragma unroll
        for (int dt = 0; dt < 4; ++dt)
            st4(O + (size_t)(wave * 32 + qt * 16 + l15) * LDH + dt * 16 + quad * 4, Oa[dt][qt][0] * inv, Oa[dt][qt][1] * inv, Oa[dt][qt][2] * inv, Oa[dt][qt][3] * inv);
    }
}

DI void scan_item(const Params& p, int l, int item, char* smem) {
    float* sT = (float*)smem;
    float* sVv = sT + 16 * 320;
    float* sY = sVv + 256;
    const int tid = gtid(), lane = tid & 63, wave = tid >> 6;
    const int scan = item >> 2, rg = item & 3;
    const int b = scan >> 3, head = (scan >> 1) & 3, dir = scan & 1;
    const bf16_t* rkv = (const bf16_t*)(p.ws + O_RKV);
    const bf16_t* dec = (const bf16_t*)(p.ws + O_DEC);
    const float* invn = (const float*)(p.ws + O_INVN);
    float* yout = (float*)(p.ws + O_Y) + (size_t)dir * NT * 256;
    const int k2 = (tid & 31) * 2, tq = tid >> 5;
    const float* kkw = p.in[I_KK] + (size_t)(l * 2 + dir) * 256 + head * 64;
    const float* kaw = p.in[I_KA] + (size_t)(l * 2 + dir) * 256 + head * 64;
    const float kkc0 = kkw[k2], kkc1 = kkw[k2 + 1], kac0 = kaw[k2], kac1 = kaw[k2 + 1];
    unsigned rr[2], kr[2], ow[2], as[2]; float inn[2]; bf16_t vv;
    const int tbase = b * TPB;
#define SCAN_TOK(s) (tbase + (dir ? ((s) < 256 ? 255 - (s) : 4607 - (s)) : (s)))
#define SCAN_LOAD(ch)                                                                                          \
    {                                                                                                          \
        _Pragma("unroll") for (int i = 0; i < 2; ++i) {                                                        \
            const int tok = SCAN_TOK((ch) * 16 + tq + 8 * i);                                                  \
            rr[i] = *(const unsigned*)(rkv + (size_t)tok * 768 + head * 64 + k2);                              \
            kr[i] = *(const unsigned*)(rkv + (size_t)tok * 768 + 256 + head * 64 + k2);                        \
            ow[i] = *(const unsigned*)(dec + (size_t)tok * 1024 + dir * 256 + head * 64 + k2);                 \
            as[i] = *(const unsigned*)(dec + (size_t)tok * 1024 + 512 + dir * 256 + head * 64 + k2);           \
            inn[i] = invn[tok * 8 + dir * 4 + head];                                                           \
        }                                                                                                      \
        {                                                                                                      \
            const int tok = SCAN_TOK((ch) * 16 + (tid >> 4));                                                  \
            vv = rkv[(size_t)tok * 768 + 512 + head * 64 + rg * 16 + (tid & 15)];                              \
        }                                                                                                      \
    }
#define SCAN_YRED(ch)                                                                                          \
    {                                                                                                          \
        const int tl = tid >> 4, row = tid & 15;                                                               \
        const float* yp = sY + tl * 256 + (row >> 2) * 64 + (row & 3) * 16;                                    \
        const f32x4 q0 = *(const f32x4*)yp, q1 = *(const f32x4*)(yp + 4), q2 = *(const f32x4*)(yp + 8), q3 = *(const f32x4*)(yp + 12);   \
        const f32x4 qs = (q0 + q1) + (q2 + q3);                                                                \
        yout[(size_t)SCAN_TOK((ch) * 16 + tl) * 256 + head * 64 + rg * 16 + row] = (qs[0] + qs[1]) + (qs[2] + qs[3]);   \
    }
    float S0 = 0.f, S1 = 0.f, S2 = 0.f, S3 = 0.f;
    const int c = lane & 15, rloc = wave * 4 + (lane >> 4);
    __builtin_amdgcn_s_setprio(3);
    SCAN_LOAD(0);
    for (int ch = 0; ch < 272; ++ch) {
        __syncthreads();
        if (ch > 0) SCAN_YRED(ch - 1)
#pragma unroll
        for (int i = 0; i < 2; ++i) {
            float* base = sT + (tq + 8 * i) * 320 + k2;
            const float r0 = lo2f(rr[i]), r1 = hi2f(rr[i]), k0 = lo2f(kr[i]), k1 = hi2f(kr[i]);
            const float o0 = lo2f(ow[i]), o1 = hi2f(ow[i]), a0 = lo2f(as[i]), a1 = hi2f(as[i]);
            const float kk0 = k0 * kkc0 * inn[i], kk1 = k1 * kkc1 * inn[i];
            *(float2*)(base) = make_float2(1.f - o0, 1.f - o1);
            *(float2*)(base + 64) = make_float2(kk0, kk1);
            *(float2*)(base + 128) = make_float2(kk0 * a0, kk1 * a1);
            *(float2*)(base + 192) = make_float2(k0 * (1.f + (a0 - 1.f) * kac0), k1 * (1.f + (a1 - 1.f) * kac1));
            *(float2*)(base + 256) = make_float2(r0, r1);
        }
        sVv[tid] = bf2f(vv);
        __syncthreads();
        if (ch + 1 < 272) SCAN_LOAD(ch + 1);
#define SC_LD(bi, t0)                                                                                   \
    _Pragma("unroll") for (int q = 0; q < 2; ++q) {                                                     \
        const float* bp = sT + ((t0) + q) * 320 + c * 4;                                                \
        W4[bi][q] = *(const f32x4*)bp; K4[bi][q] = *(const f32x4*)(bp + 64); B4[bi][q] = *(const f32x4*)(bp + 128);   \
        D4[bi][q] = *(const f32x4*)(bp + 192); R4[bi][q] = *(const f32x4*)(bp + 256); VX[bi][q] = sVv[((t0) + q) * 16 + rloc];  \
    }
#define SC_CP(bi, t0)                                                                                   \
    _Pragma("unroll") for (int q = 0; q < 2; ++q) {                                                     \
        float sa = (S0 * K4[bi][q][0] + S1 * K4[bi][q][1]) + (S2 * K4[bi][q][2] + S3 * K4[bi][q][3]);   \
        sa = sum16(sa);                                                                                 \
        S0 = S0 * W4[bi][q][0] - sa * B4[bi][q][0] + VX[bi][q] * D4[bi][q][0];                          \
        S1 = S1 * W4[bi][q][1] - sa * B4[bi][q][1] + VX[bi][q] * D4[bi][q][1];                          \
        S2 = S2 * W4[bi][q][2] - sa * B4[bi][q][2] + VX[bi][q] * D4[bi][q][2];                          \
        S3 = S3 * W4[bi][q][3] - sa * B4[bi][q][3] + VX[bi][q] * D4[bi][q][3];                          \
        sY[((t0) + q) * 256 + tid] = (S0 * R4[bi][q][0] + S1 * R4[bi][q][1]) + (S2 * R4[bi][q][2] + S3 * R4[bi][q][3]);  \
    }
        {
            f32x4 W4[2][2], K4[2][2], B4[2][2], D4[2][2], R4[2][2]; float VX[2][2];
            SC_LD(0, 0);
#pragma unroll 1
            for (int it = 0; it < 4; ++it) {
                SC_LD(1, it * 4 + 2);
                SC_CP(0, it * 4);
                if (it < 3) SC_LD(0, it * 4 + 4);
                SC_CP(1, it * 4 + 2);
            }
        }
    }
    __syncthreads();
    SCAN_YRED(271)
#undef SC_LD
#undef SC_CP
#undef SCAN_YRED
#undef SCAN_LOAD
#undef SCAN_TOK
    __builtin_amdgcn_s_setprio(0);
}

DI void phase_mix(const Params& p, int l, char* smem, int* s_item) {
    char* ws = p.ws;
    int* ctr = (int*)(ws + O_CTL) + l;
    const bool want_ctx = l < 3;
    const int nattn = 3072 + (want_ctx ? 192 : 0);
    const int total = nattn + 2304 + (l < 3 ? 804 : 0);
    const bf16_t* naqk = (const bf16_t*)(ws + O_NAQK);
    const bf16_t* vta = (const bf16_t*)(ws + O_VTA);
    const bf16_t* gq = (const bf16_t*)(ws + O_GQ);
    const bf16_t* vtb = (const bf16_t*)(ws + O_VTB);
    const bf16_t* qc = (const bf16_t*)(ws + O_QC);
    const bf16_t* kc = (const bf16_t*)(ws + O_KC);
    const bf16_t* vtc = (const bf16_t*)(ws + O_VTC);
    bf16_t* mix = (bf16_t*)(ws + O_HBUF);
    const float* rpb = p.in[I_RPB] + (size_t)l * 4 * 465;
    {
        const int G = gridDim.x, bb = blockIdx.x;
        for (int sidx = 0; sidx < 256; ++sidx) {
            const int owner = (G == 512) ? ((sidx & 127) + (sidx >> 7) * 256) : (sidx % G);
            if (owner == bb) { for (int rep = 0; rep < REP_SCAN; ++rep) scan_item(p, l, sidx, smem); }
        }
    }
    while (true) {
        if (threadIdx.x == 0) *s_item = atomicAdd(ctr, 1);
        __syncthreads();
        const int item = *s_item;
        __syncthreads();
        if (item >= total) break;
        if (item >= nattn) { const int j = item - nattn; if (j < 2304) wconv_late(p, l, j, smem); else wconv_early(p, l + 1, j - 2304, smem); continue; }
        int type, b, h, qtok0, nkt0, qr0 = 0; bool isctx = false;
        if (item < 3072) {
            const int i1 = item;
            type = i1 >> 10;
            const int r = i1 & 1023;
            b = r >> 7; h = (r >> 5) & 3;
            const int qb = r & 31;
            qtok0 = b * TPB + 256 + qb * 128; nkt0 = 68; qr0 = qb * 2;
        } else {
            const int i2 = item - 3072;
            type = i2 >> 6;
            const int r = i2 & 63;
            b = r >> 3; h = (r >> 1) & 3;
            qtok0 = b * TPB + (r & 1) * 128; nkt0 = 4; isctx = true;
        }
        const size_t kb = (size_t)b * TPB;
        for (int rep = 0; rep < REP_ATTN; ++rep) {
            if (type == 0) {
                attn_item<96, false>(qc + (size_t)qtok0 * 384 + h * 96, 384, kc + kb * 384 + h * 96, 384, vtc + ((size_t)b * 256 + h * 64) * TPB,
                                     0, nkt0, 0, 0, mix + (size_t)qtok0 * LDH + 512 + h * 64, 0, nullptr, smem);
            } else if (type == 2 && !isctx) {
                const int st0 = clampi(qr0 - 4, 0, 56), st1 = clampi(qr0 + 1 - 4, 0, 56);
                attn_item<64, true>(naqk + (size_t)qtok0 * LDNA + h * 64, LDNA, naqk + kb * LDNA + 256 + h * 64, LDNA, vta + ((size_t)b * 256 + h * 64) * TPB,
                                    0, 4, 256 + st0 * 64, st1 + 8 - st0, mix + (size_t)qtok0 * LDH + h * 64, qr0, rpb + h * 465, smem);
            } else {
                const bf16_t *Qp, *Kp, *Vp; bf16_t* Op; int ld;
                if (type == 1) {
                    const int kvh = h >> 1;
                    Qp = gq + (size_t)qtok0 * 384 + h * 64; Kp = gq + kb * 384 + 256 + kvh * 64; Vp = vtb + ((size_t)b * 128 + kvh * 64) * TPB;
                    Op = mix + (size_t)qtok0 * LDH + 256 + h * 64; ld = 384;
                } else {
                    Qp = naqk + (size_t)qtok0 * LDNA + h * 64; Kp = naqk + kb * LDNA + 256 + h * 64; Vp = vta + ((size_t)b * 256 + h * 64) * TPB;
                    Op = mix + (size_t)qtok0 * LDH + h * 64; ld = LDNA;
                }
                attn_item<64, false>(Qp, ld, Kp, ld, Vp, 0, nkt0, 0, 0, Op, 0, nullptr, smem);
            }
        }
    }
}

DI void phase_rwkv_fin(const Params& p, int l) {
    const int tid = gtid(), lane = tid & 63, wave = tid >> 6;
    char* ws = p.ws;
    const float* yf = (const float*)(ws + O_Y);
    const float* yb = yf + (size_t)NT * 256;
    const bf16_t* rkv = (const bf16_t*)(ws + O_RKV);
    const bf16_t* dec = (const bf16_t*)(ws + O_DEC);
    const bf16_t* gate = (const bf16_t*)(ws + O_GATE);
    bf16_t* mix = (bf16_t*)(ws + O_HBUF);
    const int c = lane * 4;
    const float4 ka0 = *(const float4*)(p.in[I_KA] + (size_t)(l * 2) * 256 + c), ka1 = *(const float4*)(p.in[I_KA] + (size_t)(l * 2 + 1) * 256 + c);
    const float4 rk0 = *(const float4*)(p.in[I_RK] + (size_t)(l * 2) * 256 + c), rk1 = *(const float4*)(p.in[I_RK] + (size_t)(l * 2 + 1) * 256 + c);
    const float4 lw = *(const float4*)(p.in[I_LNW] + l * 256 + c), lb = *(const float4*)(p.in[I_LNB] + l * 256 + c);
    for (int tok = blockIdx.x * 4 + wave; tok < NT; tok += gridDim.x * 4) {
        const float4 a = *(const float4*)(yf + (size_t)tok * 256 + c), bb = *(const float4*)(yb + (size_t)tok * 256 + c);
        const float y0 = a.x + bb.x, y1 = a.y + bb.y, y2 = a.z + bb.z, y3 = a.w + bb.w;
        const float mu = sum16(y0 + y1 + y2 + y3) * (1.f / 64.f);
        const float d0 = y0 - mu, d1 = y1 - mu, d2 = y2 - mu, d3 = y3 - mu;
        const float var = sum16(d0 * d0 + d1 * d1 + d2 * d2 + d3 * d3) * (1.f / 64.f);
        const float rstd = rsqrtf(var + 64e-5f);
        const uint2 ur = *(const uint2*)(rkv + (size_t)tok * 768 + c), uk = *(const uint2*)(rkv + (size_t)tok * 768 + 256 + c), uv = *(const uint2*)(rkv + (size_t)tok * 768 + 512 + c);
        const uint2 uaf = *(const uint2*)(dec + (size_t)tok * 1024 + 512 + c), uab = *(const uint2*)(dec + (size_t)tok * 1024 + 768 + c);
        const uint2 ug = *(const uint2*)(gate + (size_t)tok * 256 + c);
        const float r0 = lo2f(ur.x), r1 = hi2f(ur.x), r2 = lo2f(ur.y), r3 = hi2f(ur.y);
        const float k0 = lo2f(uk.x), k1 = hi2f(uk.x), k2 = lo2f(uk.y), k3 = hi2f(uk.y);
        const float v0 = lo2f(uv.x), v1 = hi2f(uv.x), v2 = lo2f(uv.y), v3 = hi2f(uv.y);
        const float f0 = lo2f(uaf.x), f1 = hi2f(uaf.x), f2 = lo2f(uaf.y), f3 = hi2f(uaf.y);
        const float b0 = lo2f(uab.x), b1 = hi2f(uab.x), b2 = lo2f(uab.y), b3 = hi2f(uab.y);
        float bs = r0 * k0 * ((1.f + (f0 - 1.f) * ka0.x) * rk0.x + (1.f + (b0 - 1.f) * ka1.x) * rk1.x)
                 + r1 * k1 * ((1.f + (f1 - 1.f) * ka0.y) * rk0.y + (1.f + (b1 - 1.f) * ka1.y) * rk1.y)
                 + r2 * k2 * ((1.f + (f2 - 1.f) * ka0.z) * rk0.z + (1.f + (b2 - 1.f) * ka1.z) * rk1.z)
                 + r3 * k3 * ((1.f + (f3 - 1.f) * ka0.w) * rk0.w + (1.f + (b3 - 1.f) * ka1.w) * rk1.w);
        bs = sum16(bs);
        const float o0 = (d0 * rstd * lw.x + lb.x + bs * v0) * lo2f(ug.x);
        const float o1 = (d1 * rstd * lw.y + lb.y + bs * v1) * hi2f(ug.x);
        const float o2 = (d2 * rstd * lw.z + lb.z + bs * v2) * lo2f(ug.y);
        const float o3 = (d3 * rstd * lw.w + lb.w + bs * v3) * hi2f(ug.y);
        st4(mix + (size_t)tok * LDH + 768 + c, o0, o1, o2, o3);
    }
}

DI void phase_final(const Params& p) {
    const int tid = gtid(), lane = tid & 63, wave = tid >> 6;
    const float* g = p.in[I_FNG];
    for (int row = blockIdx.x * 4 + wave; row < NB * 4096; row += gridDim.x * 4) {
        float* x = p.out + (size_t)row * 1024;
        f32x4 v[4]; float ss = 0.f;
#pragma unroll
        for (int i = 0; i < 4; ++i) { v[i] = ((const f32x4*)x)[lane + 64 * i]; ss += v[i].x * v[i].x + v[i].y * v[i].y + v[i].z * v[i].z + v[i].w * v[i].w; }
        ss = wsum64(ss);
        const float rs = rsqrtf(ss * (1.f / 1024.f) + 1e-6f);
#pragma unroll
        for (int i = 0; i < 4; ++i) {
            const float4 g4 = ((const float4*)g)[lane + 64 * i];
            float4 o; o.x = v[i].x * rs * g4.x; o.y = v[i].y * rs * g4.y; o.z = v[i].z * rs * g4.z; o.w = v[i].w * rs * g4.w;
            ((float4*)x)[lane + 64 * i] = o;
        }
    }
}

#define XB_TMO      128
#define XB_XCNT(j)  (256  + 64 * (j))
#define XB_XSUB(j)  (1280 + 64 * (j))
#define XB_XGEN(j)  (2304 + 64 * (j))
#define XB_TOP      3328
#define XB_TOPGEN   3392
#define XCD_BAR_WORDS 3456
#define XB_SPIN_CAP (1u << 18)
#define LAS __attribute__((address_space(3)))

__device__ __forceinline__ unsigned xb_ld(unsigned* p)              { return __hip_atomic_load(p, __ATOMIC_RELAXED, __HIP_MEMORY_SCOPE_AGENT); }
__device__ __forceinline__ unsigned xb_add(unsigned* p, unsigned v) { return __hip_atomic_fetch_add(p, v, __ATOMIC_RELAXED, __HIP_MEMORY_SCOPE_AGENT); }
__device__ __forceinline__ unsigned xb_xcc_id() { return (unsigned)__builtin_amdgcn_s_getreg((3 << 11) | 20) & 0xFu; }
#define XB_SPIN(cond, bar) do { unsigned _sp = 0; while (cond) { __builtin_amdgcn_s_sleep(1); \
    if ((++_sp & 255u) == 0u) { if (xb_ld(&(bar)[XB_TMO])) break; if (_sp > XB_SPIN_CAP) { atomicAdd(&(bar)[XB_TMO], 1u); break; } } } } while (0)

struct XcdBarrier {
    unsigned* bar; unsigned x;
    volatile LAS unsigned* st;
};

__device__ __forceinline__ XcdBarrier xcd_barrier_post(unsigned* bar, volatile LAS unsigned* st) {
    XcdBarrier b; b.bar = bar; b.x = xb_xcc_id(); b.st = st;
    if (threadIdx.x == 0) (void)xb_add(&bar[XB_XCNT(b.x)], 1u);
    return b;
}
__device__ __forceinline__ void xcd_barrier_complete(unsigned* bar, unsigned x, unsigned& nloc, unsigned& nx) {
    const unsigned G = gridDim.x * gridDim.y * gridDim.z;
    unsigned sum, cnt, mine, sp = 0u;
    for (;;) {
        sum = 0u; cnt = 0u; mine = 0u;
#pragma unroll
        for (unsigned j = 0; j < 16; ++j) { const unsigned c = xb_ld(&bar[XB_XCNT(j)]); sum += c; cnt += (c > 0u) ? 1u : 0u; mine = (j == x) ? c : mine; }
        if (sum == G) break;
        __builtin_amdgcn_s_sleep(1);
        if ((++sp & 255u) == 0u) { if (xb_ld(&bar[XB_TMO])) break; if (sp > XB_SPIN_CAP) { atomicAdd(&bar[XB_TMO], 1u); break; } }
    }
    nloc = mine > 0u ? mine : 1u; nx = cnt > 0u ? cnt : 1u;
}

__device__ __forceinline__ void xcd_barrier(const XcdBarrier& b) {
    asm volatile("s_waitcnt vmcnt(0)" ::: "memory");
    __syncthreads();
    if (threadIdx.x == 0) {
        unsigned* bar = b.bar;
        __builtin_amdgcn_s_waitcnt(0);
        unsigned nloc = b.st[0], nx = b.st[1];
        if (nloc == 0u) { xcd_barrier_complete(bar, b.x, nloc, nx); b.st[0] = nloc; b.st[1] = nx; }
        const unsigned old = xb_add(&bar[XB_XSUB(b.x)], 1u);
        const unsigned gen = old / nloc;
        if (old + 1u == (gen + 1u) * nloc) {
            __builtin_amdgcn_fence(__ATOMIC_RELEASE, "agent");
            asm volatile("s_waitcnt vmcnt(0)" ::: "memory");
            const unsigned og = xb_add(&bar[XB_TOP], 1u);
            const unsigned tg = og / nx;
            if (og + 1u == (tg + 1u) * nx) xb_add(&bar[XB_TOPGEN], 1u);
            else XB_SPIN(xb_ld(&bar[XB_TOPGEN]) == tg, bar);
            __builtin_amdgcn_fence(__ATOMIC_ACQUIRE, "agent");
            xb_add(&bar[XB_XGEN(b.x)], 1u);
            asm volatile("s_waitcnt vmcnt(0)" ::: "memory");
        } else {
            XB_SPIN(xb_ld(&bar[XB_XGEN(b.x)]) == gen, bar);
            __builtin_amdgcn_fence(__ATOMIC_ACQUIRE, "agent");
            asm volatile("s_waitcnt vmcnt(0)" ::: "memory");
        }
    }
    __syncthreads();
}


__global__ void __launch_bounds__(256, 3) mega(Params p) {
    __shared__ __attribute__((aligned(16))) char smem[49152];
    __shared__ int s_item;
    __shared__ uint4 xb_words;
    cg::grid_group grid = cg::this_grid();
    if (threadIdx.x == 0) xb_words = make_uint4(0u, 0u, 0u, 0u);
    __syncthreads();
    XcdBarrier xb = xcd_barrier_post((unsigned*)(p.ws + O_CTL), (volatile LAS unsigned*)&xb_words);
    char* ws = p.ws;
    const int G = gridDim.x;
    const int pb = ((G & 7) == 0) ? ((int)(blockIdx.x & 7) * (G >> 3) + (int)(blockIdx.x >> 3)) : (int)blockIdx.x;
    float* xc = (float*)(ws + O_XC);
    bf16_t* hbuf = (bf16_t*)(ws + O_HBUF);

    phase_mod(p, smem);
    phase_wconv(p, 0, smem);
    grid.sync();
    for (int step = 0; step < 40; ++step) {
        const int l = step / 10, ph = step - l * 10;
        const float* modl = (const float*)(ws + O_MOD) + (size_t)l * 9 * 6144;
        const float* xl_src = (l == 0) ? p.in[I_X] : p.out;
        const float* xc_src = (l == 0) ? p.in[I_CTX] : xc;
        switch (ph) {
        case 0: {
            for (int rep = 0; rep < REP_EWA; ++rep) phase_norm(xl_src, xc_src, p.in[I_N1G] + l * 1024, modl, 0, 1, hbuf);
        } break;
        case 1: {
            {
                EpiIn e{(bf16_t*)(ws + O_NAQK), (bf16_t*)(ws + O_VTA), (bf16_t*)(ws + O_GQ), (bf16_t*)(ws + O_VTB), (bf16_t*)(ws + O_MLAR), (bf16_t*)(ws + O_RWR)};
                for (int rep = 0; rep < REP_GEMM; ++rep) for (int t = pb; t < 272 * 23; t += G) { int mt, nt; tile_mn(t, 23, mt, nt); gemm_tile(hbuf, LDH, (const bf16_t*)(ws + O_WIN), LDW1, 1024, mt * 128, nt * 128, smem, e); }
            }
        } break;
        case 2: {
            phase_post(p, l);
        } break;
        case 3: {
            {
                EpiUQ e1{(bf16_t*)(ws + O_QC), (const float*)(ws + O_RSM)};
                EpiUKV e2{(bf16_t*)(ws + O_KC), (bf16_t*)(ws + O_VTC), (const float*)(ws + O_RSM)};
                EpiAux e3{(bf16_t*)(ws + O_DEC), (bf16_t*)(ws + O_GATE), p.in[I_W0] + l * 512, p.in[I_A0] + l * 512};
                const bf16_t* mlar = (const bf16_t*)(ws + O_MLAR);
                for (int rep = 0; rep < REP_GEMM; ++rep) for (int t = pb; t < 272 * 17; t += G) {
                    const int mt = t / 17, j = t % 17;
                    if (j < 3) gemm_tile(mlar, 416, (const bf16_t*)(ws + O_WUQ), 256, 256, mt * 128, j * 128, smem, e1);
                    else if (j < 7) gemm_tile(mlar + 256, 416, (const bf16_t*)(ws + O_WUKV), 128, 128, mt * 128, (j - 3) * 128, smem, e2);
                    else {
                        const int n0 = (j - 7) * 128, blk = n0 >> 8;
                        if (blk < 4) {
                            gemm_tile(hbuf + blk * 64, 448, (const bf16_t*)(ws + O_WAUX) + (size_t)blk * 256 * 64 - (size_t)(blk * 256) * 64, 64, 64, mt * 128, n0, smem, e3);
                        } else {
                            gemm_tile(hbuf + 256, 448, (const bf16_t*)(ws + O_WG2) - (size_t)1024 * 192, 192, 192, mt * 128, n0, smem, e3);
                        }
                    }
                }
            }
        } break;
        case 4: {
            phase_mix(p, l, smem, &s_item);
        } break;
        case 5: {
            for (int rep = 0; rep < REP_EW; ++rep) phase_rwkv_fin(p, l);
        } break;
        case 6: {
            {
                EpiRes e{xl_src, xc_src, p.out, xc, modl + 2 * 1024};
                for (int t = pb; t < 272 * 8; t += G) { int mt, nt; tile_mn(t, 8, mt, nt); if (l == 3 && (mt % 34) < 2) continue;
                    gemm_tile(hbuf, LDH, (const bf16_t*)(ws + O_WOUT), LDW1, 1024, mt * 128, nt * 128, smem, e); }
            }
        } break;
        case 7: {
            for (int rep = 0; rep < REP_EW; ++rep) phase_norm(p.out, xc, p.in[I_N2G] + l * 1024, modl, 3, 4, hbuf);
        } break;
        case 8: {
            {
                EpiFc1 e{(bf16_t*)(ws + O_HID)};
                for (int rep = 0; rep < REP_GEMM; ++rep) for (int t = pb; t < 272 * 32; t += G) { int mt, nt; tile_mn(t, 32, mt, nt); if (l == 3 && (mt % 34) < 2) continue;
                    gemm_tile(hbuf, LDH, (const bf16_t*)(ws + O_WFC1), LDW1, 1024, mt * 128, nt * 128, smem, e); }
            }
        } break;
        case 9: {
            {
                EpiRes e{p.out, xc, p.out, xc, modl + 5 * 1024};
                for (int t = pb; t < 272 * 8; t += G) { int mt, nt; tile_mn(t, 8, mt, nt); if (l == 3 && (mt % 34) < 2) continue;
                    gemm_tile((const bf16_t*)(ws + O_HID), LDHID, (const bf16_t*)(ws + O_WFC2), LDW4, 4096, mt * 128, nt * 128, smem, e); }
            }
        } break;
        }
        for (int rep = 0; rep < REP_SYNC; ++rep) xcd_barrier(xb);
    }
    phase_final(p);
}

extern "C" void kernel_launch(void* const* d_in, const int* in_sizes, int n_in, void* d_out, int out_size, void* d_ws, size_t ws_size, hipStream_t stream) {
    static int grid_blocks = 0;
    if (n_in != 31 || ws_size < O_END) { fprintf(stderr, "kernel_launch: bad n_in %d or ws_size %zu < %zu\n", n_in, ws_size, (size_t)O_END); return; }
    if (!grid_blocks) {
        int dev = 0, cus = 0, per_cu = 0;
        hipGetDevice(&dev);
        hipDeviceGetAttribute(&cus, hipDeviceAttributeMultiprocessorCount, dev);
        hipOccupancyMaxActiveBlocksPerMultiprocessor(&per_cu, mega, 256, 0);
        if (per_cu > 3) per_cu = 3;
        if (per_cu < 1) per_cu = 1;
        grid_blocks = cus * per_cu;
    }
    Params p{};
    for (int i = 0; i < 31; ++i) p.in[i] = (const float*)d_in[i];
    p.out = (float*)d_out;
    p.ws = (char*)d_ws;
    (void)hipMemsetAsync(d_ws, 0, 16384, stream);
    void* args[] = {&p};
    hipError_t e = hipLaunchCooperativeKernel((void*)mega, dim3(grid_blocks), dim3(256), args, 0, stream);
    if (e != hipSuccess) fprintf(stderr, "cooperative launch failed: %s (grid %d)\n", hipGetErrorString(e), grid_blocks);
}
```

```cpp
#include <hip/hip_runtime.h>
#include <hip/hip_cooperative_groups.h>
#include <stdint.h>
#include <stdio.h>
namespace cg = cooperative_groups;
#ifndef REP_GEMM
#define REP_GEMM 1
#endif
#ifndef REP_ATTN
#define REP_ATTN 1
#endif
#ifndef REP_EW
#define REP_EW 1
#endif
#ifndef REP_SYNC
#define REP_SYNC 1
#endif
#ifndef REP_EWA
#define REP_EWA 1
#endif
#ifndef REP_SCAN
#define REP_SCAN 1
#endif

#define DI __device__ __forceinline__
typedef unsigned short bf16_t;
typedef short bf16x8 __attribute__((ext_vector_type(8)));
typedef short bf16x4 __attribute__((ext_vector_type(4)));
typedef float f32x4 __attribute__((ext_vector_type(4)));
typedef unsigned u32x4 __attribute__((ext_vector_type(4)));

constexpr int NB = 8, TPB = 4352, NT = NB * TPB;
constexpr int INC = 2880, INP = 2944;
constexpr int LDH = 1088, LDHID = 4160, LDW1 = 1088, LDW4 = 4160, LDNA = 576;
constexpr float LOG2E = 1.4426950408889634f;
constexpr float QS64 = 0.125f * LOG2E;
constexpr float QS96 = 0.10206207261596577f * LOG2E;
constexpr float ROPE_L2T = 13.287712379549449f;

constexpr size_t al(size_t x) { return (x + 255) & ~size_t(255); }
constexpr size_t O_CTL = 0;
constexpr size_t O_MOD = 16384;
constexpr size_t O_XC = O_MOD + al((size_t)4 * 9 * 6144 * 4);
constexpr size_t O_WIN = O_XC + al((size_t)2048 * 1024 * 4);
constexpr size_t O_WOUT = O_WIN + al((size_t)INP * LDW1 * 2);
constexpr size_t O_WFC1 = O_WOUT + al((size_t)1024 * LDW1 * 2);
constexpr size_t O_WFC2 = O_WFC1 + al((size_t)4096 * LDW1 * 2);
constexpr size_t O_WUQ = O_WFC2 + al((size_t)1024 * LDW4 * 2);
constexpr size_t O_WUKV = O_WUQ + al((size_t)384 * 256 * 2);
constexpr size_t O_WAUX = O_WUKV + al((size_t)512 * 128 * 2);
constexpr size_t O_WG2 = O_WAUX + al((size_t)4 * 256 * 64 * 2);
constexpr size_t O_HBUF = O_WG2 + al((size_t)256 * 192 * 2);
constexpr size_t O_BIG = O_HBUF + al((size_t)NT * LDH * 2);
constexpr size_t O_NAQK = O_BIG;
constexpr size_t O_VTA = O_NAQK + al((size_t)NT * LDNA * 2);
constexpr size_t O_GQ = O_VTA + al((size_t)NB * 256 * TPB * 2);
constexpr size_t O_VTB = O_GQ + al((size_t)NT * 384 * 2);
constexpr size_t O_MLAR = O_VTB + al((size_t)NB * 128 * TPB * 2);
constexpr size_t O_RWR = O_MLAR + al((size_t)NT * 416 * 2);
constexpr size_t O_QC = O_RWR + al((size_t)NT * 1184 * 2);
constexpr size_t O_KC = O_QC + al((size_t)NT * 384 * 2);
constexpr size_t O_VTC = O_KC + al((size_t)NT * 384 * 2);
constexpr size_t O_RKV = O_VTC + al((size_t)NB * 256 * TPB * 2);
constexpr size_t O_DEC = O_RKV + al((size_t)NT * 768 * 2);
constexpr size_t O_GATE = O_DEC + al((size_t)NT * 1024 * 2);
constexpr size_t O_INVN = O_GATE + al((size_t)NT * 256 * 2);
constexpr size_t O_RSM = O_INVN + al((size_t)NT * 8 * 4);
constexpr size_t O_END = O_RSM + al((size_t)NT * 2 * 4);
constexpr size_t O_HID = O_BIG;
constexpr size_t O_Y = O_RWR;
static_assert(O_HID + (size_t)NT * LDHID * 2 <= O_END, "hidden overlay");
static_assert(O_END <= (size_t)512 * 1024 * 1024, "workspace");
static_assert((size_t)2 * NT * 256 * 4 <= (size_t)NT * 1184 * 2, "y overlay");

struct Params {
    const float* in[31];
    float* out;
    char* ws;
};

enum { I_X = 0, I_C, I_CTX, I_CCTX, I_WMOD, I_BMOD, I_N1G, I_N2G, I_WIN, I_SHIFT, I_RPB, I_GQN, I_GKN, I_MQN, I_MKVN, I_WUQ, I_WUKV,
       I_W0, I_W2, I_A0, I_A2, I_KK, I_KA, I_RK, I_G2, I_LNW, I_LNB, I_WOUT, I_FC1, I_FC2, I_FNG };

typedef __bf16 hwbf16x2 __attribute__((ext_vector_type(2)));
typedef float f32x2 __attribute__((ext_vector_type(2)));
DI unsigned pk2(float a, float b) { f32x2 v = {a, b}; hwbf16x2 r = __builtin_convertvector(v, hwbf16x2); return __builtin_bit_cast(unsigned, r); }
DI bf16_t f2bf(float x) { return (bf16_t)(pk2(x, x) & 0xffffu); }
DI float bf2f(bf16_t b) { return __uint_as_float(((unsigned)b) << 16); }
DI float lo2f(unsigned u) { return __uint_as_float(u << 16); }
DI float hi2f(unsigned u) { return __uint_as_float(u & 0xffff0000u); }
DI void st4(bf16_t* p, float a, float b, float c, float d) { uint2 u; u.x = pk2(a, b); u.y = pk2(c, d); *(uint2*)p = u; }
template <int CTRL> DI float dppf(float v) { return __int_as_float(__builtin_amdgcn_update_dpp(0, __float_as_int(v), CTRL, 0xF, 0xF, true)); }
DI float sum16(float v) { v += dppf<0xB1>(v); v += dppf<0x4E>(v); v += dppf<0x141>(v); v += dppf<0x140>(v); return v; }
DI float wsum64(float v) { v = sum16(v); v += __shfl_xor(v, 16); v += __shfl_xor(v, 32); return v; }
DI float sigm(float x) { return 1.f / (1.f + __expf(-x)); }
DI int gtid() { int t = threadIdx.x; asm volatile("" : "+v"(t)); return t; }
DI int clampi(int v, int lo, int hi) { return v < lo ? lo : (v > hi ? hi : v); }

template <class T> struct IsRes;
template <class Epi>
DI void gemm_tile(const bf16_t* __restrict__ A, int lda, const bf16_t* __restrict__ Bt, int ldb, int K, int m0, int n0, char* smem, const Epi& epi) {
    char* sA = smem;
    char* sB = smem + 16384;
    const int tid = gtid(), lane = tid & 63, wave = tid >> 6;
    const int wm = wave >> 1, wn = wave & 1, l15 = lane & 15, quad = lane >> 4;
    f32x4 acc[4][4];
#pragma unroll
    for (int i = 0; i < 4; ++i)
#pragma unroll
        for (int j = 0; j < 4; ++j) acc[i][j] = (f32x4){0.f, 0.f, 0.f, 0.f};
    const int srow = lane >> 3, skc = (lane & 7) ^ (lane >> 3);
    const bf16_t* Ag = A + (size_t)(m0 + wave * 8 + srow) * lda + skc * 8;
    const bf16_t* Bg = Bt + (size_t)(n0 + wave * 8 + srow) * ldb + skc * 8;
    const size_t a32 = (size_t)32 * lda, b32 = (size_t)32 * ldb;
    const int sw = l15 & 7;
    for (int k0 = 0; k0 < K; k0 += 64) {
        __syncthreads();
#pragma unroll
        for (int i = 0; i < 4; ++i) {
            __builtin_amdgcn_global_load_lds((const unsigned*)(Ag + i * a32 + k0), (__attribute__((address_space(3))) unsigned*)(sA + (i * 4 + wave) * 1024), 16, 0, 0);
            __builtin_amdgcn_global_load_lds((const unsigned*)(Bg + i * b32 + k0), (__attribute__((address_space(3))) unsigned*)(sB + (i * 4 + wave) * 1024), 16, 0, 0);
        }
        asm volatile("s_waitcnt vmcnt(0)" ::: "memory");
        __syncthreads();
#pragma unroll
        for (int ks = 0; ks < 2; ++ks) {
            bf16x8 wf[4], xf[4];
            const int co = ((ks * 4 + quad) ^ sw) * 16;
#pragma unroll
            for (int t = 0; t < 4; ++t) {
                wf[t] = *(const bf16x8*)(sB + (wn * 64 + t * 16 + l15) * 128 + co);
                xf[t] = *(const bf16x8*)(sA + (wm * 64 + t * 16 + l15) * 128 + co);
            }
#pragma unroll
            for (int nt = 0; nt < 4; ++nt)
#pragma unroll
                for (int mt = 0; mt < 4; ++mt) acc[nt][mt] = __builtin_amdgcn_mfma_f32_16x16x32_bf16(wf[nt], xf[mt], acc[nt][mt], 0, 0, 0);
        }
    }
    if constexpr (IsRes<Epi>::value) {
#pragma unroll
        for (int nt = 0; nt < 4; ++nt) {
            f32x4 xv[4], gv[4];
#pragma unroll
            for (int mt = 0; mt < 4; ++mt) epi.loadxg(m0 + wm * 64 + mt * 16 + l15, n0 + wn * 64 + nt * 16 + quad * 4, xv[mt], gv[mt]);
#pragma unroll
            for (int mt = 0; mt < 4; ++mt) epi.storex(m0 + wm * 64 + mt * 16 + l15, n0 + wn * 64 + nt * 16 + quad * 4, xv[mt], gv[mt], acc[nt][mt]);
        }
    } else {
#pragma unroll
        for (int nt = 0; nt < 4; ++nt)
#pragma unroll
            for (int mt = 0; mt < 4; ++mt) epi(m0 + wm * 64 + mt * 16 + l15, n0 + wn * 64 + nt * 16 + quad * 4, acc[nt][mt]);
    }
}

DI void tile_mn(int t, int nn, int& mt, int& nt) { const int sup = t / (8 * nn), tin = t - sup * 8 * nn; mt = sup * 8 + (tin & 7); nt = tin >> 3; }

struct EpiIn {
    bf16_t *naqk, *vta, *gq, *vtb, *mlar, *rwr;
    DI void operator()(int m, int n, f32x4 v) const {
        if (n >= INC) return;
        if (n < 512) {
            const float s = (n < 256) ? QS64 : 1.f;
            st4(naqk + (size_t)m * LDNA + n, v[0] * s, v[1] * s, v[2] * s, v[3] * s);
        } else if (n < 768) {
            const int b = m / TPB, tib = m - b * TPB;
            bf16_t* d = vta + ((size_t)b * 256 + (n - 512)) * TPB + tib;
            d[0] = f2bf(v[0]); d[TPB] = f2bf(v[1]); d[2 * TPB] = f2bf(v[2]); d[3 * TPB] = f2bf(v[3]);
        } else if (n < 1152) {
            st4(gq + (size_t)m * 384 + (n - 768), v[0], v[1], v[2], v[3]);
        } else if (n < 1280) {
            const int b = m / TPB, tib = m - b * TPB;
            bf16_t* d = vtb + ((size_t)b * 128 + (n - 1152)) * TPB + tib;
            d[0] = f2bf(v[0]); d[TPB] = f2bf(v[1]); d[2 * TPB] = f2bf(v[2]); d[3 * TPB] = f2bf(v[3]);
        } else if (n < 1696) {
            st4(mlar + (size_t)m * 416 + (n - 1280), v[0], v[1], v[2], v[3]);
        } else {
            st4(rwr + (size_t)m * 1184 + (n - 1696), v[0], v[1], v[2], v[3]);
        }
    }
};

DI void rope_rot(float& a, float& b, int pos, float fidx, float fscale) {
    const float ang = (float)pos * __builtin_amdgcn_exp2f(-fidx * fscale);
    const float c = __cosf(ang), s = __sinf(ang);
    const float a2 = a * c - b * s, b2 = a * s + b * c;
    a = a2; b = b2;
}

struct EpiUQ {
    bf16_t* qc; const float* rsm;
    DI void operator()(int m, int n, f32x4 v) const {
        const float rs = rsm[m * 2] * QS96;
        float a = v[0] * rs, b = v[1] * rs, c = v[2] * rs, d = v[3] * rs;
        const int h = n / 96, dd = n - h * 96;
        const int bb = m / TPB, tib = m - bb * TPB;
        if (dd >= 64 && tib >= 256) {
            const int t = tib - 256, row = t >> 6, col = t & 63;
            const int i0 = (dd - 64) >> 1, i1 = i0 + 1;
            rope_rot(a, b, i0 < 8 ? row : col, (float)(i0 & 7), ROPE_L2T / 8.f);
            rope_rot(c, d, i1 < 8 ? row : col, (float)(i1 & 7), ROPE_L2T / 8.f);
        }
        st4(qc + (size_t)m * 384 + n, a, b, c, d);
    }
};
struct EpiUKV {
    bf16_t *kc, *vtc; const float* rsm;
    DI void operator()(int m, int n, f32x4 v) const {
        const float rs = rsm[m * 2 + 1];
        const int h = n >> 7, dd = n & 127;
        if (dd < 64) {
            st4(kc + (size_t)m * 384 + h * 96 + dd, v[0] * rs, v[1] * rs, v[2] * rs, v[3] * rs);
        } else {
            const int b = m / TPB, tib = m - b * TPB;
            bf16_t* d = vtc + ((size_t)b * 256 + h * 64 + (dd - 64)) * TPB + tib;
            d[0] = f2bf(v[0] * rs); d[TPB] = f2bf(v[1] * rs); d[2 * TPB] = f2bf(v[2] * rs); d[3 * TPB] = f2bf(v[3] * rs);
        }
    }
};
struct EpiAux {
    bf16_t *dec, *gate; const float *w0, *a0;
    DI void operator()(int m, int n, f32x4 v) const {
        const int j = n >> 8, c = n & 255;
        float o[4];
        if (j < 2) {
#pragma unroll
            for (int r = 0; r < 4; ++r) {
                const float u = w0[j * 256 + c + r] + v[r];
                const float z = -u;
                const float sp = fmaxf(z, 0.f) + __logf(1.f + __expf(-fabsf(z)));
                const float w = -sp - 0.5f;
                const float e = __expf(w);
                o[r] = 1.f - __expf(-e);
            }
            st4(dec + (size_t)m * 1024 + j * 256 + c, o[0], o[1], o[2], o[3]);
        } else if (j < 4) {
#pragma unroll
            for (int r = 0; r < 4; ++r) o[r] = sigm(a0[(j - 2) * 256 + c + r] + v[r]);
            st4(dec + (size_t)m * 1024 + 512 + (j - 2) * 256 + c, o[0], o[1], o[2], o[3]);
        } else {
            st4(gate + (size_t)m * 256 + c, v[0], v[1], v[2], v[3]);
        }
    }
};
struct EpiRes {
    const float *srcl, *srcc; float *dstl, *dstc; const float* modg;
    DI void loadxg(int m, int n, f32x4& x, f32x4& g) const {
        const int b = m / TPB, tib = m - b * TPB;
        const float* s; int mr;
        if (tib < 256) { s = srcc + ((size_t)b * 256 + tib) * 1024 + n; mr = 8; }
        else { s = srcl + ((size_t)b * 4096 + (tib - 256)) * 1024 + n; mr = b; }
        g = *(const f32x4*)(modg + mr * 6144 + n);
        x = *(const f32x4*)s;
    }
    DI void storex(int m, int n, const f32x4& x, const f32x4& g, f32x4 v) const {
        const int b = m / TPB, tib = m - b * TPB;
        float* d = (tib < 256) ? dstc + ((size_t)b * 256 + tib) * 1024 + n : dstl + ((size_t)b * 4096 + (tib - 256)) * 1024 + n;
        *(f32x4*)d = x + g * v;
    }
    DI void operator()(int m, int n, f32x4 v) const { f32x4 x, g; loadxg(m, n, x, g); storex(m, n, x, g, v); }
};
template <class T> struct IsRes { static constexpr bool value = false; };
template <> struct IsRes<EpiRes> { static constexpr bool value = true; };
struct EpiFc1 {
    bf16_t* hid;
    DI void operator()(int m, int n, f32x4 v) const {
        float a = fmaxf(v[0], 0.f), b = fmaxf(v[1], 0.f), c = fmaxf(v[2], 0.f), d = fmaxf(v[3], 0.f);
        st4(hid + (size_t)m * LDHID + n, a * a, b * b, c * c, d * d);
    }
};

DI void phase_mod(const Params& p, char* smem) {
    float* sc = (float*)smem;
    float* red = sc + 9 * 1024;
    const int tid = gtid(), lane = tid & 63, wave = tid >> 6;
    for (int i = tid; i < 9 * 1024; i += 256) { const float v = (i < 8192) ? p.in[I_C][i] : p.in[I_CCTX][i - 8192]; sc[i] = v / (1.f + __expf(-v)); }
    __syncthreads();
    float* mod = (float*)(p.ws + O_MOD);
    for (int item = blockIdx.x; item < 4 * 96; item += gridDim.x) {
        const int l = item / 96, nb = (item % 96) * 64;
        const float* w = p.in[I_WMOD] + (size_t)l * 1024 * 6144 + nb + lane;
        float acc[9];
#pragma unroll
        for (int r = 0; r < 9; ++r) acc[r] = 0.f;
#pragma unroll 8
        for (int k = wave * 256; k < wave * 256 + 256; ++k) {
            const float wv = w[(size_t)k * 6144];
#pragma unroll
            for (int r = 0; r < 9; ++r) acc[r] += sc[r * 1024 + k] * wv;
        }
#pragma unroll
        for (int r = 0; r < 9; ++r) red[(wave * 9 + r) * 64 + lane] = acc[r];
        __syncthreads();
        for (int i = tid; i < 9 * 64; i += 256) {
            const int r = i >> 6, ln = i & 63;
            const float s = red[(0 * 9 + r) * 64 + ln] + red[(1 * 9 + r) * 64 + ln] + red[(2 * 9 + r) * 64 + ln] + red[(3 * 9 + r) * 64 + ln];
            mod[((size_t)l * 9 + r) * 6144 + nb + ln] = s + p.in[I_BMOD][l * 6144 + nb + ln];
        }
        __syncthreads();
    }
}

DI void wconv_tile(const float* src, const float* g, int K, int N, bf16_t* dst, int nkt, int ldd, int t, char* smem) {
    float* tile = (float*)smem;
    const int tid = gtid();
    const int kt = t % nkt, nt = t / nkt, k0 = kt * 64, n0 = nt * 64;
    __syncthreads();
#pragma unroll 4
    for (int i = 0; i < 16; ++i) {
        const int kl = (tid >> 6) + 4 * i, nl = tid & 63, k = k0 + kl, n = n0 + nl;
        float v = 0.f;
        if (k < K && n < N) { v = src[(size_t)k * N + n]; if (g) v *= g[k]; }
        tile[kl * 65 + nl] = v;
    }
    __syncthreads();
#pragma unroll 4
    for (int i = 0; i < 8; ++i) {
        const int nl = (tid >> 5) + 8 * i, kl = (tid & 31) * 2;
        *(unsigned*)(dst + (size_t)(n0 + nl) * ldd + k0 + kl) = pk2(tile[kl * 65 + nl], tile[(kl + 1) * 65 + nl]);
    }
}
DI void wconv(const float* src, const float* g, int K, int N, bf16_t* dst, int Kp, int Np, int ldd, int rot, char* smem) {
    const int nkt = Kp / 64, nnt = Np / 64, G = gridDim.x;
    for (int t = (blockIdx.x + G - (rot % G)) % G; t < nkt * nnt; t += G) wconv_tile(src, g, K, N, dst, nkt, ldd, t, smem);
}
DI void wconv_late(const Params& p, int l, int u, char* smem) {
    char* ws = p.ws;
    if (u < 1024) wconv_tile(p.in[I_FC1] + (size_t)l * 1024 * 4096, nullptr, 1024, 4096, (bf16_t*)(ws + O_WFC1), 16, LDW1, u, smem);
    else if (u < 2048) wconv_tile(p.in[I_FC2] + (size_t)l * 4096 * 1024, nullptr, 4096, 1024, (bf16_t*)(ws + O_WFC2), 64, LDW4, u - 1024, smem);
    else wconv_tile(p.in[I_WOUT] + (size_t)l * 1024 * 1024, nullptr, 1024, 1024, (bf16_t*)(ws + O_WOUT), 16, LDW1, u - 2048, smem);
}
DI void wconv_early(const Params& p, int l, int u, char* smem) {
    char* ws = p.ws;
    if (u < 736) wconv_tile(p.in[I_WIN] + (size_t)l * 1024 * INC, nullptr, 1024, INC, (bf16_t*)(ws + O_WIN), 16, LDW1, u, smem);
    else if (u < 760) wconv_tile(p.in[I_WUQ] + (size_t)l * 256 * 384, p.in[I_MQN] + l * 256, 256, 384, (bf16_t*)(ws + O_WUQ), 4, 256, u - 736, smem);
    else if (u < 776) wconv_tile(p.in[I_WUKV] + (size_t)l * 128 * 512, p.in[I_MKVN] + l * 128, 128, 512, (bf16_t*)(ws + O_WUKV), 2, 128, u - 760, smem);
    else if (u < 792) {
        const int v = u - 776, j = v >> 2, d = j & 1;
        const float* src = (j < 2 ? p.in[I_W2] : p.in[I_A2]) + (size_t)(l * 2 + d) * 64 * 256;
        wconv_tile(src, nullptr, 64, 256, (bf16_t*)(ws + O_WAUX) + (size_t)j * 256 * 64, 1, 64, v & 3, smem);
    } else wconv_tile(p.in[I_G2] + (size_t)l * 160 * 256, nullptr, 160, 256, (bf16_t*)(ws + O_WG2), 3, 192, u - 792, smem);
}

DI void phase_wconv(const Params& p, int l, char* smem) {
    char* ws = p.ws;
    wconv(p.in[I_WIN] + (size_t)l * 1024 * INC, nullptr, 1024, INC, (bf16_t*)(ws + O_WIN), 1024, INP, LDW1, 0, smem);
    wconv(p.in[I_WUQ] + (size_t)l * 256 * 384, p.in[I_MQN] + l * 256, 256, 384, (bf16_t*)(ws + O_WUQ), 256, 384, 256, 3040, smem);
    wconv(p.in[I_WUKV] + (size_t)l * 128 * 512, p.in[I_MKVN] + l * 128, 128, 512, (bf16_t*)(ws + O_WUKV), 128, 512, 128, 3064, smem);
    for (int d = 0; d < 2; ++d) {
        wconv(p.in[I_W2] + (size_t)(l * 2 + d) * 64 * 256, nullptr, 64, 256, (bf16_t*)(ws + O_WAUX) + d * 256 * 64, 64, 256, 64, 3080 + d * 4, smem);
        wconv(p.in[I_A2] + (size_t)(l * 2 + d) * 64 * 256, nullptr, 64, 256, (bf16_t*)(ws + O_WAUX) + (2 + d) * 256 * 64, 64, 256, 64, 3088 + d * 4, smem);
    }
    wconv(p.in[I_G2] + (size_t)l * 160 * 256, nullptr, 160, 256, (bf16_t*)(ws + O_WG2), 192, 256, 192, 3096, smem);
}

DI void phase_norm(const float* xl, const float* xc, const float* g, const float* modl, int shi, int sci, bf16_t* dst) {
    const int tid = gtid(), lane = tid & 63, wave = tid >> 6;
    for (int tok = blockIdx.x * 4 + wave; tok < NT; tok += gridDim.x * 4) {
        const int b = tok / TPB, tib = tok - b * TPB;
        const float* row; int mr;
        if (tib < 256) { row = xc + ((size_t)b * 256 + tib) * 1024; mr = 8; } else { row = xl + ((size_t)b * 4096 + tib - 256) * 1024; mr = b; }
        const float* sh = modl + mr * 6144 + shi * 1024;
        const float* sc = modl + mr * 6144 + sci * 1024;
        f32x4 v[4]; float ss = 0.f;
#pragma unroll
        for (int i = 0; i < 4; ++i) { v[i] = ((const f32x4*)row)[lane + 64 * i]; ss += v[i].x * v[i].x + v[i].y * v[i].y + v[i].z * v[i].z + v[i].w * v[i].w; }
        ss = wsum64(ss);
        const float rs = rsqrtf(ss * (1.f / 1024.f) + 1e-6f);
#pragma unroll
        for (int i = 0; i < 4; ++i) {
            const int c = (lane + 64 * i) * 4;
            const float4 g4 = *(const float4*)(g + c), s4 = *(const float4*)(sc + c), h4 = *(const float4*)(sh + c);
            st4(dst + (size_t)tok * LDH + c, v[i].x * rs * g4.x * (1.f + s4.x) + h4.x, v[i].y * rs * g4.y * (1.f + s4.y) + h4.y,
                v[i].z * rs * g4.z * (1.f + s4.z) + h4.z, v[i].w * rs * g4.w * (1.f + s4.w) + h4.w);
        }
    }
}

DI void phase_post(const Params& p, int l) {
    const int tid = gtid(), lane = tid & 63, wave = tid >> 6;
    char* ws = p.ws;
    bf16_t* gq = (bf16_t*)(ws + O_GQ);
    const bf16_t* mlar = (const bf16_t*)(ws + O_MLAR);
    bf16_t* kc = (bf16_t*)(ws + O_KC);
    float* rsm = (float*)(ws + O_RSM);
    const bf16_t* rwr = (const bf16_t*)(ws + O_RWR);
    bf16_t* rkv = (bf16_t*)(ws + O_RKV);
    bf16_t* acat = (bf16_t*)(ws + O_HBUF);
    float* invn = (float*)(ws + O_INVN);
    const float* gqn = p.in[I_GQN] + l * 64;
    const float* gkn = p.in[I_GKN] + l * 64;
    const float* taps = p.in[I_SHIFT] + (size_t)l * 3 * 1184;
    const float* kkw = p.in[I_KK] + (size_t)l * 512;
    for (int tok = blockIdx.x * 4 + wave; tok < NT; tok += gridDim.x * 4) {
        const int b = tok / TPB, tib = tok - b * TPB;
        const bool lat = tib >= 256;
        const int t = tib - 256, prow = t >> 6, pcol = t & 63;
        unsigned gqu[3];
#pragma unroll
        for (int it = 0; it < 3; ++it) gqu[it] = *(const unsigned*)(gq + (size_t)tok * 384 + (it * 2 + (lane >> 5)) * 64 + (lane & 31) * 2);
        const bf16_t* mr = mlar + (size_t)tok * 416;
        const uint2 uq = *(const uint2*)(mr + lane * 4);
        const unsigned ukv = *(const unsigned*)(mr + 256 + lane * 2);
        const unsigned ukr = *(const unsigned*)(mr + 384 + (lane & 15) * 2);
        {
            const int pair = lane & 31;
#pragma unroll
            for (int it = 0; it < 3; ++it) {
                const int head = it * 2 + (lane >> 5);
                unsigned* ptr = (unsigned*)(gq + (size_t)tok * 384 + head * 64 + pair * 2);
                const unsigned u = gqu[it];
                float x1 = lo2f(u), x2 = hi2f(u);
                float ss = x1 * x1 + x2 * x2;
                ss += __shfl_xor(ss, 1); ss += __shfl_xor(ss, 2); ss += __shfl_xor(ss, 4); ss += __shfl_xor(ss, 8); ss += __shfl_xor(ss, 16);
                const float rs = rsqrtf(ss * (1.f / 64.f) + 1e-6f);
                const float* gg = head < 4 ? gqn : gkn;
                x1 *= rs * gg[pair * 2]; x2 *= rs * gg[pair * 2 + 1];
                if (lat) rope_rot(x1, x2, pair < 16 ? prow : pcol, (float)(pair & 15), ROPE_L2T / 16.f);
                if (head < 4) { x1 *= QS64; x2 *= QS64; }
                *ptr = pk2(x1, x2);
            }
        }
        {
            float a0 = lo2f(uq.x), a1 = hi2f(uq.x), a2 = lo2f(uq.y), a3 = hi2f(uq.y);
            float sq = wsum64(a0 * a0 + a1 * a1 + a2 * a2 + a3 * a3);
            float c0 = lo2f(ukv), c1 = hi2f(ukv);
            float sk = wsum64(c0 * c0 + c1 * c1);
            if (lane == 0) { rsm[tok * 2] = rsqrtf(sq * (1.f / 256.f) + 1e-6f); rsm[tok * 2 + 1] = rsqrtf(sk * (1.f / 128.f) + 1e-6f); }
            if (lane < 16) {
                const unsigned u = ukr;
                float x1 = lo2f(u), x2 = hi2f(u);
                if (lat) rope_rot(x1, x2, lane < 8 ? prow : pcol, (float)(lane & 7), ROPE_L2T / 8.f);
                const unsigned o = pk2(x1, x2);
#pragma unroll
                for (int h = 0; h < 4; ++h) *(unsigned*)(kc + (size_t)tok * 384 + h * 96 + 64 + lane * 2) = o;
            }
        }
        {
            const bool hasp = (tib != 0) && (tib != 256);
            const bool hasn = (tib != 255) && (tib != TPB - 1);
            const bf16_t* r0 = rwr + (size_t)tok * 1184;
#pragma unroll
            for (int hb = 0; hb < 5; ++hb) {
            unsigned X0[2], X1[2], X2[2];
#pragma unroll
            for (int ii = 0; ii < 2; ++ii) {
                const int c = (lane + 64 * (hb * 2 + ii)) * 2;
                X0[ii] = 0u; X1[ii] = 0u; X2[ii] = 0u;
                if (c < 1184) {
                    X1[ii] = *(const unsigned*)(r0 + c);
                    if (hasp) X0[ii] = *(const unsigned*)(r0 + c - 1184);
                    if (hasn) X2[ii] = *(const unsigned*)(r0 + c + 1184);
                }
            }
#pragma unroll
            for (int ii = 0; ii < 2; ++ii) {
                const int i = hb * 2 + ii;
                const int c = (lane + 64 * i) * 2;
                float u0 = 0.f, u1 = 0.f;
                if (c < 1184) {
                    const float2 t1 = *(const float2*)(taps + 1184 + c);
                    u0 = lo2f(X1[ii]) * t1.x; u1 = hi2f(X1[ii]) * t1.y;
                    if (hasp) { const float2 t0 = *(const float2*)(taps + c); u0 += lo2f(X0[ii]) * t0.x; u1 += hi2f(X0[ii]) * t0.y; }
                    if (hasn) { const float2 t2 = *(const float2*)(taps + 2 * 1184 + c); u0 += lo2f(X2[ii]) * t2.x; u1 += hi2f(X2[ii]) * t2.y; }
                }
                if (i < 6) {
                    const unsigned pk = pk2(u0, u1);
                    *(unsigned*)(rkv + (size_t)tok * 768 + c) = pk;
                    if (i == 2 || i == 3) {
                        const float k0 = lo2f(pk), k1 = hi2f(pk);
                        const float2 f0 = *(const float2*)(kkw + c - 256), f1 = *(const float2*)(kkw + 256 + c - 256);
                        float s0 = (k0 * f0.x) * (k0 * f0.x) + (k1 * f0.y) * (k1 * f0.y);
                        float s1 = (k0 * f1.x) * (k0 * f1.x) + (k1 * f1.y) * (k1 * f1.y);
                        s0 = sum16(s0); s1 = sum16(s1);
                        s0 += __shfl_xor(s0, 16); s1 += __shfl_xor(s1, 16);
                        if ((lane & 31) == 0) {
                            const int hd = (i - 2) * 2 + (lane >> 5);
                            invn[tok * 8 + hd] = 1.f / fmaxf(sqrtf(s0), 1e-12f);
                            invn[tok * 8 + 4 + hd] = 1.f / fmaxf(sqrtf(s1), 1e-12f);
                        }
                    }
                } else if (i == 6) {
                    *(unsigned*)(acat + (size_t)tok * 448 + (c - 768)) = pk2(tanhf(u0), tanhf(u1));
                } else if (i == 7) {
                    *(unsigned*)(acat + (size_t)tok * 448 + 128 + (c - 896)) = pk2(u0, u1);
                } else {
                    const int cc = c - 1024;
                    if (cc < 192) *(unsigned*)(acat + (size_t)tok * 448 + 256 + cc) = (cc < 160) ? pk2(sigm(u0), sigm(u1)) : 0u;
                }
            }
            }
        }
    }
}

template <int DK, bool NAM>
DI void attn_item(const bf16_t* __restrict__ Q, int ldq, const bf16_t* __restrict__ Kb, int ldk, const bf16_t* __restrict__ Vt,
                          int s0, int nt0, int s1, int nt1, bf16_t* __restrict__ O, int qr0, const float* rpb_g, char* smem) {
    constexpr int KS = DK + 16, KCH = DK / 8, NKC = 64 * KCH / 256;
    bf16_t* sK = (bf16_t*)smem;
    bf16_t* sV = sK + 64 * 112;
    float* sR = (float*)(sV + 64 * 72);
    const int tid = gtid(), lane = tid & 63, wave = tid >> 6, l15 = lane & 15, quad = lane >> 4;
    const int ntot = nt0 + nt1;
    if (NAM) {
        __syncthreads();
        for (int i = tid; i < 465; i += 256) sR[i] = rpb_g[i] * LOG2E;
    }
    bf16x8 qf[2][DK / 32];
#pragma unroll
    for (int qt = 0; qt < 2; ++qt)
#pragma unroll
        for (int ks = 0; ks < DK / 32; ++ks) qf[qt][ks] = *(const bf16x8*)(Q + (size_t)(wave * 32 + qt * 16 + l15) * ldq + ks * 32 + quad * 8);
    f32x4 Oa[4][2];
#pragma unroll
    for (int i = 0; i < 4; ++i) { Oa[i][0] = (f32x4){0.f, 0.f, 0.f, 0.f}; Oa[i][1] = (f32x4){0.f, 0.f, 0.f, 0.f}; }
    float mrun[2] = {-1e30f, -1e30f}, lrun[2] = {0.f, 0.f};
    u32x4 rk[NKC], rv[2];
    {
        const int key0 = (0 < nt0) ? s0 : s1;
#pragma unroll
        for (int i = 0; i < NKC; ++i) { const int c = tid + 256 * i, row = c / KCH, kc = c % KCH; rk[i] = *(const u32x4*)(Kb + (size_t)(key0 + row) * ldk + kc * 8); }
#pragma unroll
        for (int i = 0; i < 2; ++i) { const int c = tid + 256 * i, row = c >> 3, kc = c & 7; rv[i] = *(const u32x4*)(Vt + (size_t)row * TPB + key0 + kc * 8); }
    }
    for (int j = 0; j < ntot; ++j) {
        __syncthreads();
#pragma unroll
        for (int i = 0; i < NKC; ++i) { const int c = tid + 256 * i, row = c / KCH, kc = c % KCH; *(u32x4*)(sK + row * KS + kc * 8) = rk[i]; }
#pragma unroll
        for (int i = 0; i < 2; ++i) { const int c = tid + 256 * i, row = c >> 3, kc = c & 7; *(u32x4*)(sV + row * 72 + kc * 8) = rv[i]; }
        __syncthreads();
        if (j + 1 < ntot) {
            const int jn = j + 1;
            const int key0 = (jn < nt0) ? (s0 + 64 * jn) : (s1 + 64 * (jn - nt0));
#pragma unroll
            for (int i = 0; i < NKC; ++i) { const int c = tid + 256 * i, row = c / KCH, kc = c % KCH; rk[i] = *(const u32x4*)(Kb + (size_t)(key0 + row) * ldk + kc * 8); }
#pragma unroll
            for (int i = 0; i < 2; ++i) { const int c = tid + 256 * i, row = c >> 3, kc = c & 7; rv[i] = *(const u32x4*)(Vt + (size_t)row * TPB + key0 + kc * 8); }
        }
        f32x4 S[4][2];
#pragma unroll
        for (int kt = 0; kt < 4; ++kt) { S[kt][0] = (f32x4){0.f, 0.f, 0.f, 0.f}; S[kt][1] = (f32x4){0.f, 0.f, 0.f, 0.f}; }
#pragma unroll
        for (int ks = 0; ks < DK / 32; ++ks)
#pragma unroll
            for (int kt = 0; kt < 4; ++kt) {
                const bf16x8 kf = *(const bf16x8*)(sK + (kt * 16 + l15) * KS + ks * 32 + quad * 8);
                S[kt][0] = __builtin_amdgcn_mfma_f32_16x16x32_bf16(kf, qf[0][ks], S[kt][0], 0, 0, 0);
                S[kt][1] = __builtin_amdgcn_mfma_f32_16x16x32_bf16(kf, qf[1][ks], S[kt][1], 0, 0, 0);
            }
        if (NAM) {
            if (j >= nt0) {
                const int kr = (s1 - 256) / 64 + (j - nt0);
#pragma unroll
                for (int qt = 0; qt < 2; ++qt) {
                    const int qi = wave * 32 + qt * 16 + l15, qrow = qr0 + (qi >> 6), qc = qi & 63;
                    const int st = clampi(qrow - 4, 0, 56), cs = clampi(qc - 8, 0, 48);
                    const bool rowok = (kr >= st) && (kr < st + 8);
                    const int rbase = (kr - qrow + 7) * 31 - qc + 15;
#pragma unroll
                    for (int kt = 0; kt < 4; ++kt)
#pragma unroll
                        for (int r = 0; r < 4; ++r) {
                            const int kcx = kt * 16 + quad * 4 + r;
                            const bool ok = rowok && (kcx >= cs) && (kcx < cs + 16);
                            const float bias = sR[ok ? (rbase + kcx) : 0];
                            S[kt][qt][r] = ok ? (S[kt][qt][r] + bias) : -1e30f;
                        }
                }
            }
        }
        bf16x8 pf[2][2];
#pragma unroll
        for (int qt = 0; qt < 2; ++qt) {
            float mx = -1e30f;
#pragma unroll
            for (int kt = 0; kt < 4; ++kt)
#pragma unroll
                for (int r = 0; r < 4; ++r) mx = fmaxf(mx, S[kt][qt][r]);
            mx = fmaxf(mx, __shfl_xor(mx, 16));
            mx = fmaxf(mx, __shfl_xor(mx, 32));
            const float mnew = fmaxf(mrun[qt], mx);
            const float alpha = __builtin_amdgcn_exp2f(mrun[qt] - mnew);
            mrun[qt] = mnew;
            float ps = 0.f;
#pragma unroll
            for (int kt = 0; kt < 4; ++kt)
#pragma unroll
                for (int r = 0; r < 4; ++r) { const float pv = __builtin_amdgcn_exp2f(S[kt][qt][r] - mnew); S[kt][qt][r] = pv; ps += pv; }
            lrun[qt] = lrun[qt] * alpha + ps;
            if (__any(alpha != 1.f)) {
#pragma unroll
                for (int dt = 0; dt < 4; ++dt) { Oa[dt][qt][0] *= alpha; Oa[dt][qt][1] *= alpha; Oa[dt][qt][2] *= alpha; Oa[dt][qt][3] *= alpha; }
            }
#pragma unroll
            for (int s = 0; s < 2; ++s) {
                u32x4 f;
                f[0] = pk2(S[2 * s][qt][0], S[2 * s][qt][1]); f[1] = pk2(S[2 * s][qt][2], S[2 * s][qt][3]);
                f[2] = pk2(S[2 * s + 1][qt][0], S[2 * s + 1][qt][1]); f[3] = pk2(S[2 * s + 1][qt][2], S[2 * s + 1][qt][3]);
                pf[qt][s] = __builtin_bit_cast(bf16x8, f);
            }
        }
#pragma unroll
        for (int s = 0; s < 2; ++s)
#pragma unroll
            for (int dt = 0; dt < 4; ++dt) {
                const bf16x4 v0 = *(const bf16x4*)(sV + (dt * 16 + l15) * 72 + (2 * s) * 16 + quad * 4);
                const bf16x4 v1 = *(const bf16x4*)(sV + (dt * 16 + l15) * 72 + (2 * s + 1) * 16 + quad * 4);
                const bf16x8 vf = __builtin_shufflevector(v0, v1, 0, 1, 2, 3, 4, 5, 6, 7);
                Oa[dt][0] = __builtin_amdgcn_mfma_f32_16x16x32_bf16(vf, pf[0][s], Oa[dt][0], 0, 0, 0);
                Oa[dt][1] = __builtin_amdgcn_mfma_f32_16x16x32_bf16(vf, pf[1][s], Oa[dt][1], 0, 0, 0);
            }
    }
#pragma unroll
    for (int qt = 0; qt < 2; ++qt) {
        float lt = lrun[qt];
        lt += __shfl_xor(lt, 16); lt += __shfl_xor(lt, 32);
        const float inv = 1.f / lt;
#pragma unroll
        for (int dt = 0; dt < 4; ++dt)
            st4(O + (size_t)(wave * 32 + qt * 16 + l15) * LDH + dt * 16 + quad * 4, Oa[dt][qt][0] * inv, Oa[dt][qt][1] * inv, Oa[dt][qt][2] * inv, Oa[dt][qt][3] * inv);
    }
}

DI void scan_item(const Params& p, int l, int item, char* smem) {
    float* sT = (float*)smem;
    float* sVv = sT + 16 * 320;
    float* sY = sVv + 256;
    const int tid = gtid(), lane = tid & 63, wave = tid >> 6;
    const int scan = item >> 2, rg = item & 3;
    const int b = scan >> 3, head = (scan >> 1) & 3, dir = scan & 1;
    const bf16_t* rkv = (const bf16_t*)(p.ws + O_RKV);
    const bf16_t* dec = (const bf16_t*)(p.ws + O_DEC);
    const float* invn = (const float*)(p.ws + O_INVN);
    float* yout = (float*)(p.ws + O_Y) + (size_t)dir * NT * 256;
    const int k2 = (tid & 31) * 2, tq = tid >> 5;
    const float* kkw = p.in[I_KK] + (size_t)(l * 2 + dir) * 256 + head * 64;
    const float* kaw = p.in[I_KA] + (size_t)(l * 2 + dir) * 256 + head * 64;
    const float kkc0 = kkw[k2], kkc1 = kkw[k2 + 1], kac0 = kaw[k2], kac1 = kaw[k2 + 1];
    unsigned rr[2], kr[2], ow[2], as[2]; float inn[2]; bf16_t vv;
    const int tbase = b * TPB;
#define SCAN_TOK(s) (tbase + (dir ? ((s) < 256 ? 255 - (s) : 4607 - (s)) : (s)))
#define SCAN_LOAD(ch)                                                                                          \
    {                                                                                                          \
        _Pragma("unroll") for (int i = 0; i < 2; ++i) {                                                        \
            const int tok = SCAN_TOK((ch) * 16 + tq + 8 * i);                                                  \
            rr[i] = *(const unsigned*)(rkv + (size_t)tok * 768 + head * 64 + k2);                              \
            kr[i] = *(const unsigned*)(rkv + (size_t)tok * 768 + 256 + head * 64 + k2);                        \
            ow[i] = *(const unsigned*)(dec + (size_t)tok * 1024 + dir * 256 + head * 64 + k2);                 \
            as[i] = *(const unsigned*)(dec + (size_t)tok * 1024 + 512 + dir * 256 + head * 64 + k2);           \
            inn[i] = invn[tok * 8 + dir * 4 + head];                                                           \
        }                                                                                                      \
        {                                                                                                      \
            const int tok = SCAN_TOK((ch) * 16 + (tid >> 4));                                                  \
            vv = rkv[(size_t)tok * 768 + 512 + head * 64 + rg * 16 + (tid & 15)];                              \
        }                                                                                                      \
    }
#define SCAN_YRED(ch)                                                                                          \
    {                                                                                                          \
        const int tl = tid >> 4, row = tid & 15;                                                               \
        const float* yp = sY + tl * 256 + (row >> 2) * 64 + (row & 3) * 16;                                    \
        const f32x4 q0 = *(const f32x4*)yp, q1 = *(const f32x4*)(yp + 4), q2 = *(const f32x4*)(yp + 8), q3 = *(const f32x4*)(yp + 12);   \
        const f32x4 qs = (q0 + q1) + (q2 + q3);                                                                \
        yout[(size_t)SCAN_TOK((ch) * 16 + tl) * 256 + head * 64 + rg * 16 + row] = (qs[0] + qs[1]) + (qs[2] + qs[3]);   \
    }
    float S0 = 0.f, S1 = 0.f, S2 = 0.f, S3 = 0.f;
    const int c = lane & 15, rloc = wave * 4 + (lane >> 4);
    __builtin_amdgcn_s_setprio(3);
    SCAN_LOAD(0);
    for (int ch = 0; ch < 272; ++ch) {
        __syncthreads();
        if (ch > 0) SCAN_YRED(ch - 1)
#pragma unroll
        for (int i = 0; i < 2; ++i) {
            float* base = sT + (tq + 8 * i) * 320 + k2;
            const float r0 = lo2f(rr[i]), r1 = hi2f(rr[i]), k0 = lo2f(kr[i]), k1 = hi2f(kr[i]);
            const float o0 = lo2f(ow[i]), o1 = hi2f(ow[i]), a0 = lo2f(as[i]), a1 = hi2f(as[i]);
            const float kk0 = k0 * kkc0 * inn[i], kk1 = k1 * kkc1 * inn[i];
            *(float2*)(base) = make_float2(1.f - o0, 1.f - o1);
            *(float2*)(base + 64) = make_float2(kk0, kk1);
            *(float2*)(base + 128) = make_float2(kk0 * a0, kk1 * a1);
            *(float2*)(base + 192) = make_float2(k0 * (1.f + (a0 - 1.f) * kac0), k1 * (1.f + (a1 - 1.f) * kac1));
            *(float2*)(base + 256) = make_float2(r0, r1);
        }
        sVv[tid] = bf2f(vv);
        __syncthreads();
        if (ch + 1 < 272) SCAN_LOAD(ch + 1);
#define SC_LD(bi, t0)                                                                                   \
    _Pragma("unroll") for (int q = 0; q < 2; ++q) {                                                     \
        const float* bp = sT + ((t0) + q) * 320 + c * 4;                                                \
        W4[bi][q] = *(const f32x4*)bp; K4[bi][q] = *(const f32x4*)(bp + 64); B4[bi][q] = *(const f32x4*)(bp + 128);   \
        D4[bi][q] = *(const f32x4*)(bp + 192); R4[bi][q] = *(const f32x4*)(bp + 256); VX[bi][q] = sVv[((t0) + q) * 16 + rloc];  \
    }
#define SC_CP(bi, t0)                                                                                   \
    _Pragma("unroll") for (int q = 0; q < 2; ++q) {                                                     \
        float sa = (S0 * K4[bi][q][0] + S1 * K4[bi][q][1]) + (S2 * K4[bi][q][2] + S3 * K4[bi][q][3]);   \
        sa = sum16(sa);                                                                                 \
        S0 = S0 * W4[bi][q][0] - sa * B4[bi][q][0] + VX[bi][q] * D4[bi][q][0];                          \
        S1 = S1 * W4[bi][q][1] - sa * B4[bi][q][1] + VX[bi][q] * D4[bi][q][1];                          \
        S2 = S2 * W4[bi][q][2] - sa * B4[bi][q][2] + VX[bi][q] * D4[bi][q][2];                          \
        S3 = S3 * W4[bi][q][3] - sa * B4[bi][q][3] + VX[bi][q] * D4[bi][q][3];                          \
        sY[((t0) + q) * 256 + tid] = (S0 * R4[bi][q][0] + S1 * R4[bi][q][1]) + (S2 * R4[bi][q][2] + S3 * R4[bi][q][3]);  \
    }
        {
            f32x4 W4[2][2], K4[2][2], B4[2][2], D4[2][2], R4[2][2]; float VX[2][2];
            SC_LD(0, 0);
#pragma unroll 1
            for (int it = 0; it < 4; ++it) {
                SC_LD(1, it * 4 + 2);
                SC_CP(0, it * 4);
                if (it < 3) SC_LD(0, it * 4 + 4);
                SC_CP(1, it * 4 + 2);
            }
        }
    }
    __syncthreads();
    SCAN_YRED(271)
#undef SC_LD
#undef SC_CP
#undef SCAN_YRED
#undef SCAN_LOAD
#undef SCAN_TOK
    __builtin_amdgcn_s_setprio(0);
}

DI void phase_mix(const Params& p, int l, char* smem, int* s_item) {
    char* ws = p.ws;
    int* ctr = (int*)(ws + O_CTL) + l;
    const bool want_ctx = l < 3;
    const int nattn = 3072 + (want_ctx ? 192 : 0);
    const int total = nattn + 2304 + (l < 3 ? 804 : 0);
    const bf16_t* naqk = (const bf16_t*)(ws + O_NAQK);
    const bf16_t* vta = (const bf16_t*)(ws + O_VTA);
    const bf16_t* gq = (const bf16_t*)(ws + O_GQ);
    const bf16_t* vtb = (const bf16_t*)(ws + O_VTB);
    const bf16_t* qc = (const bf16_t*)(ws + O_QC);
    const bf16_t* kc = (const bf16_t*)(ws + O_KC);
    const bf16_t* vtc = (const bf16_t*)(ws + O_VTC);
    bf16_t* mix = (bf16_t*)(ws + O_HBUF);
    const float* rpb = p.in[I_RPB] + (size_t)l * 4 * 465;
    {
        const int G = gridDim.x, bb = blockIdx.x;
        for (int sidx = 0; sidx < 256; ++sidx) {
            const int owner = (G == 512) ? ((sidx & 127) + (sidx >> 7) * 256) : (sidx % G);
            if (owner == bb) { for (int rep = 0; rep < REP_SCAN; ++rep) scan_item(p, l, sidx, smem); }
        }
    }
    while (true) {
        if (threadIdx.x == 0) *s_item = atomicAdd(ctr, 1);
        __syncthreads();
        const int item = *s_item;
        __syncthreads();
        if (item >= total) break;
        if (item >= nattn) { const int j = item - nattn; if (j < 2304) wconv_late(p, l, j, smem); else wconv_early(p, l + 1, j - 2304, smem); continue; }
        int type, b, h, qtok0, nkt0, qr0 = 0; bool isctx = false;
        if (item < 3072) {
            const int i1 = item;
            type = i1 >> 10;
            const int r = i1 & 1023;
            b = r >> 7; h = (r >> 5) & 3;
            const int qb = r & 31;
            qtok0 = b * TPB + 256 + qb * 128; nkt0 = 68; qr0 = qb * 2;
        } else {
            const int i2 = item - 3072;
            type = i2 >> 6;
            const int r = i2 & 63;
            b = r >> 3; h = (r >> 1) & 3;
            qtok0 = b * TPB + (r & 1) * 128; nkt0 = 4; isctx = true;
        }
        const size_t kb = (size_t)b * TPB;
        for (int rep = 0; rep < REP_ATTN; ++rep) {
            if (type == 0) {
                attn_item<96, false>(qc + (size_t)qtok0 * 384 + h * 96, 384, kc + kb * 384 + h * 96, 384, vtc + ((size_t)b * 256 + h * 64) * TPB,
                                     0, nkt0, 0, 0, mix + (size_t)qtok0 * LDH + 512 + h * 64, 0, nullptr, smem);
            } else if (type == 2 && !isctx) {
                const int st0 = clampi(qr0 - 4, 0, 56), st1 = clampi(qr0 + 1 - 4, 0, 56);
                attn_item<64, true>(naqk + (size_t)qtok0 * LDNA + h * 64, LDNA, naqk + kb * LDNA + 256 + h * 64, LDNA, vta + ((size_t)b * 256 + h * 64) * TPB,
                                    0, 4, 256 + st0 * 64, st1 + 8 - st0, mix + (size_t)qtok0 * LDH + h * 64, qr0, rpb + h * 465, smem);
            } else {
                const bf16_t *Qp, *Kp, *Vp; bf16_t* Op; int ld;
                if (type == 1) {
                    const int kvh = h >> 1;
                    Qp = gq + (size_t)qtok0 * 384 + h * 64; Kp = gq + kb * 384 + 256 + kvh * 64; Vp = vtb + ((size_t)b * 128 + kvh * 64) * TPB;
                    Op = mix + (size_t)qtok0 * LDH + 256 + h * 64; ld = 384;
                } else {
                    Qp = naqk + (size_t)qtok0 * LDNA + h * 64; Kp = naqk + kb * LDNA + 256 + h * 64; Vp = vta + ((size_t)b * 256 + h * 64) * TPB;
                    Op = mix + (size_t)qtok0 * LDH + h * 64; ld = LDNA;
                }
                attn_item<64, false>(Qp, ld, Kp, ld, Vp, 0, nkt0, 0, 0, Op, 0, nullptr, smem);
            }
        }
    }
}

DI void phase_rwkv_fin(const Params& p, int l) {
    const int tid = gtid(), lane = tid & 63, wave = tid >> 6;
    char* ws = p.ws;
    const float* yf = (const float*)(ws + O_Y);
    const float* yb = yf + (size_t)NT * 256;
    const bf16_t* rkv = (const bf16_t*)(ws + O_RKV);
    const bf16_t* dec = (const bf16_t*)(ws + O_DEC);
    const bf16_t* gate = (const bf16_t*)(ws + O_GATE);
    bf16_t* mix = (bf16_t*)(ws + O_HBUF);
    const int c = lane * 4;
    const float4 ka0 = *(const float4*)(p.in[I_KA] + (size_t)(l * 2) * 256 + c), ka1 = *(const float4*)(p.in[I_KA] + (size_t)(l * 2 + 1) * 256 + c);
    const float4 rk0 = *(const float4*)(p.in[I_RK] + (size_t)(l * 2) * 256 + c), rk1 = *(const float4*)(p.in[I_RK] + (size_t)(l * 2 + 1) * 256 + c);
    const float4 lw = *(const float4*)(p.in[I_LNW] + l * 256 + c), lb = *(const float4*)(p.in[I_LNB] + l * 256 + c);
    for (int tok = blockIdx.x * 4 + wave; tok < NT; tok += gridDim.x * 4) {
        const float4 a = *(const float4*)(yf + (size_t)tok * 256 + c), bb = *(const float4*)(yb + (size_t)tok * 256 + c);
        const float y0 = a.x + bb.x, y1 = a.y + bb.y, y2 = a.z + bb.z, y3 = a.w + bb.w;
        const float mu = sum16(y0 + y1 + y2 + y3) * (1.f / 64.f);
        const float d0 = y0 - mu, d1 = y1 - mu, d2 = y2 - mu, d3 = y3 - mu;
        const float var = sum16(d0 * d0 + d1 * d1 + d2 * d2 + d3 * d3) * (1.f / 64.f);
        const float rstd = rsqrtf(var + 64e-5f);
        const uint2 ur = *(const uint2*)(rkv + (size_t)tok * 768 + c), uk = *(const uint2*)(rkv + (size_t)tok * 768 + 256 + c), uv = *(const uint2*)(rkv + (size_t)tok * 768 + 512 + c);
        const uint2 uaf = *(const uint2*)(dec + (size_t)tok * 1024 + 512 + c), uab = *(const uint2*)(dec + (size_t)tok * 1024 + 768 + c);
        const uint2 ug = *(const uint2*)(gate + (size_t)tok * 256 + c);
        const float r0 = lo2f(ur.x), r1 = hi2f(ur.x), r2 = lo2f(ur.y), r3 = hi2f(ur.y);
        const float k0 = lo2f(uk.x), k1 = hi2f(uk.x), k2 = lo2f(uk.y), k3 = hi2f(uk.y);
        const float v0 = lo2f(uv.x), v1 = hi2f(uv.x), v2 = lo2f(uv.y), v3 = hi2f(uv.y);
        const float f0 = lo2f(uaf.x), f1 = hi2f(uaf.x), f2 = lo2f(uaf.y), f3 = hi2f(uaf.y);
        const float b0 = lo2f(uab.x), b1 = hi2f(uab.x), b2 = lo2f(uab.y), b3 = hi2f(uab.y);
        float bs = r0 * k0 * ((1.f + (f0 - 1.f) * ka0.x) * rk0.x + (1.f + (b0 - 1.f) * ka1.x) * rk1.x)
                 + r1 * k1 * ((1.f + (f1 - 1.f) * ka0.y) * rk0.y + (1.f + (b1 - 1.f) * ka1.y) * rk1.y)
                 + r2 * k2 * ((1.f + (f2 - 1.f) * ka0.z) * rk0.z + (1.f + (b2 - 1.f) * ka1.z) * rk1.z)
                 + r3 * k3 * ((1.f + (f3 - 1.f) * ka0.w) * rk0.w + (1.f + (b3 - 1.f) * ka1.w) * rk1.w);
        bs = sum16(bs);
        const float o0 = (d0 * rstd * lw.x + lb.x + bs * v0) * lo2f(ug.x);
        const float o1 = (d1 * rstd * lw.y + lb.y + bs * v1) * hi2f(ug.x);
        const float o2 = (d2 * rstd * lw.z + lb.z + bs * v2) * lo2f(ug.y);
        const float o3 = (d3 * rstd * lw.w + lb.w + bs * v3) * hi2f(ug.y);
        st4(mix + (size_t)tok * LDH + 768 + c, o0, o1, o2, o3);
    }
}

DI void phase_final(const Params& p) {
    const int tid = gtid(), lane = tid & 63, wave = tid >> 6;
    const float* g = p.in[I_FNG];
    for (int row = blockIdx.x * 4 + wave; row < NB * 4096; row += gridDim.x * 4) {
        float* x = p.out + (size_t)row * 1024;
        f32x4 v[4]; float ss = 0.f;
#pragma unroll
        for (int i = 0; i < 4; ++i) { v[i] = ((const f32x4*)x)[lane + 64 * i]; ss += v[i].x * v[i].x + v[i].y * v[i].y + v[i].z * v[i].z + v[i].w * v[i].w; }
        ss = wsum64(ss);
        const float rs = rsqrtf(ss * (1.f / 1024.f) + 1e-6f);
#pragma unroll
        for (int i = 0; i < 4; ++i) {
            const float4 g4 = ((const float4*)g)[lane + 64 * i];
            float4 o; o.x = v[i].x * rs * g4.x; o.y = v[i].y * rs * g4.y; o.z = v[i].z * rs * g4.z; o.w = v[i].w * rs * g4.w;
            ((float4*)x)[lane + 64 * i] = o;
        }
    }
}

#define XB_TMO      128
#define XB_XCNT(j)  (256  + 64 * (j))
#define XB_XSUB(j)  (1280 + 64 * (j))
#define XB_XGEN(j)  (2304 + 64 * (j))
#define XB_TOP      3328
#define XB_TOPGEN   3392
#define XCD_BAR_WORDS 3456
#define XB_SPIN_CAP (1u << 18)
#define LAS __attribute__((address_space(3)))

__device__ __forceinline__ unsigned xb_ld(unsigned* p)              { return __hip_atomic_load(p, __ATOMIC_RELAXED, __HIP_MEMORY_SCOPE_AGENT); }
__device__ __forceinline__ unsigned xb_add(unsigned* p, unsigned v) { return __hip_atomic_fetch_add(p, v, __ATOMIC_RELAXED, __HIP_MEMORY_SCOPE_AGENT); }
__device__ __forceinline__ unsigned xb_xcc_id() { return (unsigned)__builtin_amdgcn_s_getreg((3 << 11) | 20) & 0xFu; }
#define XB_SPIN(cond, bar) do { unsigned _sp = 0; while (cond) { __builtin_amdgcn_s_sleep(1); \
    if ((++_sp & 255u) == 0u) { if (xb_ld(&(bar)[XB_TMO])) break; if (_sp > XB_SPIN_CAP) { atomicAdd(&(bar)[XB_TMO], 1u); break; } } } } while (0)

struct XcdBarrier {
    unsigned* bar; unsigned x;
    volatile LAS unsigned* st;
};

__device__ __forceinline__ XcdBarrier xcd_barrier_post(unsigned* bar, volatile LAS unsigned* st) {
    XcdBarrier b; b.bar = bar; b.x = xb_xcc_id(); b.st = st;
    if (threadIdx.x == 0) (void)xb_add(&bar[XB_XCNT(b.x)], 1u);
    return b;
}
__device__ __forceinline__ void xcd_barrier_complete(unsigned* bar, unsigned x, unsigned& nloc, unsigned& nx) {
    const unsigned G = gridDim.x * gridDim.y * gridDim.z;
    unsigned sum, cnt, mine, sp = 0u;
    for (;;) {
        sum = 0u; cnt = 0u; mine = 0u;
#pragma unroll
        for (unsigned j = 0; j < 16; ++j) { const unsigned c = xb_ld(&bar[XB_XCNT(j)]); sum += c; cnt += (c > 0u) ? 1u : 0u; mine = (j == x) ? c : mine; }
        if (sum == G) break;
        __builtin_amdgcn_s_sleep(1);
        if ((++sp & 255u) == 0u) { if (xb_ld(&bar[XB_TMO])) break; if (sp > XB_SPIN_CAP) { atomicAdd(&bar[XB_TMO], 1u); break; } }
    }
    nloc = mine > 0u ? mine : 1u; nx = cnt > 0u ? cnt : 1u;
}

__device__ __forceinline__ void xcd_barrier(const XcdBarrier& b) {
    asm volatile("s_waitcnt vmcnt(0)" ::: "memory");
    __syncthreads();
    if (threadIdx.x == 0) {
        unsigned* bar = b.bar;
        __builtin_amdgcn_s_waitcnt(0);
        unsigned nloc = b.st[0], nx = b.st[1];
        if (nloc == 0u) { xcd_barrier_complete(bar, b.x, nloc, nx); b.st[0] = nloc; b.st[1] = nx; }
        const unsigned old = xb_add(&bar[XB_XSUB(b.x)], 1u);
        const unsigned gen = old / nloc;
        if (old + 1u == (gen + 1u) * nloc) {
            __builtin_amdgcn_fence(__ATOMIC_RELEASE, "agent");
            asm volatile("s_waitcnt vmcnt(0)" ::: "memory");
            const unsigned og = xb_add(&bar[XB_TOP], 1u);
            const unsigned tg = og / nx;
            if (og + 1u == (tg + 1u) * nx) xb_add(&bar[XB_TOPGEN], 1u);
            else XB_SPIN(xb_ld(&bar[XB_TOPGEN]) == tg, bar);
            __builtin_amdgcn_fence(__ATOMIC_ACQUIRE, "agent");
            xb_add(&bar[XB_XGEN(b.x)], 1u);
            asm volatile("s_waitcnt vmcnt(0)" ::: "memory");
        } else {
            XB_SPIN(xb_ld(&bar[XB_XGEN(b.x)]) == gen, bar);
            __builtin_amdgcn_fence(__ATOMIC_ACQUIRE, "agent");
            asm volatile("s_waitcnt vmcnt(0)" ::: "memory");
        }
    }
    __syncthreads();
}


__global__ void __launch_bounds__(256, 3) mega(Params p) {
    __shared__ __attribute__((aligned(16))) char smem[49152];
    __shared__ int s_item;
    __shared__ uint4 xb_words;
    cg::grid_group grid = cg::this_grid();
    if (threadIdx.x == 0) xb_words = make_uint4(0u, 0u, 0u, 0u);
    __syncthreads();
    XcdBarrier xb = xcd_barrier_post((unsigned*)(p.ws + O_CTL), (volatile LAS unsigned*)&xb_words);
    char* ws = p.ws;
    const int G = gridDim.x;
    const int pb = ((G & 7) == 0) ? ((int)(blockIdx.x & 7) * (G >> 3) + (int)(blockIdx.x >> 3)) : (int)blockIdx.x;
    float* xc = (float*)(ws + O_XC);
    bf16_t* hbuf = (bf16_t*)(ws + O_HBUF);

    phase_mod(p, smem);
    phase_wconv(p, 0, smem);
    grid.sync();
    for (int step = 0; step < 40; ++step) {
        const int l = step / 10, ph = step - l * 10;
        const float* modl = (const float*)(ws + O_MOD) + (size_t)l * 9 * 6144;
        const float* xl_src = (l == 0) ? p.in[I_X] : p.out;
        const float* xc_src = (l == 0) ? p.in[I_CTX] : xc;
        switch (ph) {
        case 0: {
            for (int rep = 0; rep < REP_EWA; ++rep) phase_norm(xl_src, xc_src, p.in[I_N1G] + l * 1024, modl, 0, 1, hbuf);
        } break;
        case 1: {
            {
                EpiIn e{(bf16_t*)(ws + O_NAQK), (bf16_t*)(ws + O_VTA), (bf16_t*)(ws + O_GQ), (bf16_t*)(ws + O_VTB), (bf16_t*)(ws + O_MLAR), (bf16_t*)(ws + O_RWR)};
                for (int rep = 0; rep < REP_GEMM; ++rep) for (int t = pb; t < 272 * 23; t += G) { int mt, nt; tile_mn(t, 23, mt, nt); gemm_tile(hbuf, LDH, (const bf16_t*)(ws + O_WIN), LDW1, 1024, mt * 128, nt * 128, smem, e); }
            }
        } break;
        case 2: {
            phase_post(p, l);
        } break;
        case 3: {
            {
                EpiUQ e1{(bf16_t*)(ws + O_QC), (const float*)(ws + O_RSM)};
                EpiUKV e2{(bf16_t*)(ws + O_KC), (bf16_t*)(ws + O_VTC), (const float*)(ws + O_RSM)};
                EpiAux e3{(bf16_t*)(ws + O_DEC), (bf16_t*)(ws + O_GATE), p.in[I_W0] + l * 512, p.in[I_A0] + l * 512};
                const bf16_t* mlar = (const bf16_t*)(ws + O_MLAR);
                for (int rep = 0; rep < REP_GEMM; ++rep) for (int t = pb; t < 272 * 17; t += G) {
                    const int mt = t / 17, j = t % 17;
                    if (j < 3) gemm_tile(mlar, 416, (const bf16_t*)(ws + O_WUQ), 256, 256, mt * 128, j * 128, smem, e1);
                    else if (j < 7) gemm_tile(mlar + 256, 416, (const bf16_t*)(ws + O_WUKV), 128, 128, mt * 128, (j - 3) * 128, smem, e2);
                    else {
                        const int n0 = (j - 7) * 128, blk = n0 >> 8;
                        if (blk < 4) {
                            gemm_tile(hbuf + blk * 64, 448, (const bf16_t*)(ws + O_WAUX) + (size_t)blk * 256 * 64 - (size_t)(blk * 256) * 64, 64, 64, mt * 128, n0, smem, e3);
                        } else {
                            gemm_tile(hbuf + 256, 448, (const bf16_t*)(ws + O_WG2) - (size_t)1024 * 192, 192, 192, mt * 128, n0, smem, e3);
                        }
                    }
                }
            }
        } break;
        case 4: {
            phase_mix(p, l, smem, &s_item);
        } break;
        case 5: {
            for (int rep = 0; rep < REP_EW; ++rep) phase_rwkv_fin(p, l);
        } break;
        case 6: {
            {
                EpiRes e{xl_src, xc_src, p.out, xc, modl + 2 * 1024};
                for (int t = pb; t < 272 * 8; t += G) { int mt, nt; tile_mn(t, 8, mt, nt); if (l == 3 && (mt % 34) < 2) continue;
                    gemm_tile(hbuf, LDH, (const bf16_t*)(ws + O_WOUT), LDW1, 1024, mt * 128, nt * 128, smem, e); }
            }
        } break;
        case 7: {
            for (int rep = 0; rep < REP_EW; ++rep) phase_norm(p.out, xc, p.in[I_N2G] + l * 1024, modl, 3, 4, hbuf);
        } break;
        case 8: {
            {
                EpiFc1 e{(bf16_t*)(ws + O_HID)};
                for (int rep = 0; rep < REP_GEMM; ++rep) for (int t = pb; t < 272 * 32; t += G) { int mt, nt; tile_mn(t, 32, mt, nt); if (l == 3 && (mt % 34) < 2) continue;
                    gemm_tile(hbuf, LDH, (const bf16_t*)(ws + O_WFC1), LDW1, 1024, mt * 128, nt * 128, smem, e); }
            }
        } break;
        case 9: {
            {
                EpiRes e{p.out, xc, p.out, xc, modl + 5 * 1024};
                for (int t = pb; t < 272 * 8; t += G) { int mt, nt; tile_mn(t, 8, mt, nt); if (l == 3 && (mt % 34) < 2) continue;
                    gemm_tile((const bf16_t*)(ws + O_HID), LDHID, (const bf16_t*)(ws + O_WFC2), LDW4, 4096, mt * 128, nt * 128, smem, e); }
            }
        } break;
        }
        for (int rep = 0; rep < REP_SYNC; ++rep) xcd_barrier(xb);
    }
    phase_final(p);
}

extern "C" void kernel_launch(void* const* d_in, const int* in_sizes, int n_in, void* d_out, int out_size, void* d_ws, size_t ws_size, hipStream_t stream) {
    static int grid_blocks = 0;
    if (n_in != 31 || ws_size < O_END) { fprintf(stderr, "kernel_launch: bad n_in %d or ws_size %zu < %zu\n", n_in, ws_size, (size_t)O_END); return; }
    if (!grid_blocks) {
        int dev = 0, cus = 0, per_cu = 0;
        hipGetDevice(&dev);
        hipDeviceGetAttribute(&cus, hipDeviceAttributeMultiprocessorCount, dev);
        hipOccupancyMaxActiveBlocksPerMultiprocessor(&per_cu, mega, 256, 0);
        if (per_cu > 3) per_cu = 3;
        if (per_cu < 1) per_cu = 1;
        grid_blocks = cus * per_cu;
    }
    Params p{};
    for (int i = 0; i < 31; ++i) p.in[i] = (const float*)d_in[i];
    p.out = (float*)d_out;
    p.ws = (char*)d_ws;
    (void)hipMemsetAsync(d_ws, 0, 16384, stream);
    void* args[] = {&p};
    hipError_t e = hipLaunchCooperativeKernel((void*)mega, dim3(grid_blocks), dim3(256), args, 0, stream);
    if (e != hipSuccess) fprintf(stderr, "cooperative launch failed: %s (grid %d)\n", hipGetErrorString(e), grid_blocks);
}
```

```cpp
#include <hip/hip_runtime.h>
#include <hip/hip_cooperative_groups.h>
#include <stdint.h>
#include <stdio.h>
namespace cg = cooperative_groups;
#ifndef REP_GEMM
#define REP_GEMM 1
#endif
#ifndef REP_ATTN
#define REP_ATTN 1
#endif
#ifndef REP_EW
#define REP_EW 1
#endif
#ifndef REP_SYNC
#define REP_SYNC 1
#endif
#ifndef REP_EWA
#define REP_EWA 1
#endif
#ifndef REP_SCAN
#define REP_SCAN 1
#endif

#define DI __device__ __forceinline__
typedef unsigned short bf16_t;
typedef short bf16x8 __attribute__((ext_vector_type(8)));
typedef short bf16x4 __attribute__((ext_vector_type(4)));
typedef float f32x4 __attribute__((ext_vector_type(4)));
typedef unsigned u32x4 __attribute__((ext_vector_type(4)));

constexpr int NB = 8, TPB = 4352, NT = NB * TPB;
constexpr int INC = 2880, INP = 2944;
constexpr int LDH = 1088, LDHID = 4160, LDW1 = 1088, LDW4 = 4160, LDNA = 576;
constexpr float LOG2E = 1.4426950408889634f;
constexpr float QS64 = 0.125f * LOG2E;
constexpr float QS96 = 0.10206207261596577f * LOG2E;
constexpr float ROPE_L2T = 13.287712379549449f;

constexpr size_t al(size_t x) { return (x + 255) & ~size_t(255); }
constexpr size_t O_CTL = 0;
constexpr size_t O_MOD = 16384;
constexpr size_t O_XC = O_MOD + al((size_t)4 * 9 * 6144 * 4);
constexpr size_t O_WIN = O_XC + al((size_t)2048 * 1024 * 4);
constexpr size_t O_WOUT = O_WIN + al((size_t)INP * LDW1 * 2);
constexpr size_t O_WFC1 = O_WOUT + al((size_t)1024 * LDW1 * 2);
constexpr size_t O_WFC2 = O_WFC1 + al((size_t)4096 * LDW1 * 2);
constexpr size_t O_WUQ = O_WFC2 + al((size_t)1024 * LDW4 * 2);
constexpr size_t O_WUKV = O_WUQ + al((size_t)384 * 256 * 2);
constexpr size_t O_WAUX = O_WUKV + al((size_t)512 * 128 * 2);
constexpr size_t O_WG2 = O_WAUX + al((size_t)4 * 256 * 64 * 2);
constexpr size_t O_HBUF = O_WG2 + al((size_t)256 * 192 * 2);
constexpr size_t O_BIG = O_HBUF + al((size_t)NT * LDH * 2);
constexpr size_t O_NAQK = O_BIG;
constexpr size_t O_VTA = O_NAQK + al((size_t)NT * LDNA * 2);
constexpr size_t O_GQ = O_VTA + al((size_t)NB * 256 * TPB * 2);
constexpr size_t O_VTB = O_GQ + al((size_t)NT * 384 * 2);
constexpr size_t O_MLAR = O_VTB + al((size_t)NB * 128 * TPB * 2);
constexpr size_t O_RWR = O_MLAR + al((size_t)NT * 416 * 2);
constexpr size_t O_QC = O_RWR + al((size_t)NT * 1184 * 2);
constexpr size_t O_KC = O_QC + al((size_t)NT * 384 * 2);
constexpr size_t O_VTC = O_KC + al((size_t)NT * 384 * 2);
constexpr size_t O_RKV = O_VTC + al((size_t)NB * 256 * TPB * 2);
constexpr size_t O_DEC = O_RKV + al((size_t)NT * 768 * 2);
constexpr size_t O_GATE = O_DEC + al((size_t)NT * 1024 * 2);
constexpr size_t O_INVN = O_GATE + al((size_t)NT * 256 * 2);
constexpr size_t O_RSM = O_INVN + al((size_t)NT * 8 * 4);
constexpr size_t O_END = O_RSM + al((size_t)NT * 2 * 4);
constexpr size_t O_HID = O_BIG;
constexpr size_t O_Y = O_RWR;
static_assert(O_HID + (size_t)NT * LDHID * 2 <= O_END, "hidden overlay");
static_assert(O_END <= (size_t)512 * 1024 * 1024, "workspace");
static_assert((size_t)2 * NT * 256 * 4 <= (size_t)NT * 1184 * 2, "y overlay");

struct Params {
    const float* in[31];
    float* out;
    char* ws;
};

enum { I_X = 0, I_C, I_CTX, I_CCTX, I_WMOD, I_BMOD, I_N1G, I_N2G, I_WIN, I_SHIFT, I_RPB, I_GQN, I_GKN, I_MQN, I_MKVN, I_WUQ, I_WUKV,
       I_W0, I_W2, I_A0, I_A2, I_KK, I_KA, I_RK, I_G2, I_LNW, I_LNB, I_WOUT, I_FC1, I_FC2, I_FNG };

typedef __bf16 hwbf16x2 __attribute__((ext_vector_type(2)));
typedef float f32x2 __attribute__((ext_vector_type(2)));
DI unsigned pk2(float a, float b) { f32x2 v = {a, b}; hwbf16x2 r = __builtin_convertvector(v, hwbf16x2); return __builtin_bit_cast(unsigned, r); }
DI bf16_t f2bf(float x) { return (bf16_t)(pk2(x, x) & 0xffffu); }
DI float bf2f(bf16_t b) { return __uint_as_float(((unsigned)b) << 16); }
DI float lo2f(unsigned u) { return __uint_as_float(u << 16); }
DI float hi2f(unsigned u) { return __uint_as_float(u & 0xffff0000u); }
DI void st4(bf16_t* p, float a, float b, float c, float d) { uint2 u; u.x = pk2(a, b); u.y = pk2(c, d); *(uint2*)p = u; }
template <int CTRL> DI float dppf(float v) { return __int_as_float(__builtin_amdgcn_update_dpp(0, __float_as_int(v), CTRL, 0xF, 0xF, true)); }
DI float sum16(float v) { v += dppf<0xB1>(v); v += dppf<0x4E>(v); v += dppf<0x141>(v); v += dppf<0x140>(v); return v; }
DI float wsum64(float v) { v = sum16(v); v += __shfl_xor(v, 16); v += __shfl_xor(v, 32); return v; }
DI float sigm(float x) { return 1.f / (1.f + __expf(-x)); }
DI int gtid() { int t = threadIdx.x; asm volatile("" : "+v"(t)); return t; }
DI int clampi(int v, int lo, int hi) { return v < lo ? lo : (v > hi ? hi : v); }

template <class T> struct IsRes;
template <class T> struct HasRS;
template <class Epi>
DI void gemm_tile(const bf16_t* __restrict__ A, int lda, const bf16_t* __restrict__ Bt, int ldb, int K, int m0, int n0, char* smem, const Epi& epi) {
    char* sA = smem;
    char* sB = smem + 16384;
    const int tid = gtid(), lane = tid & 63, wave = tid >> 6;
    const int wm = wave >> 1, wn = wave & 1, l15 = lane & 15, quad = lane >> 4;
    f32x4 acc[4][4];
#pragma unroll
    for (int i = 0; i < 4; ++i)
#pragma unroll
        for (int j = 0; j < 4; ++j) acc[i][j] = (f32x4){0.f, 0.f, 0.f, 0.f};
    const int srow = lane >> 3, skc = (lane & 7) ^ (lane >> 3);
    const bf16_t* Ag = A + (size_t)(m0 + wave * 8 + srow) * lda + skc * 8;
    const bf16_t* Bg = Bt + (size_t)(n0 + wave * 8 + srow) * ldb + skc * 8;
    const size_t a32 = (size_t)32 * lda, b32 = (size_t)32 * ldb;
    const int sw = l15 & 7;
    for (int k0 = 0; k0 < K; k0 += 64) {
        __syncthreads();
#pragma unroll
        for (int i = 0; i < 4; ++i) {
            __builtin_amdgcn_global_load_lds((const unsigned*)(Ag + i * a32 + k0), (__attribute__((address_space(3))) unsigned*)(sA + (i * 4 + wave) * 1024), 16, 0, 0);
            __builtin_amdgcn_global_load_lds((const unsigned*)(Bg + i * b32 + k0), (__attribute__((address_space(3))) unsigned*)(sB + (i * 4 + wave) * 1024), 16, 0, 0);
        }
        asm volatile("s_waitcnt vmcnt(0)" ::: "memory");
        __syncthreads();
#pragma unroll
        for (int ks = 0; ks < 2; ++ks) {
            bf16x8 wf[4], xf[4];
            const int co = ((ks * 4 + quad) ^ sw) * 16;
#pragma unroll
            for (int t = 0; t < 4; ++t) {
                wf[t] = *(const bf16x8*)(sB + (wn * 64 + t * 16 + l15) * 128 + co);
                xf[t] = *(const bf16x8*)(sA + (wm * 64 + t * 16 + l15) * 128 + co);
            }
#pragma unroll
            for (int nt = 0; nt < 4; ++nt)
#pragma unroll
                for (int mt = 0; mt < 4; ++mt) acc[nt][mt] = __builtin_amdgcn_mfma_f32_16x16x32_bf16(wf[nt], xf[mt], acc[nt][mt], 0, 0, 0);
        }
    }
    if constexpr (IsRes<Epi>::value) {
#pragma unroll
        for (int nt = 0; nt < 4; ++nt) {
            f32x4 xv[4], gv[4];
#pragma unroll
            for (int mt = 0; mt < 4; ++mt) epi.loadxg(m0 + wm * 64 + mt * 16 + l15, n0 + wn * 64 + nt * 16 + quad * 4, xv[mt], gv[mt]);
#pragma unroll
            for (int mt = 0; mt < 4; ++mt) epi.storex(m0 + wm * 64 + mt * 16 + l15, n0 + wn * 64 + nt * 16 + quad * 4, xv[mt], gv[mt], acc[nt][mt]);
        }
    } else if constexpr (HasRS<Epi>::value) {
        float rs4[4];
#pragma unroll
        for (int mt = 0; mt < 4; ++mt) rs4[mt] = epi.rowscale(m0 + wm * 64 + mt * 16 + l15);
#pragma unroll
        for (int nt = 0; nt < 4; ++nt)
#pragma unroll
            for (int mt = 0; mt < 4; ++mt) epi.apply(m0 + wm * 64 + mt * 16 + l15, n0 + wn * 64 + nt * 16 + quad * 4, acc[nt][mt], rs4[mt]);
    } else {
#pragma unroll
        for (int nt = 0; nt < 4; ++nt)
#pragma unroll
            for (int mt = 0; mt < 4; ++mt) epi(m0 + wm * 64 + mt * 16 + l15, n0 + wn * 64 + nt * 16 + quad * 4, acc[nt][mt]);
    }
}

DI void tile_mn(int t, int nn, int& mt, int& nt) { const int sup = t / (8 * nn), tin = t - sup * 8 * nn; mt = sup * 8 + (tin & 7); nt = tin >> 3; }

struct EpiIn {
    bf16_t *naqk, *vta, *gq, *vtb, *mlar, *rwr;
    DI void operator()(int m, int n, f32x4 v) const {
        if (n >= INC) return;
        if (n < 512) {
            const float s = (n < 256) ? QS64 : 1.f;
            st4(naqk + (size_t)m * LDNA + n, v[0] * s, v[1] * s, v[2] * s, v[3] * s);
        } else if (n < 768) {
            const int b = m / TPB, tib = m - b * TPB;
            bf16_t* d = vta + ((size_t)b * 256 + (n - 512)) * TPB + tib;
            d[0] = f2bf(v[0]); d[TPB] = f2bf(v[1]); d[2 * TPB] = f2bf(v[2]); d[3 * TPB] = f2bf(v[3]);
        } else if (n < 1152) {
            st4(gq + (size_t)m * 384 + (n - 768), v[0], v[1], v[2], v[3]);
        } else if (n < 1280) {
            const int b = m / TPB, tib = m - b * TPB;
            bf16_t* d = vtb + ((size_t)b * 128 + (n - 1152)) * TPB + tib;
            d[0] = f2bf(v[0]); d[TPB] = f2bf(v[1]); d[2 * TPB] = f2bf(v[2]); d[3 * TPB] = f2bf(v[3]);
        } else if (n < 1696) {
            st4(mlar + (size_t)m * 416 + (n - 1280), v[0], v[1], v[2], v[3]);
        } else {
            st4(rwr + (size_t)m * 1184 + (n - 1696), v[0], v[1], v[2], v[3]);
        }
    }
};

DI void rope_rot(float& a, float& b, int pos, float fidx, float fscale) {
    const float ang = (float)pos * __builtin_amdgcn_exp2f(-fidx * fscale);
    const float c = __cosf(ang), s = __sinf(ang);
    const float a2 = a * c - b * s, b2 = a * s + b * c;
    a = a2; b = b2;
}

struct EpiUQ {
    bf16_t* qc; const float* rsm;
    DI float rowscale(int m) const { return rsm[m * 2] * QS96; }
    DI void operator()(int m, int n, f32x4 v) const { apply(m, n, v, rowscale(m)); }
    DI void apply(int m, int n, f32x4 v, float rs) const {
        float a = v[0] * rs, b = v[1] * rs, c = v[2] * rs, d = v[3] * rs;
        const int h = n / 96, dd = n - h * 96;
        const int bb = m / TPB, tib = m - bb * TPB;
        if (dd >= 64 && tib >= 256) {
            const int t = tib - 256, row = t >> 6, col = t & 63;
            const int i0 = (dd - 64) >> 1, i1 = i0 + 1;
            rope_rot(a, b, i0 < 8 ? row : col, (float)(i0 & 7), ROPE_L2T / 8.f);
            rope_rot(c, d, i1 < 8 ? row : col, (float)(i1 & 7), ROPE_L2T / 8.f);
        }
        st4(qc + (size_t)m * 384 + n, a, b, c, d);
    }
};
struct EpiUKV {
    bf16_t *kc, *vtc; const float* rsm;
    DI float rowscale(int m) const { return rsm[m * 2 + 1]; }
    DI void operator()(int m, int n, f32x4 v) const { apply(m, n, v, rowscale(m)); }
    DI void apply(int m, int n, f32x4 v, float rs) const {
        const int h = n >> 7, dd = n & 127;
        if (dd < 64) {
            st4(kc + (size_t)m * 384 + h * 96 + dd, v[0] * rs, v[1] * rs, v[2] * rs, v[3] * rs);
        } else {
            const int b = m / TPB, tib = m - b * TPB;
            bf16_t* d = vtc + ((size_t)b * 256 + h * 64 + (dd - 64)) * TPB + tib;
            d[0] = f2bf(v[0] * rs); d[TPB] = f2bf(v[1] * rs); d[2 * TPB] = f2bf(v[2] * rs); d[3 * TPB] = f2bf(v[3] * rs);
        }
    }
};
struct EpiAux {
    bf16_t *dec, *gate; const float *w0, *a0;
    DI void operator()(int m, int n, f32x4 v) const {
        const int j = n >> 8, c = n & 255;
        float o[4];
        if (j < 2) {
#pragma unroll
            for (int r = 0; r < 4; ++r) {
                const float u = w0[j * 256 + c + r] + v[r];
                const float z = -u;
                const float sp = fmaxf(z, 0.f) + __logf(1.f + __expf(-fabsf(z)));
                const float w = -sp - 0.5f;
                const float e = __expf(w);
                o[r] = 1.f - __expf(-e);
            }
            st4(dec + (size_t)m * 1024 + j * 256 + c, o[0], o[1], o[2], o[3]);
        } else if (j < 4) {
#pragma unroll
            for (int r = 0; r < 4; ++r) o[r] = sigm(a0[(j - 2) * 256 + c + r] + v[r]);
            st4(dec + (size_t)m * 1024 + 512 + (j - 2) * 256 + c, o[0], o[1], o[2], o[3]);
        } else {
            st4(gate + (size_t)m * 256 + c, v[0], v[1], v[2], v[3]);
        }
    }
};
struct EpiRes {
    const float *srcl, *srcc; float *dstl, *dstc; const float* modg;
    DI void loadxg(int m, int n, f32x4& x, f32x4& g) const {
        const int b = m / TPB, tib = m - b * TPB;
        const float* s; int mr;
        if (tib < 256) { s = srcc + ((size_t)b * 256 + tib) * 1024 + n; mr = 8; }
        else { s = srcl + ((size_t)b * 4096 + (tib - 256)) * 1024 + n; mr = b; }
        g = *(const f32x4*)(modg + mr * 6144 + n);
        x = *(const f32x4*)s;
    }
    DI void storex(int m, int n, const f32x4& x, const f32x4& g, f32x4 v) const {
        const int b = m / TPB, tib = m - b * TPB;
        float* d = (tib < 256) ? dstc + ((size_t)b * 256 + tib) * 1024 + n : dstl + ((size_t)b * 4096 + (tib - 256)) * 1024 + n;
        *(f32x4*)d = x + g * v;
    }
    DI void operator()(int m, int n, f32x4 v) const { f32x4 x, g; loadxg(m, n, x, g); storex(m, n, x, g, v); }
};
template <class T> struct IsRes { static constexpr bool value = false; };
template <class T> struct HasRS { static constexpr bool value = false; };
template <> struct HasRS<EpiUQ> { static constexpr bool value = true; };
template <> struct HasRS<EpiUKV> { static constexpr bool value = true; };
template <> struct IsRes<EpiRes> { static constexpr bool value = true; };
struct EpiFc1 {
    bf16_t* hid;
    DI void operator()(int m, int n, f32x4 v) const {
        float a = fmaxf(v[0], 0.f), b = fmaxf(v[1], 0.f), c = fmaxf(v[2], 0.f), d = fmaxf(v[3], 0.f);
        st4(hid + (size_t)m * LDHID + n, a * a, b * b, c * c, d * d);
    }
};

DI void phase_mod(const Params& p, char* smem) {
    float* sc = (float*)smem;
    float* red = sc + 9 * 1024;
    const int tid = gtid(), lane = tid & 63, wave = tid >> 6;
    for (int i = tid; i < 9 * 1024; i += 256) { const float v = (i < 8192) ? p.in[I_C][i] : p.in[I_CCTX][i - 8192]; sc[i] = v / (1.f + __expf(-v)); }
    __syncthreads();
    float* mod = (float*)(p.ws + O_MOD);
    for (int item = blockIdx.x; item < 4 * 96; item += gridDim.x) {
        const int l = item / 96, nb = (item % 96) * 64;
        const float* w = p.in[I_WMOD] + (size_t)l * 1024 * 6144 + nb + lane;
        float acc[9];
#pragma unroll
        for (int r = 0; r < 9; ++r) acc[r] = 0.f;
#pragma unroll 8
        for (int k = wave * 256; k < wave * 256 + 256; ++k) {
            const float wv = w[(size_t)k * 6144];
#pragma unroll
            for (int r = 0; r < 9; ++r) acc[r] += sc[r * 1024 + k] * wv;
        }
#pragma unroll
        for (int r = 0; r < 9; ++r) red[(wave * 9 + r) * 64 + lane] = acc[r];
        __syncthreads();
        for (int i = tid; i < 9 * 64; i += 256) {
            const int r = i >> 6, ln = i & 63;
            const float s = red[(0 * 9 + r) * 64 + ln] + red[(1 * 9 + r) * 64 + ln] + red[(2 * 9 + r) * 64 + ln] + red[(3 * 9 + r) * 64 + ln];
            mod[((size_t)l * 9 + r) * 6144 + nb + ln] = s + p.in[I_BMOD][l * 6144 + nb + ln];
        }
        __syncthreads();
    }
}

DI void wconv_tile(const float* src, const float* g, int K, int N, bf16_t* dst, int nkt, int ldd, int t, char* smem) {
    float* tile = (float*)smem;
    const int tid = gtid();
    const int kt = t % nkt, nt = t / nkt, k0 = kt * 64, n0 = nt * 64;
    __syncthreads();
#pragma unroll 4
    for (int i = 0; i < 16; ++i) {
        const int kl = (tid >> 6) + 4 * i, nl = tid & 63, k = k0 + kl, n = n0 + nl;
        float v = 0.f;
        if (k < K && n < N) { v = src[(size_t)k * N + n]; if (g) v *= g[k]; }
        tile[kl * 65 + nl] = v;
    }
    __syncthreads();
#pragma unroll 4
    for (int i = 0; i < 8; ++i) {
        const int nl = (tid >> 5) + 8 * i, kl = (tid & 31) * 2;
        *(unsigned*)(dst + (size_t)(n0 + nl) * ldd + k0 + kl) = pk2(tile[kl * 65 + nl], tile[(kl + 1) * 65 + nl]);
    }
}
DI void wconv(const float* src, const float* g, int K, int N, bf16_t* dst, int Kp, int Np, int ldd, int rot, char* smem) {
    const int nkt = Kp / 64, nnt = Np / 64, G = gridDim.x;
    for (int t = (blockIdx.x + G - (rot % G)) % G; t < nkt * nnt; t += G) wconv_tile(src, g, K, N, dst, nkt, ldd, t, smem);
}
DI void wconv_late(const Params& p, int l, int u, char* smem) {
    char* ws = p.ws;
    if (u < 1024) wconv_tile(p.in[I_FC1] + (size_t)l * 1024 * 4096, nullptr, 1024, 4096, (bf16_t*)(ws + O_WFC1), 16, LDW1, u, smem);
    else if (u < 2048) wconv_tile(p.in[I_FC2] + (size_t)l * 4096 * 1024, nullptr, 4096, 1024, (bf16_t*)(ws + O_WFC2), 64, LDW4, u - 1024, smem);
    else wconv_tile(p.in[I_WOUT] + (size_t)l * 1024 * 1024, nullptr, 1024, 1024, (bf16_t*)(ws + O_WOUT), 16, LDW1, u - 2048, smem);
}
DI void wconv_early(const Params& p, int l, int u, char* smem) {
    char* ws = p.ws;
    if (u < 736) wconv_tile(p.in[I_WIN] + (size_t)l * 1024 * INC, nullptr, 1024, INC, (bf16_t*)(ws + O_WIN), 16, LDW1, u, smem);
    else if (u < 760) wconv_tile(p.in[I_WUQ] + (size_t)l * 256 * 384, p.in[I_MQN] + l * 256, 256, 384, (bf16_t*)(ws + O_WUQ), 4, 256, u - 736, smem);
    else if (u < 776) wconv_tile(p.in[I_WUKV] + (size_t)l * 128 * 512, p.in[I_MKVN] + l * 128, 128, 512, (bf16_t*)(ws + O_WUKV), 2, 128, u - 760, smem);
    else if (u < 792) {
        const int v = u - 776, j = v >> 2, d = j & 1;
        const float* src = (j < 2 ? p.in[I_W2] : p.in[I_A2]) + (size_t)(l * 2 + d) * 64 * 256;
        wconv_tile(src, nullptr, 64, 256, (bf16_t*)(ws + O_WAUX) + (size_t)j * 256 * 64, 1, 64, v & 3, smem);
    } else wconv_tile(p.in[I_G2] + (size_t)l * 160 * 256, nullptr, 160, 256, (bf16_t*)(ws + O_WG2), 3, 192, u - 792, smem);
}

DI void phase_wconv(const Params& p, int l, char* smem) {
    char* ws = p.ws;
    wconv(p.in[I_WIN] + (size_t)l * 1024 * INC, nullptr, 1024, INC, (bf16_t*)(ws + O_WIN), 1024, INP, LDW1, 0, smem);
    wconv(p.in[I_WUQ] + (size_t)l * 256 * 384, p.in[I_MQN] + l * 256, 256, 384, (bf16_t*)(ws + O_WUQ), 256, 384, 256, 3040, smem);
    wconv(p.in[I_WUKV] + (size_t)l * 128 * 512, p.in[I_MKVN] + l * 128, 128, 512, (bf16_t*)(ws + O_WUKV), 128, 512, 128, 3064, smem);
    for (int d = 0; d < 2; ++d) {
        wconv(p.in[I_W2] + (size_t)(l * 2 + d) * 64 * 256, nullptr, 64, 256, (bf16_t*)(ws + O_WAUX) + d * 256 * 64, 64, 256, 64, 3080 + d * 4, smem);
        wconv(p.in[I_A2] + (size_t)(l * 2 + d) * 64 * 256, nullptr, 64, 256, (bf16_t*)(ws + O_WAUX) + (2 + d) * 256 * 64, 64, 256, 64, 3088 + d * 4, smem);
    }
    wconv(p.in[I_G2] + (size_t)l * 160 * 256, nullptr, 160, 256, (bf16_t*)(ws + O_WG2), 192, 256, 192, 3096, smem);
}

DI void phase_norm(const float* xl, const float* xc, const float* g, const float* modl, int shi, int sci, bf16_t* dst) {
    const int tid = gtid(), lane = tid & 63, wave = tid >> 6;
    for (int tok = blockIdx.x * 4 + wave; tok < NT; tok += gridDim.x * 4) {
        const int b = tok / TPB, tib = tok - b * TPB;
        const float* row; int mr;
        if (tib < 256) { row = xc + ((size_t)b * 256 + tib) * 1024; mr = 8; } else { row = xl + ((size_t)b * 4096 + tib - 256) * 1024; mr = b; }
        const float* sh = modl + mr * 6144 + shi * 1024;
        const float* sc = modl + mr * 6144 + sci * 1024;
        f32x4 v[4]; float ss = 0.f;
#pragma unroll
        for (int i = 0; i < 4; ++i) { v[i] = ((const f32x4*)row)[lane + 64 * i]; ss += v[i].x * v[i].x + v[i].y * v[i].y + v[i].z * v[i].z + v[i].w * v[i].w; }
        ss = wsum64(ss);
        const float rs = rsqrtf(ss * (1.f / 1024.f) + 1e-6f);
#pragma unroll
        for (int i = 0; i < 4; ++i) {
            const int c = (lane + 64 * i) * 4;
            const float4 g4 = *(const float4*)(g + c), s4 = *(const float4*)(sc + c), h4 = *(const float4*)(sh + c);
            st4(dst + (size_t)tok * LDH + c, v[i].x * rs * g4.x * (1.f + s4.x) + h4.x, v[i].y * rs * g4.y * (1.f + s4.y) + h4.y,
                v[i].z * rs * g4.z * (1.f + s4.z) + h4.z, v[i].w * rs * g4.w * (1.f + s4.w) + h4.w);
        }
    }
}

DI void phase_post(const Params& p, int l) {
    const int tid = gtid(), lane = tid & 63, wave = tid >> 6;
    char* ws = p.ws;
    bf16_t* gq = (bf16_t*)(ws + O_GQ);
    const bf16_t* mlar = (const bf16_t*)(ws + O_MLAR);
    bf16_t* kc = (bf16_t*)(ws + O_KC);
    float* rsm = (float*)(ws + O_RSM);
    const bf16_t* rwr = (const bf16_t*)(ws + O_RWR);
    bf16_t* rkv = (bf16_t*)(ws + O_RKV);
    bf16_t* acat = (bf16_t*)(ws + O_HBUF);
    float* invn = (float*)(ws + O_INVN);
    const float* gqn = p.in[I_GQN] + l * 64;
    const float* gkn = p.in[I_GKN] + l * 64;
    const float* taps = p.in[I_SHIFT] + (size_t)l * 3 * 1184;
    const float* kkw = p.in[I_KK] + (size_t)l * 512;
    for (int tok = blockIdx.x * 4 + wave; tok < NT; tok += gridDim.x * 4) {
        const int b = tok / TPB, tib = tok - b * TPB;
        const bool lat = tib >= 256;
        const int t = tib - 256, prow = t >> 6, pcol = t & 63;
        unsigned gqu[3];
#pragma unroll
        for (int it = 0; it < 3; ++it) gqu[it] = *(const unsigned*)(gq + (size_t)tok * 384 + (it * 2 + (lane >> 5)) * 64 + (lane & 31) * 2);
        const bf16_t* mr = mlar + (size_t)tok * 416;
        const uint2 uq = *(const uint2*)(mr + lane * 4);
        const unsigned ukv = *(const unsigned*)(mr + 256 + lane * 2);
        const unsigned ukr = *(const unsigned*)(mr + 384 + (lane & 15) * 2);
        {
            const int pair = lane & 31;
#pragma unroll
            for (int it = 0; it < 3; ++it) {
                const int head = it * 2 + (lane >> 5);
                unsigned* ptr = (unsigned*)(gq + (size_t)tok * 384 + head * 64 + pair * 2);
                const unsigned u = gqu[it];
                float x1 = lo2f(u), x2 = hi2f(u);
                float ss = x1 * x1 + x2 * x2;
                ss += __shfl_xor(ss, 1); ss += __shfl_xor(ss, 2); ss += __shfl_xor(ss, 4); ss += __shfl_xor(ss, 8); ss += __shfl_xor(ss, 16);
                const float rs = rsqrtf(ss * (1.f / 64.f) + 1e-6f);
                const float* gg = head < 4 ? gqn : gkn;
                x1 *= rs * gg[pair * 2]; x2 *= rs * gg[pair * 2 + 1];
                if (lat) rope_rot(x1, x2, pair < 16 ? prow : pcol, (float)(pair & 15), ROPE_L2T / 16.f);
                if (head < 4) { x1 *= QS64; x2 *= QS64; }
                *ptr = pk2(x1, x2);
            }
        }
        {
            float a0 = lo2f(uq.x), a1 = hi2f(uq.x), a2 = lo2f(uq.y), a3 = hi2f(uq.y);
            float sq = wsum64(a0 * a0 + a1 * a1 + a2 * a2 + a3 * a3);
            float c0 = lo2f(ukv), c1 = hi2f(ukv);
            float sk = wsum64(c0 * c0 + c1 * c1);
            if (lane == 0) { rsm[tok * 2] = rsqrtf(sq * (1.f / 256.f) + 1e-6f); rsm[tok * 2 + 1] = rsqrtf(sk * (1.f / 128.f) + 1e-6f); }
            if (lane < 16) {
                const unsigned u = ukr;
                float x1 = lo2f(u), x2 = hi2f(u);
                if (lat) rope_rot(x1, x2, lane < 8 ? prow : pcol, (float)(lane & 7), ROPE_L2T / 8.f);
                const unsigned o = pk2(x1, x2);
#pragma unroll
                for (int h = 0; h < 4; ++h) *(unsigned*)(kc + (size_t)tok * 384 + h * 96 + 64 + lane * 2) = o;
            }
        }
        {
            const bool hasp = (tib != 0) && (tib != 256);
            const bool hasn = (tib != 255) && (tib != TPB - 1);
            const bf16_t* r0 = rwr + (size_t)tok * 1184;
#pragma unroll
            for (int hb = 0; hb < 5; ++hb) {
            unsigned X0[2], X1[2], X2[2];
#pragma unroll
            for (int ii = 0; ii < 2; ++ii) {
                const int c = (lane + 64 * (hb * 2 + ii)) * 2;
                X0[ii] = 0u; X1[ii] = 0u; X2[ii] = 0u;
                if (c < 1184) {
                    X1[ii] = *(const unsigned*)(r0 + c);
                    if (hasp) X0[ii] = *(const unsigned*)(r0 + c - 1184);
                    if (hasn) X2[ii] = *(const unsigned*)(r0 + c + 1184);
                }
            }
#pragma unroll
            for (int ii = 0; ii < 2; ++ii) {
                const int i = hb * 2 + ii;
                const int c = (lane + 64 * i) * 2;
                float u0 = 0.f, u1 = 0.f;
                if (c < 1184) {
                    const float2 t1 = *(const float2*)(taps + 1184 + c);
                    u0 = lo2f(X1[ii]) * t1.x; u1 = hi2f(X1[ii]) * t1.y;
                    if (hasp) { const float2 t0 = *(const float2*)(taps + c); u0 += lo2f(X0[ii]) * t0.x; u1 += hi2f(X0[ii]) * t0.y; }
                    if (hasn) { const float2 t2 = *(const float2*)(taps + 2 * 1184 + c); u0 += lo2f(X2[ii]) * t2.x; u1 += hi2f(X2[ii]) * t2.y; }
                }
                if (i < 6) {
                    const unsigned pk = pk2(u0, u1);
                    *(unsigned*)(rkv + (size_t)tok * 768 + c) = pk;
                    if (i == 2 || i == 3) {
                        const float k0 = lo2f(pk), k1 = hi2f(pk);
                        const float2 f0 = *(const float2*)(kkw + c - 256), f1 = *(const float2*)(kkw + 256 + c - 256);
                        float s0 = (k0 * f0.x) * (k0 * f0.x) + (k1 * f0.y) * (k1 * f0.y);
                        float s1 = (k0 * f1.x) * (k0 * f1.x) + (k1 * f1.y) * (k1 * f1.y);
                        s0 = sum16(s0); s1 = sum16(s1);
                        s0 += __shfl_xor(s0, 16); s1 += __shfl_xor(s1, 16);
                        if ((lane & 31) == 0) {
                            const int hd = (i - 2) * 2 + (lane >> 5);
                            invn[tok * 8 + hd] = 1.f / fmaxf(sqrtf(s0), 1e-12f);
                            invn[tok * 8 + 4 + hd] = 1.f / fmaxf(sqrtf(s1), 1e-12f);
                        }
                    }
                } else if (i == 6) {
                    *(unsigned*)(acat + (size_t)tok * 448 + (c - 768)) = pk2(tanhf(u0), tanhf(u1));
                } else if (i == 7) {
                    *(unsigned*)(acat + (size_t)tok * 448 + 128 + (c - 896)) = pk2(u0, u1);
                } else {
                    const int cc = c - 1024;
                    if (cc < 192) *(unsigned*)(acat + (size_t)tok * 448 + 256 + cc) = (cc < 160) ? pk2(sigm(u0), sigm(u1)) : 0u;
                }
            }
            }
        }
    }
}

template <int DK, bool NAM>
DI void attn_item(const bf16_t* __restrict__ Q, int ldq, const bf16_t* __restrict__ Kb, int ldk, const bf16_t* __restrict__ Vt,
                          int s0, int nt0, int s1, int nt1, bf16_t* __restrict__ O, int qr0, const float* rpb_g, char* smem) {
    constexpr int KS = DK + 16, KCH = DK / 8, NKC = 64 * KCH / 256;
    bf16_t* sK = (bf16_t*)smem;
    bf16_t* sV = sK + 64 * 112;
    float* sR = (float*)(sV + 64 * 72);
    const int tid = gtid(), lane = tid & 63, wave = tid >> 6, l15 = lane & 15, quad = lane >> 4;
    const int ntot = nt0 + nt1;
    if (NAM) {
        __syncthreads();
        for (int i = tid; i < 465; i += 256) sR[i] = rpb_g[i] * LOG2E;
    }
    bf16x8 qf[2][DK / 32];
#pragma unroll
    for (int qt = 0; qt < 2; ++qt)
#pragma unroll
        for (int ks = 0; ks < DK / 32; ++ks) qf[qt][ks] = *(const bf16x8*)(Q + (size_t)(wave * 32 + qt * 16 + l15) * ldq + ks * 32 + quad * 8);
    f32x4 Oa[4][2];
#pragma unroll
    for (int i = 0; i < 4; ++i) { Oa[i][0] = (f32x4){0.f, 0.f, 0.f, 0.f}; Oa[i][1] = (f32x4){0.f, 0.f, 0.f, 0.f}; }
    float mrun[2] = {-1e30f, -1e30f}, lrun[2] = {0.f, 0.f};
    u32x4 rk[NKC], rv[2];
    {
        const int key0 = (0 < nt0) ? s0 : s1;
#pragma unroll
        for (int i = 0; i < NKC; ++i) { const int c = tid + 256 * i, row = c / KCH, kc = c % KCH; rk[i] = *(const u32x4*)(Kb + (size_t)(key0 + row) * ldk + kc * 8); }
#pragma unroll
        for (int i = 0; i < 2; ++i) { const int c = tid + 256 * i, row = c >> 3, kc = c & 7; rv[i] = *(const u32x4*)(Vt + (size_t)row * TPB + key0 + kc * 8); }
    }
    for (int j = 0; j < ntot; ++j) {
        __syncthreads();
#pragma unroll
        for (int i = 0; i < NKC; ++i) { const int c = tid + 256 * i, row = c / KCH, kc = c % KCH; *(u32x4*)(sK + row * KS + kc * 8) = rk[i]; }
#pragma unroll
        for (int i = 0; i < 2; ++i) { const int c = tid + 256 * i, row = c >> 3, kc = c & 7; *(u32x4*)(sV + row * 72 + kc * 8) = rv[i]; }
        __syncthreads();
        if (j + 1 < ntot) {
            const int jn = j + 1;
            const int key0 = (jn < nt0) ? (s0 + 64 * jn) : (s1 + 64 * (jn - nt0));
#pragma unroll
            for (int i = 0; i < NKC; ++i) { const int c = tid + 256 * i, row = c / KCH, kc = c % KCH; rk[i] = *(const u32x4*)(Kb + (size_t)(key0 + row) * ldk + kc * 8); }
#pragma unroll
            for (int i = 0; i < 2; ++i) { const int c = tid + 256 * i, row = c >> 3, kc = c & 7; rv[i] = *(const u32x4*)(Vt + (size_t)row * TPB + key0 + kc * 8); }
        }
        f32x4 S[4][2];
#pragma unroll
        for (int kt = 0; kt < 4; ++kt) { S[kt][0] = (f32x4){0.f, 0.f, 0.f, 0.f}; S[kt][1] = (f32x4){0.f, 0.f, 0.f, 0.f}; }
#pragma unroll
        for (int ks = 0; ks < DK / 32; ++ks)
#pragma unroll
            for (int kt = 0; kt < 4; ++kt) {
                const bf16x8 kf = *(const bf16x8*)(sK + (kt * 16 + l15) * KS + ks * 32 + quad * 8);
                S[kt][0] = __builtin_amdgcn_mfma_f32_16x16x32_bf16(kf, qf[0][ks], S[kt][0], 0, 0, 0);
                S[kt][1] = __builtin_amdgcn_mfma_f32_16x16x32_bf16(kf, qf[1][ks], S[kt][1], 0, 0, 0);
            }
        if (NAM) {
            if (j >= nt0) {
                const int kr = (s1 - 256) / 64 + (j - nt0);
#pragma unroll
                for (int qt = 0; qt < 2; ++qt) {
                    const int qi = wave * 32 + qt * 16 + l15, qrow = qr0 + (qi >> 6), qc = qi & 63;
                    const int st = clampi(qrow - 4, 0, 56), cs = clampi(qc - 8, 0, 48);
                    const bool rowok = (kr >= st) && (kr < st + 8);
                    const int rbase = (kr - qrow + 7) * 31 - qc + 15;
#pragma unroll
                    for (int kt = 0; kt < 4; ++kt)
#pragma unroll
                        for (int r = 0; r < 4; ++r) {
                            const int kcx = kt * 16 + quad * 4 + r;
                            const bool ok = rowok && (kcx >= cs) && (kcx < cs + 16);
                            const float bias = sR[ok ? (rbase + kcx) : 0];
                            S[kt][qt][r] = ok ? (S[kt][qt][r] + bias) : -1e30f;
                        }
                }
            }
        }
        bf16x8 pf[2][2];
#pragma unroll
        for (int qt = 0; qt < 2; ++qt) {
            float mx = -1e30f;
#pragma unroll
            for (int kt = 0; kt < 4; ++kt)
#pragma unroll
                for (int r = 0; r < 4; ++r) mx = fmaxf(mx, S[kt][qt][r]);
            mx = fmaxf(mx, __shfl_xor(mx, 16));
            mx = fmaxf(mx, __shfl_xor(mx, 32));
            const float mnew = fmaxf(mrun[qt], mx);
            const float alpha = __builtin_amdgcn_exp2f(mrun[qt] - mnew);
            mrun[qt] = mnew;
            float ps = 0.f;
#pragma unroll
            for (int kt = 0; kt < 4; ++kt)
#pragma unroll
                for (int r = 0; r < 4; ++r) { const float pv = __builtin_amdgcn_exp2f(S[kt][qt][r] - mnew); S[kt][qt][r] = pv; ps += pv; }
            lrun[qt] = lrun[qt] * alpha + ps;
            if (__any(alpha != 1.f)) {
#pragma unroll
                for (int dt = 0; dt < 4; ++dt) { Oa[dt][qt][0] *= alpha; Oa[dt][qt][1] *= alpha; Oa[dt][qt][2] *= alpha; Oa[dt][qt][3] *= alpha; }
            }
#pragma unroll
            for (int s = 0; s < 2; ++s) {
                u32x4 f;
                f[0] = pk2(S[2 * s][qt][0], S[2 * s][qt][1]); f[1] = pk2(S[2 * s][qt][2], S[2 * s][qt][3]);
                f[2] = pk2(S[2 * s + 1][qt][0], S[2 * s + 1][qt][1]); f[3] = pk2(S[2 * s + 1][qt][2], S[2 * s + 1][qt][3]);
                pf[qt][s] = __builtin_bit_cast(bf16x8, f);
            }
        }
#pragma unroll
        for (int s = 0; s < 2; ++s)
#pragma unroll
            for (int dt = 0; dt < 4; ++dt) {
                const bf16x4 v0 = *(const bf16x4*)(sV + (dt * 16 + l15) * 72 + (2 * s) * 16 + quad * 4);
                const bf16x4 v1 = *(const bf16x4*)(sV + (dt * 16 + l15) * 72 + (2 * s + 1) * 16 + quad * 4);
                const bf16x8 vf = __builtin_shufflevector(v0, v1, 0, 1, 2, 3, 4, 5, 6, 7);
                Oa[dt][0] = __builtin_amdgcn_mfma_f32_16x16x32_bf16(vf, pf[0][s], Oa[dt][0], 0, 0, 0);
                Oa[dt][1] = __builtin_amdgcn_mfma_f32_16x16x32_bf16(vf, pf[1][s], Oa[dt][1], 0, 0, 0);
            }
    }
#pragma unroll
    for (int qt = 0; qt < 2; ++qt) {
        float lt = lrun[qt];
        lt += __shfl_xor(lt, 16); lt += __shfl_xor(lt, 32);
        const float inv = 1.f / lt;
#pragma unroll
        for (int dt = 0; dt < 4; ++dt)
            st4(O + (size_t)(wave * 32 + qt * 16 + l15) * LDH + dt * 16 + quad * 4, Oa[dt][qt][0] * inv, Oa[dt][qt][1] * inv, Oa[dt][qt][2] * inv, Oa[dt][qt][3] * inv);
    }
}

DI void scan_item(const Params& p, int l, int item, char* smem) {
    float* sT = (float*)smem;
    float* sVv = sT + 16 * 320;
    float* sY = sVv + 256;
    const int tid = gtid(), lane = tid & 63, wave = tid >> 6;
    const int scan = item >> 2, rg = item & 3;
    const int b = scan >> 3, head = (scan >> 1) & 3, dir = scan & 1;
    const bf16_t* rkv = (const bf16_t*)(p.ws + O_RKV);
    const bf16_t* dec = (const bf16_t*)(p.ws + O_DEC);
    const float* invn = (const float*)(p.ws + O_INVN);
    float* yout = (float*)(p.ws + O_Y) + (size_t)dir * NT * 256;
    const int k2 = (tid & 31) * 2, tq = tid >> 5;
    const float* kkw = p.in[I_KK] + (size_t)(l * 2 + dir) * 256 + head * 64;
    const float* kaw = p.in[I_KA] + (size_t)(l * 2 + dir) * 256 + head * 64;
    const float kkc0 = kkw[k2], kkc1 = kkw[k2 + 1], kac0 = kaw[k2], kac1 = kaw[k2 + 1];
    unsigned rr[2], kr[2], ow[2], as[2]; float inn[2]; bf16_t vv;
    const int tbase = b * TPB;
#define SCAN_TOK(s) (tbase + (dir ? ((s) < 256 ? 255 - (s) : 4607 - (s)) : (s)))
#define SCAN_LOAD(ch)                                                                                          \
    {                                                                                                          \
        _Pragma("unroll") for (int i = 0; i < 2; ++i) {                                                        \
            const int tok = SCAN_TOK((ch) * 16 + tq + 8 * i);                                                  \
            rr[i] = *(const unsigned*)(rkv + (size_t)tok * 768 + head * 64 + k2);                              \
            kr[i] = *(const unsigned*)(rkv + (size_t)tok * 768 + 256 + head * 64 + k2);                        \
            ow[i] = *(const unsigned*)(dec + (size_t)tok * 1024 + dir * 256 + head * 64 + k2);                 \
            as[i] = *(const unsigned*)(dec + (size_t)tok * 1024 + 512 + dir * 256 + head * 64 + k2);           \
            inn[i] = invn[tok * 8 + dir * 4 + head];                                                           \
        }                                                                                                      \
        {                                                                                                      \
            const int tok = SCAN_TOK((ch) * 16 + (tid >> 4));                                                  \
            vv = rkv[(size_t)tok * 768 + 512 + head * 64 + rg * 16 + (tid & 15)];                              \
        }                                                                                                      \
    }
#define SCAN_YRED(ch)                                                                                          \
    {                                                                                                          \
        const int tl = tid >> 4, row = tid & 15;                                                               \
        const float* yp = sY + tl * 256 + (row >> 2) * 64 + (row & 3) * 16;                                    \
        const f32x4 q0 = *(const f32x4*)yp, q1 = *(const f32x4*)(yp + 4), q2 = *(const f32x4*)(yp + 8), q3 = *(const f32x4*)(yp + 12);   \
        const f32x4 qs = (q0 + q1) + (q2 + q3);                                                                \
        yout[(size_t)SCAN_TOK((ch) * 16 + tl) * 256 + head * 64 + rg * 16 + row] = (qs[0] + qs[1]) + (qs[2] + qs[3]);   \
    }
    float S0 = 0.f, S1 = 0.f, S2 = 0.f, S3 = 0.f;
    const int c = lane & 15, rloc = wave * 4 + (lane >> 4);
    __builtin_amdgcn_s_setprio(3);
    SCAN_LOAD(0);
    for (int ch = 0; ch < 272; ++ch) {
        __syncthreads();
        if (ch > 0) SCAN_YRED(ch - 1)
#pragma unroll
        for (int i = 0; i < 2; ++i) {
            float* base = sT + (tq + 8 * i) * 320 + k2;
            const float r0 = lo2f(rr[i]), r1 = hi2f(rr[i]), k0 = lo2f(kr[i]), k1 = hi2f(kr[i]);
            const float o0 = lo2f(ow[i]), o1 = hi2f(ow[i]), a0 = lo2f(as[i]), a1 = hi2f(as[i]);
            const float kk0 = k0 * kkc0 * inn[i], kk1 = k1 * kkc1 * inn[i];
            *(float2*)(base) = make_float2(1.f - o0, 1.f - o1);
            *(float2*)(base + 64) = make_float2(kk0, kk1);
            *(float2*)(base + 128) = make_float2(kk0 * a0, kk1 * a1);
            *(float2*)(base + 192) = make_float2(k0 * (1.f + (a0 - 1.f) * kac0), k1 * (1.f + (a1 - 1.f) * kac1));
            *(float2*)(base + 256) = make_float2(r0, r1);
        }
        sVv[tid] = bf2f(vv);
        __syncthreads();
        if (ch + 1 < 272) SCAN_LOAD(ch + 1);
#define SC_LD(bi, t0)                                                                                   \
    _Pragma("unroll") for (int q = 0; q < 2; ++q) {                                                     \
        const float* bp = sT + ((t0) + q) * 320 + c * 4;                                                \
        W4[bi][q] = *(const f32x4*)bp; K4[bi][q] = *(const f32x4*)(bp + 64); B4[bi][q] = *(const f32x4*)(bp + 128);   \
        D4[bi][q] = *(const f32x4*)(bp + 192); R4[bi][q] = *(const f32x4*)(bp + 256); VX[bi][q] = sVv[((t0) + q) * 16 + rloc];  \
    }
#define SC_CP(bi, t0)                                                                                   \
    _Pragma("unroll") for (int q = 0; q < 2; ++q) {                                                     \
        float sa = (S0 * K4[bi][q][0] + S1 * K4[bi][q][1]) + (S2 * K4[bi][q][2] + S3 * K4[bi][q][3]);   \
        sa = sum16(sa);                                                                                 \
        S0 = S0 * W4[bi][q][0] - sa * B4[bi][q][0] + VX[bi][q] * D4[bi][q][0];                          \
        S1 = S1 * W4[bi][q][1] - sa * B4[bi][q][1] + VX[bi][q] * D4[bi][q][1];                          \
        S2 = S2 * W4[bi][q][2] - sa * B4[bi][q][2] + VX[bi][q] * D4[bi][q][2];                          \
        S3 = S3 * W4[bi][q][3] - sa * B4[bi][q][3] + VX[bi][q] * D4[bi][q][3];                          \
        sY[((t0) + q) * 256 + tid] = (S0 * R4[bi][q][0] + S1 * R4[bi][q][1]) + (S2 * R4[bi][q][2] + S3 * R4[bi][q][3]);  \
    }
        {
            f32x4 W4[2][2], K4[2][2], B4[2][2], D4[2][2], R4[2][2]; float VX[2][2];
            SC_LD(0, 0);
#pragma unroll 1
            for (int it = 0; it < 4; ++it) {
                SC_LD(1, it * 4 + 2);
                SC_CP(0, it * 4);
                if (it < 3) SC_LD(0, it * 4 + 4);
                SC_CP(1, it * 4 + 2);
            }
        }
    }
    __syncthreads();
    SCAN_YRED(271)
#undef SC_LD
#undef SC_CP
#undef SCAN_YRED
#undef SCAN_LOAD
#undef SCAN_TOK
    __builtin_amdgcn_s_setprio(0);
}

DI void phase_mix(const Params& p, int l, char* smem, int* s_item) {
    char* ws = p.ws;
    int* ctr = (int*)(ws + O_CTL) + l;
    const bool want_ctx = l < 3;
    const int nattn = 3072 + (want_ctx ? 192 : 0);
    const int total = nattn + 2304 + (l < 3 ? 804 : 0);
    const bf16_t* naqk = (const bf16_t*)(ws + O_NAQK);
    const bf16_t* vta = (const bf16_t*)(ws + O_VTA);
    const bf16_t* gq = (const bf16_t*)(ws + O_GQ);
    const bf16_t* vtb = (const bf16_t*)(ws + O_VTB);
    const bf16_t* qc = (const bf16_t*)(ws + O_QC);
    const bf16_t* kc = (const bf16_t*)(ws + O_KC);
    const bf16_t* vtc = (const bf16_t*)(ws + O_VTC);
    bf16_t* mix = (bf16_t*)(ws + O_HBUF);
    const float* rpb = p.in[I_RPB] + (size_t)l * 4 * 465;
    {
        const int G = gridDim.x, bb = blockIdx.x;
        for (int sidx = 0; sidx < 256; ++sidx) {
            const int owner = (G == 512) ? ((sidx & 127) + (sidx >> 7) * 256) : (sidx % G);
            if (owner == bb) { for (int rep = 0; rep < REP_SCAN; ++rep) scan_item(p, l, sidx, smem); }
        }
    }
    while (true) {
        if (threadIdx.x == 0) *s_item = atomicAdd(ctr, 1);
        __syncthreads();
        const int item = *s_item;
        __syncthreads();
        if (item >= total) break;
        if (item >= nattn) { const int j = item - nattn; if (j < 2304) wconv_late(p, l, j, smem); else wconv_early(p, l + 1, j - 2304, smem); continue; }
        int type, b, h, qtok0, nkt0, qr0 = 0; bool isctx = false;
        if (item < 3072) {
            const int i1 = item;
            type = i1 >> 10;
            const int r = i1 & 1023;
            b = r >> 7; h = (r >> 5) & 3;
            const int qb = r & 31;
            qtok0 = b * TPB + 256 + qb * 128; nkt0 = 68; qr0 = qb * 2;
        } else {
            const int i2 = item - 3072;
            type = i2 >> 6;
            const int r = i2 & 63;
            b = r >> 3; h = (r >> 1) & 3;
            qtok0 = b * TPB + (r & 1) * 128; nkt0 = 4; isctx = true;
        }
        const size_t kb = (size_t)b * TPB;
        for (int rep = 0; rep < REP_ATTN; ++rep) {
            if (type == 0) {
                attn_item<96, false>(qc + (size_t)qtok0 * 384 + h * 96, 384, kc + kb * 384 + h * 96, 384, vtc + ((size_t)b * 256 + h * 64) * TPB,
                                     0, nkt0, 0, 0, mix + (size_t)qtok0 * LDH + 512 + h * 64, 0, nullptr, smem);
            } else if (type == 2 && !isctx) {
                const int st0 = clampi(qr0 - 4, 0, 56), st1 = clampi(qr0 + 1 - 4, 0, 56);
                attn_item<64, true>(naqk + (size_t)qtok0 * LDNA + h * 64, LDNA, naqk + kb * LDNA + 256 + h * 64, LDNA, vta + ((size_t)b * 256 + h * 64) * TPB,
                                    0, 4, 256 + st0 * 64, st1 + 8 - st0, mix + (size_t)qtok0 * LDH + h * 64, qr0, rpb + h * 465, smem);
            } else {
                const bf16_t *Qp, *Kp, *Vp; bf16_t* Op; int ld;
                if (type == 1) {
                    const int kvh = h >> 1;
                    Qp = gq + (size_t)qtok0 * 384 + h * 64; Kp = gq + kb * 384 + 256 + kvh * 64; Vp = vtb + ((size_t)b * 128 + kvh * 64) * TPB;
                    Op = mix + (size_t)qtok0 * LDH + 256 + h * 64; ld = 384;
                } else {
                    Qp = naqk + (size_t)qtok0 * LDNA + h * 64; Kp = naqk + kb * LDNA + 256 + h * 64; Vp = vta + ((size_t)b * 256 + h * 64) * TPB;
                    Op = mix + (size_t)qtok0 * LDH + h * 64; ld = LDNA;
                }
                attn_item<64, false>(Qp, ld, Kp, ld, Vp, 0, nkt0, 0, 0, Op, 0, nullptr, smem);
            }
        }
    }
}

DI void phase_rwkv_fin(const Params& p, int l) {
    const int tid = gtid(), lane = tid & 63, wave = tid >> 6;
    char* ws = p.ws;
    const float* yf = (const float*)(ws + O_Y);
    const float* yb = yf + (size_t)NT * 256;
    const bf16_t* rkv = (const bf16_t*)(ws + O_RKV);
    const bf16_t* dec = (const bf16_t*)(ws + O_DEC);
    const bf16_t* gate = (const bf16_t*)(ws + O_GATE);
    bf16_t* mix = (bf16_t*)(ws + O_HBUF);
    const int c = lane * 4;
    const float4 ka0 = *(const float4*)(p.in[I_KA] + (size_t)(l * 2) * 256 + c), ka1 = *(const float4*)(p.in[I_KA] + (size_t)(l * 2 + 1) * 256 + c);
    const float4 rk0 = *(const float4*)(p.in[I_RK] + (size_t)(l * 2) * 256 + c), rk1 = *(const float4*)(p.in[I_RK] + (size_t)(l * 2 + 1) * 256 + c);
    const float4 lw = *(const float4*)(p.in[I_LNW] + l * 256 + c), lb = *(const float4*)(p.in[I_LNB] + l * 256 + c);
    for (int tok = blockIdx.x * 4 + wave; tok < NT; tok += gridDim.x * 4) {
        const float4 a = *(const float4*)(yf + (size_t)tok * 256 + c), bb = *(const float4*)(yb + (size_t)tok * 256 + c);
        const float y0 = a.x + bb.x, y1 = a.y + bb.y, y2 = a.z + bb.z, y3 = a.w + bb.w;
        const float mu = sum16(y0 + y1 + y2 + y3) * (1.f / 64.f);
        const float d0 = y0 - mu, d1 = y1 - mu, d2 = y2 - mu, d3 = y3 - mu;
        const float var = sum16(d0 * d0 + d1 * d1 + d2 * d2 + d3 * d3) * (1.f / 64.f);
        const float rstd = rsqrtf(var + 64e-5f);
        const uint2 ur = *(const uint2*)(rkv + (size_t)tok * 768 + c), uk = *(const uint2*)(rkv + (size_t)tok * 768 + 256 + c), uv = *(const uint2*)(rkv + (size_t)tok * 768 + 512 + c);
        const uint2 uaf = *(const uint2*)(dec + (size_t)tok * 1024 + 512 + c), uab = *(const uint2*)(dec + (size_t)tok * 1024 + 768 + c);
        const uint2 ug = *(const uint2*)(gate + (size_t)tok * 256 + c);
        const float r0 = lo2f(ur.x), r1 = hi2f(ur.x), r2 = lo2f(ur.y), r3 = hi2f(ur.y);
        const float k0 = lo2f(uk.x), k1 = hi2f(uk.x), k2 = lo2f(uk.y), k3 = hi2f(uk.y);
        const float v0 = lo2f(uv.x), v1 = hi2f(uv.x), v2 = lo2f(uv.y), v3 = hi2f(uv.y);
        const float f0 = lo2f(uaf.x), f1 = hi2f(uaf.x), f2 = lo2f(uaf.y), f3 = hi2f(uaf.y);
        const float b0 = lo2f(uab.x), b1 = hi2f(uab.x), b2 = lo2f(uab.y), b3 = hi2f(uab.y);
        float bs = r0 * k0 * ((1.f + (f0 - 1.f) * ka0.x) * rk0.x + (1.f + (b0 - 1.f) * ka1.x) * rk1.x)
                 + r1 * k1 * ((1.f + (f1 - 1.f) * ka0.y) * rk0.y + (1.f + (b1 - 1.f) * ka1.y) * rk1.y)
                 + r2 * k2 * ((1.f + (f2 - 1.f) * ka0.z) * rk0.z + (1.f + (b2 - 1.f) * ka1.z) * rk1.z)
                 + r3 * k3 * ((1.f + (f3 - 1.f) * ka0.w) * rk0.w + (1.f + (b3 - 1.f) * ka1.w) * rk1.w);
        bs = sum16(bs);
        const float o0 = (d0 * rstd * lw.x + lb.x + bs * v0) * lo2f(ug.x);
        const float o1 = (d1 * rstd * lw.y + lb.y + bs * v1) * hi2f(ug.x);
        const float o2 = (d2 * rstd * lw.z + lb.z + bs * v2) * lo2f(ug.y);
        const float o3 = (d3 * rstd * lw.w + lb.w + bs * v3) * hi2f(ug.y);
        st4(mix + (size_t)tok * LDH + 768 + c, o0, o1, o2, o3);
    }
}

DI void phase_final(const Params& p) {
    const int tid = gtid(), lane = tid & 63, wave = tid >> 6;
    const float* g = p.in[I_FNG];
    for (int row = blockIdx.x * 4 + wave; row < NB * 4096; row += gridDim.x * 4) {
        float* x = p.out + (size_t)row * 1024;
        f32x4 v[4]; float ss = 0.f;
#pragma unroll
        for (int i = 0; i < 4; ++i) { v[i] = ((const f32x4*)x)[lane + 64 * i]; ss += v[i].x * v[i].x + v[i].y * v[i].y + v[i].z * v[i].z + v[i].w * v[i].w; }
        ss = wsum64(ss);
        const float rs = rsqrtf(ss * (1.f / 1024.f) + 1e-6f);
#pragma unroll
        for (int i = 0; i < 4; ++i) {
            const float4 g4 = ((const float4*)g)[lane + 64 * i];
            float4 o; o.x = v[i].x * rs * g4.x; o.y = v[i].y * rs * g4.y; o.z = v[i].z * rs * g4.z; o.w = v[i].w * rs * g4.w;
            ((float4*)x)[lane + 64 * i] = o;
        }
    }
}

#define XB_TMO      128
#define XB_XCNT(j)  (256  + 64 * (j))
#define XB_XSUB(j)  (1280 + 64 * (j))
#define XB_XGEN(j)  (2304 + 64 * (j))
#define XB_TOP      3328
#define XB_TOPGEN   3392
#define XCD_BAR_WORDS 3456
#define XB_SPIN_CAP (1u << 18)
#define LAS __attribute__((address_space(3)))

__device__ __forceinline__ unsigned xb_ld(unsigned* p)              { return __hip_atomic_load(p, __ATOMIC_RELAXED, __HIP_MEMORY_SCOPE_AGENT); }
__device__ __forceinline__ unsigned xb_add(unsigned* p, unsigned v) { return __hip_atomic_fetch_add(p, v, __ATOMIC_RELAXED, __HIP_MEMORY_SCOPE_AGENT); }
__device__ __forceinline__ unsigned xb_xcc_id() { return (unsigned)__builtin_amdgcn_s_getreg((3 << 11) | 20) & 0xFu; }
#define XB_SPIN(cond, bar) do { unsigned _sp = 0; while (cond) { __builtin_amdgcn_s_sleep(1); \
    if ((++_sp & 255u) == 0u) { if (xb_ld(&(bar)[XB_TMO])) break; if (_sp > XB_SPIN_CAP) { atomicAdd(&(bar)[XB_TMO], 1u); break; } } } } while (0)

struct XcdBarrier {
    unsigned* bar; unsigned x;
    volatile LAS unsigned* st;
};

__device__ __forceinline__ XcdBarrier xcd_barrier_post(unsigned* bar, volatile LAS unsigned* st) {
    XcdBarrier b; b.bar = bar; b.x = xb_xcc_id(); b.st = st;
    if (threadIdx.x == 0) (void)xb_add(&bar[XB_XCNT(b.x)], 1u);
    return b;
}
__device__ __forceinline__ void xcd_barrier_complete(unsigned* bar, unsigned x, unsigned& nloc, unsigned& nx) {
    const unsigned G = gridDim.x * gridDim.y * gridDim.z;
    unsigned sum, cnt, mine, sp = 0u;
    for (;;) {
        sum = 0u; cnt = 0u; mine = 0u;
#pragma unroll
        for (unsigned j = 0; j < 16; ++j) { const unsigned c = xb_ld(&bar[XB_XCNT(j)]); sum += c; cnt += (c > 0u) ? 1u : 0u; mine = (j == x) ? c : mine; }
        if (sum == G) break;
        __builtin_amdgcn_s_sleep(1);
        if ((++sp & 255u) == 0u) { if (xb_ld(&bar[XB_TMO])) break; if (sp > XB_SPIN_CAP) { atomicAdd(&bar[XB_TMO], 1u); break; } }
    }
    nloc = mine > 0u ? mine : 1u; nx = cnt > 0u ? cnt : 1u;
}

__device__ __forceinline__ void xcd_barrier(const XcdBarrier& b) {
    asm volatile("s_waitcnt vmcnt(0)" ::: "memory");
    __syncthreads();
    if (threadIdx.x == 0) {
        unsigned* bar = b.bar;
        __builtin_amdgcn_s_waitcnt(0);
        unsigned nloc = b.st[0], nx = b.st[1];
        if (nloc == 0u) { xcd_barrier_complete(bar, b.x, nloc, nx); b.st[0] = nloc; b.st[1] = nx; }
        const unsigned old = xb_add(&bar[XB_XSUB(b.x)], 1u);
        const unsigned gen = old / nloc;
        if (old + 1u == (gen + 1u) * nloc) {
            __builtin_amdgcn_fence(__ATOMIC_RELEASE, "agent");
            asm volatile("s_waitcnt vmcnt(0)" ::: "memory");
            const unsigned og = xb_add(&bar[XB_TOP], 1u);
            const unsigned tg = og / nx;
            if (og + 1u == (tg + 1u) * nx) xb_add(&bar[XB_TOPGEN], 1u);
            else XB_SPIN(xb_ld(&bar[XB_TOPGEN]) == tg, bar);
            __builtin_amdgcn_fence(__ATOMIC_ACQUIRE, "agent");
            xb_add(&bar[XB_XGEN(b.x)], 1u);
            asm volatile("s_waitcnt vmcnt(0)" ::: "memory");
        } else {
            XB_SPIN(xb_ld(&bar[XB_XGEN(b.x)]) == gen, bar);
            __builtin_amdgcn_fence(__ATOMIC_ACQUIRE, "agent");
            asm volatile("s_waitcnt vmcnt(0)" ::: "memory");
        }
    }
    __syncthreads();
}


__global__ void __launch_bounds__(256, 3) mega(Params p) {
    __shared__ __attribute__((aligned(16))) char smem[49152];
    __shared__ int s_item;
    __shared__ uint4 xb_words;
    cg::grid_group grid = cg::this_grid();
    if (threadIdx.x == 0) xb_words = make_uint4(0u, 0u, 0u, 0u);
    __syncthreads();
    XcdBarrier xb = xcd_barrier_post((unsigned*)(p.ws + O_CTL), (volatile LAS unsigned*)&xb_words);
    char* ws = p.ws;
    const int G = gridDim.x;
    const int pb = ((G & 7) == 0) ? ((int)(blockIdx.x & 7) * (G >> 3) + (int)(blockIdx.x >> 3)) : (int)blockIdx.x;
    float* xc = (float*)(ws + O_XC);
    bf16_t* hbuf = (bf16_t*)(ws + O_HBUF);

    phase_mod(p, smem);
    phase_wconv(p, 0, smem);
    grid.sync();
    for (int step = 0; step < 40; ++step) {
        const int l = step / 10, ph = step - l * 10;
        const float* modl = (const float*)(ws + O_MOD) + (size_t)l * 9 * 6144;
        const float* xl_src = (l == 0) ? p.in[I_X] : p.out;
        const float* xc_src = (l == 0) ? p.in[I_CTX] : xc;
        switch (ph) {
        case 0: {
            for (int rep = 0; rep < REP_EWA; ++rep) phase_norm(xl_src, xc_src, p.in[I_N1G] + l * 1024, modl, 0, 1, hbuf);
        } break;
        case 1: {
            {
                EpiIn e{(bf16_t*)(ws + O_NAQK), (bf16_t*)(ws + O_VTA), (bf16_t*)(ws + O_GQ), (bf16_t*)(ws + O_VTB), (bf16_t*)(ws + O_MLAR), (bf16_t*)(ws + O_RWR)};
                for (int rep = 0; rep < REP_GEMM; ++rep) for (int t = pb; t < 272 * 23; t += G) { int mt, nt; tile_mn(t, 23, mt, nt); gemm_tile(hbuf, LDH, (const bf16_t*)(ws + O_WIN), LDW1, 1024, mt * 128, nt * 128, smem, e); }
            }
        } break;
        case 2: {
            phase_post(p, l);
        } break;
        case 3: {
            {
                EpiUQ e1{(bf16_t*)(ws + O_QC), (const float*)(ws + O_RSM)};
                EpiUKV e2{(bf16_t*)(ws + O_KC), (bf16_t*)(ws + O_VTC), (const float*)(ws + O_RSM)};
                EpiAux e3{(bf16_t*)(ws + O_DEC), (bf16_t*)(ws + O_GATE), p.in[I_W0] + l * 512, p.in[I_A0] + l * 512};
                const bf16_t* mlar = (const bf16_t*)(ws + O_MLAR);
                for (int rep = 0; rep < REP_GEMM; ++rep) for (int t = pb; t < 272 * 17; t += G) {
                    const int mt = t / 17, j = t % 17;
                    if (j < 3) gemm_tile(mlar, 416, (const bf16_t*)(ws + O_WUQ), 256, 256, mt * 128, j * 128, smem, e1);
                    else if (j < 7) gemm_tile(mlar + 256, 416, (const bf16_t*)(ws + O_WUKV), 128, 128, mt * 128, (j - 3) * 128, smem, e2);
                    else {
                        const int n0 = (j - 7) * 128, blk = n0 >> 8;
                        if (blk < 4) {
                            gemm_tile(hbuf + blk * 64, 448, (const bf16_t*)(ws + O_WAUX) + (size_t)blk * 256 * 64 - (size_t)(blk * 256) * 64, 64, 64, mt * 128, n0, smem, e3);
                        } else {
                            gemm_tile(hbuf + 256, 448, (const bf16_t*)(ws + O_WG2) - (size_t)1024 * 192, 192, 192, mt * 128, n0, smem, e3);
                        }
                    }
                }
            }
        } break;
        case 4: {
            phase_mix(p, l, smem, &s_item);
        } break;
        case 5: {
            for (int rep = 0; rep < REP_EW; ++rep) phase_rwkv_fin(p, l);
        } break;
        case 6: {
            {
                EpiRes e{xl_src, xc_src, p.out, xc, modl + 2 * 1024};
                for (int t = pb; t < 272 * 8; t += G) { int mt, nt; tile_mn(t, 8, mt, nt); if (l == 3 && (mt % 34) < 2) continue;
                    gemm_tile(hbuf, LDH, (const bf16_t*)(ws + O_WOUT), LDW1, 1024, mt * 128, nt * 128, smem, e); }
            }
        } break;
        case 7: {
            for (int rep = 0; rep < REP_EW; ++rep) phase_norm(p.out, xc, p.in[I_N2G] + l * 1024, modl, 3, 4, hbuf);
        } break;
        case 8: {
            {
                EpiFc1 e{(bf16_t*)(ws + O_HID)};
                for (int rep = 0; rep < REP_GEMM; ++rep) for (int t = pb; t < 272 * 32; t += G) { int mt, nt; tile_mn(t, 32, mt, nt); if (l == 3 && (mt % 34) < 2) continue;
                    gemm_tile(hbuf, LDH, (const bf16_t*)(ws + O_WFC1), LDW1, 1024, mt * 128, nt * 128, smem, e); }
            }
        } break;
        case 9: {
            {
                EpiRes e{p.out, xc, p.out, xc, modl + 5 * 1024};
                for (int t = pb; t < 272 * 8; t += G) { int mt, nt; tile_mn(t, 8, mt, nt); if (l == 3 && (mt % 34) < 2) continue;
                    gemm_tile((const bf16_t*)(ws + O_HID), LDHID, (const bf16_t*)(ws + O_WFC2), LDW4, 4096, mt * 128, nt * 128, smem, e); }
            }
        } break;
        }
        for (int rep = 0; rep < REP_SYNC; ++rep) xcd_barrier(xb);
    }
    phase_final(p);
}

extern "C" void kernel_launch(void* const* d_in, const int* in_sizes, int n_in, void* d_out, int out_size, void* d_ws, size_t ws_size, hipStream_t stream) {
    static int grid_blocks = 0;
    if (n_in != 31 || ws_size < O_END) { fprintf(stderr, "kernel_launch: bad n_in %d or ws_size %zu < %zu\n", n_in, ws_size, (size_t)O_END); return; }
    if (!grid_blocks) {
        int dev = 0, cus = 0, per_cu = 0;
        hipGetDevice(&dev);
        hipDeviceGetAttribute(&cus, hipDeviceAttributeMultiprocessorCount, dev);
        hipOccupancyMaxActiveBlocksPerMultiprocessor(&per_cu, mega, 256, 0);
        if (per_cu > 3) per_cu = 3;
        if (per_cu < 1) per_cu = 1;
        grid_blocks = cus * per_cu;
    }
    Params p{};
    for (int i = 0; i < 31; ++i) p.in[i] = (const float*)d_in[i];
    p.out = (float*)d_out;
    p.ws = (char*)d_ws;
    (void)hipMemsetAsync(d_ws, 0, 16384, stream);
    void* args[] = {&p};
    hipError_t e = hipLaunchCooperativeKernel((void*)mega, dim3(grid_blocks), dim3(256), args, 0, stream);
    if (e != hipSuccess) fprintf(stderr, "cooperative launch failed: %s (grid %d)\n", hipGetErrorString(e), grid_blocks);
}
```

```cpp
#include <hip/hip_runtime.h>
#include <hip/hip_cooperative_groups.h>
#include <stdint.h>
#include <stdio.h>
namespace cg = cooperative_groups;
#ifndef REP_GEMM
#define REP_GEMM 1
#endif
#ifndef REP_ATTN
#define REP_ATTN 1
#endif
#ifndef REP_EW
#define REP_EW 1
#endif
#ifndef REP_SYNC
#define REP_SYNC 1
#endif
#ifndef REP_EWA
#define REP_EWA 1
#endif
#ifndef REP_SCAN
#define REP_SCAN 1
#endif

#define DI __device__ __forceinline__
typedef unsigned short bf16_t;
typedef short bf16x8 __attribute__((ext_vector_type(8)));
typedef short bf16x4 __attribute__((ext_vector_type(4)));
typedef float f32x4 __attribute__((ext_vector_type(4)));
typedef unsigned u32x4 __attribute__((ext_vector_type(4)));

constexpr int NB = 8, TPB = 4352, NT = NB * TPB;
constexpr int INC = 2880, INP = 2944;
constexpr int LDH = 1088, LDHID = 4160, LDW1 = 1088, LDW4 = 4160, LDNA = 576;
constexpr float LOG2E = 1.4426950408889634f;
constexpr float QS64 = 0.125f * LOG2E;
constexpr float QS96 = 0.10206207261596577f * LOG2E;
constexpr float ROPE_L2T = 13.287712379549449f;

constexpr size_t al(size_t x) { return (x + 255) & ~size_t(255); }
constexpr size_t O_CTL = 0;
constexpr size_t O_MOD = 16384;
constexpr size_t O_XC = O_MOD + al((size_t)4 * 9 * 6144 * 4);
constexpr size_t O_WIN = O_XC + al((size_t)2048 * 1024 * 4);
constexpr size_t O_WOUT = O_WIN + al((size_t)INP * LDW1 * 2);
constexpr size_t O_WFC1 = O_WOUT + al((size_t)1024 * LDW1 * 2);
constexpr size_t O_WFC2 = O_WFC1 + al((size_t)4096 * LDW1 * 2);
constexpr size_t O_WUQ = O_WFC2 + al((size_t)1024 * LDW4 * 2);
constexpr size_t O_WUKV = O_WUQ + al((size_t)384 * 256 * 2);
constexpr size_t O_WAUX = O_WUKV + al((size_t)512 * 128 * 2);
constexpr size_t O_WG2 = O_WAUX + al((size_t)4 * 256 * 64 * 2);
constexpr size_t O_HBUF = O_WG2 + al((size_t)256 * 192 * 2);
constexpr size_t O_BIG = O_HBUF + al((size_t)NT * LDH * 2);
constexpr size_t O_NAQK = O_BIG;
constexpr size_t O_VTA = O_NAQK + al((size_t)NT * LDNA * 2);
constexpr size_t O_GQ = O_VTA + al((size_t)NB * 256 * TPB * 2);
constexpr size_t O_VTB = O_GQ + al((size_t)NT * 384 * 2);
constexpr size_t O_MLAR = O_VTB + al((size_t)NB * 128 * TPB * 2);
constexpr size_t O_RWR = O_MLAR + al((size_t)NT * 416 * 2);
constexpr size_t O_QC = O_RWR + al((size_t)NT * 1184 * 2);
constexpr size_t O_KC = O_QC + al((size_t)NT * 384 * 2);
constexpr size_t O_VTC = O_KC + al((size_t)NT * 384 * 2);
constexpr size_t O_RKV = O_VTC + al((size_t)NB * 256 * TPB * 2);
constexpr size_t O_DEC = O_RKV + al((size_t)NT * 768 * 2);
constexpr size_t O_GATE = O_DEC + al((size_t)NT * 1024 * 2);
constexpr size_t O_INVN = O_GATE + al((size_t)NT * 256 * 2);
constexpr size_t O_RSM = O_INVN + al((size_t)NT * 8 * 4);
constexpr size_t O_END = O_RSM + al((size_t)NT * 2 * 4);
constexpr size_t O_HID = O_BIG;
constexpr size_t O_Y = O_RWR;
static_assert(O_HID + (size_t)NT * LDHID * 2 <= O_END, "hidden overlay");
static_assert(O_END <= (size_t)512 * 1024 * 1024, "workspace");
static_assert((size_t)2 * NT * 256 * 4 <= (size_t)NT * 1184 * 2, "y overlay");

struct Params {
    const float* in[31];
    float* out;
    char* ws;
};

enum { I_X = 0, I_C, I_CTX, I_CCTX, I_WMOD, I_BMOD, I_N1G, I_N2G, I_WIN, I_SHIFT, I_RPB, I_GQN, I_GKN, I_MQN, I_MKVN, I_WUQ, I_WUKV,
       I_W0, I_W2, I_A0, I_A2, I_KK, I_KA, I_RK, I_G2, I_LNW, I_LNB, I_WOUT, I_FC1, I_FC2, I_FNG };

typedef __bf16 hwbf16x2 __attribute__((ext_vector_type(2)));
typedef float f32x2 __attribute__((ext_vector_type(2)));
DI unsigned pk2(float a, float b) { f32x2 v = {a, b}; hwbf16x2 r = __builtin_convertvector(v, hwbf16x2); return __builtin_bit_cast(unsigned, r); }
DI bf16_t f2bf(float x) { return (bf16_t)(pk2(x, x) & 0xffffu); }
DI float bf2f(bf16_t b) { return __uint_as_float(((unsigned)b) << 16); }
DI float lo2f(unsigned u) { return __uint_as_float(u << 16); }
DI float hi2f(unsigned u) { return __uint_as_float(u & 0xffff0000u); }
DI void st4(bf16_t* p, float a, float b, float c, float d) { uint2 u; u.x = pk2(a, b); u.y = pk2(c, d); *(uint2*)p = u; }
template <int CTRL> DI float dppf(float v) { return __int_as_float(__builtin_amdgcn_update_dpp(0, __float_as_int(v), CTRL, 0xF, 0xF, true)); }
DI float sum16(float v) { v += dppf<0xB1>(v); v += dppf<0x4E>(v); v += dppf<0x141>(v); v += dppf<0x140>(v); return v; }
DI float wsum64(float v) { v = sum16(v); v += __shfl_xor(v, 16); v += __shfl_xor(v, 32); return v; }
DI float sigm(float x) { return 1.f / (1.f + __expf(-x)); }
DI int gtid() { int t = threadIdx.x; asm volatile("" : "+v"(t)); return t; }
DI int clampi(int v, int lo, int hi) { return v < lo ? lo : (v > hi ? hi : v); }

template <class T> struct IsRes;
template <class T> struct HasRS;
template <class T> struct HasCV;
template <class Epi>
DI void gemm_tile(const bf16_t* __restrict__ A, int lda, const bf16_t* __restrict__ Bt, int ldb, int K, int m0, int n0, char* smem, const Epi& epi) {
    char* sA = smem;
    char* sB = smem + 16384;
    const int tid = gtid(), lane = tid & 63, wave = tid >> 6;
    const int wm = wave >> 1, wn = wave & 1, l15 = lane & 15, quad = lane >> 4;
    f32x4 acc[4][4];
#pragma unroll
    for (int i = 0; i < 4; ++i)
#pragma unroll
        for (int j = 0; j < 4; ++j) acc[i][j] = (f32x4){0.f, 0.f, 0.f, 0.f};
    const int srow = lane >> 3, skc = (lane & 7) ^ (lane >> 3);
    const bf16_t* Ag = A + (size_t)(m0 + wave * 8 + srow) * lda + skc * 8;
    const bf16_t* Bg = Bt + (size_t)(n0 + wave * 8 + srow) * ldb + skc * 8;
    const size_t a32 = (size_t)32 * lda, b32 = (size_t)32 * ldb;
    const int sw = l15 & 7;
    for (int k0 = 0; k0 < K; k0 += 64) {
        __syncthreads();
#pragma unroll
        for (int i = 0; i < 4; ++i) {
            __builtin_amdgcn_global_load_lds((const unsigned*)(Ag + i * a32 + k0), (__attribute__((address_space(3))) unsigned*)(sA + (i * 4 + wave) * 1024), 16, 0, 0);
            __builtin_amdgcn_global_load_lds((const unsigned*)(Bg + i * b32 + k0), (__attribute__((address_space(3))) unsigned*)(sB + (i * 4 + wave) * 1024), 16, 0, 0);
        }
        asm volatile("s_waitcnt vmcnt(0)" ::: "memory");
        __syncthreads();
#pragma unroll
        for (int ks = 0; ks < 2; ++ks) {
            bf16x8 wf[4], xf[4];
            const int co = ((ks * 4 + quad) ^ sw) * 16;
#pragma unroll
            for (int t = 0; t < 4; ++t) {
                wf[t] = *(const bf16x8*)(sB + (wn * 64 + t * 16 + l15) * 128 + co);
                xf[t] = *(const bf16x8*)(sA + (wm * 64 + t * 16 + l15) * 128 + co);
            }
#pragma unroll
            for (int nt = 0; nt < 4; ++nt)
#pragma unroll
                for (int mt = 0; mt < 4; ++mt) acc[nt][mt] = __builtin_amdgcn_mfma_f32_16x16x32_bf16(wf[nt], xf[mt], acc[nt][mt], 0, 0, 0);
        }
    }
    if constexpr (IsRes<Epi>::value) {
#pragma unroll
        for (int nt = 0; nt < 4; ++nt) {
            f32x4 xv[4], gv[4];
#pragma unroll
            for (int mt = 0; mt < 4; ++mt) epi.loadxg(m0 + wm * 64 + mt * 16 + l15, n0 + wn * 64 + nt * 16 + quad * 4, xv[mt], gv[mt]);
#pragma unroll
            for (int mt = 0; mt < 4; ++mt) epi.storex(m0 + wm * 64 + mt * 16 + l15, n0 + wn * 64 + nt * 16 + quad * 4, xv[mt], gv[mt], acc[nt][mt]);
        }
    } else if constexpr (HasCV<Epi>::value) {
        f32x4 cv4[4];
#pragma unroll
        for (int nt = 0; nt < 4; ++nt) cv4[nt] = epi.colvec(n0 + wn * 64 + nt * 16 + quad * 4);
#pragma unroll
        for (int nt = 0; nt < 4; ++nt)
#pragma unroll
            for (int mt = 0; mt < 4; ++mt) epi.apply(m0 + wm * 64 + mt * 16 + l15, n0 + wn * 64 + nt * 16 + quad * 4, acc[nt][mt], cv4[nt]);
    } else if constexpr (HasRS<Epi>::value) {
        float rs4[4];
#pragma unroll
        for (int mt = 0; mt < 4; ++mt) rs4[mt] = epi.rowscale(m0 + wm * 64 + mt * 16 + l15);
#pragma unroll
        for (int nt = 0; nt < 4; ++nt)
#pragma unroll
            for (int mt = 0; mt < 4; ++mt) epi.apply(m0 + wm * 64 + mt * 16 + l15, n0 + wn * 64 + nt * 16 + quad * 4, acc[nt][mt], rs4[mt]);
    } else {
#pragma unroll
        for (int nt = 0; nt < 4; ++nt)
#pragma unroll
            for (int mt = 0; mt < 4; ++mt) epi(m0 + wm * 64 + mt * 16 + l15, n0 + wn * 64 + nt * 16 + quad * 4, acc[nt][mt]);
    }
}

DI void tile_mn(int t, int nn, int& mt, int& nt) { const int sup = t / (8 * nn), tin = t - sup * 8 * nn; mt = sup * 8 + (tin & 7); nt = tin >> 3; }

struct EpiIn {
    bf16_t *naqk, *vta, *gq, *vtb, *mlar, *rwr;
    DI void operator()(int m, int n, f32x4 v) const {
        if (n >= INC) return;
        if (n < 512) {
            const float s = (n < 256) ? QS64 : 1.f;
            st4(naqk + (size_t)m * LDNA + n, v[0] * s, v[1] * s, v[2] * s, v[3] * s);
        } else if (n < 768) {
            const int b = m / TPB, tib = m - b * TPB;
            bf16_t* d = vta + ((size_t)b * 256 + (n - 512)) * TPB + tib;
            d[0] = f2bf(v[0]); d[TPB] = f2bf(v[1]); d[2 * TPB] = f2bf(v[2]); d[3 * TPB] = f2bf(v[3]);
        } else if (n < 1152) {
            st4(gq + (size_t)m * 384 + (n - 768), v[0], v[1], v[2], v[3]);
        } else if (n < 1280) {
            const int b = m / TPB, tib = m - b * TPB;
            bf16_t* d = vtb + ((size_t)b * 128 + (n - 1152)) * TPB + tib;
            d[0] = f2bf(v[0]); d[TPB] = f2bf(v[1]); d[2 * TPB] = f2bf(v[2]); d[3 * TPB] = f2bf(v[3]);
        } else if (n < 1696) {
            st4(mlar + (size_t)m * 416 + (n - 1280), v[0], v[1], v[2], v[3]);
        } else {
            st4(rwr + (size_t)m * 1184 + (n - 1696), v[0], v[1], v[2], v[3]);
        }
    }
};

DI void rope_rot(float& a, float& b, int pos, float fidx, float fscale) {
    const float ang = (float)pos * __builtin_amdgcn_exp2f(-fidx * fscale);
    const float c = __cosf(ang), s = __sinf(ang);
    const float a2 = a * c - b * s, b2 = a * s + b * c;
    a = a2; b = b2;
}

struct EpiUQ {
    bf16_t* qc; const float* rsm;
    DI float rowscale(int m) const { return rsm[m * 2] * QS96; }
    DI void operator()(int m, int n, f32x4 v) const { apply(m, n, v, rowscale(m)); }
    DI void apply(int m, int n, f32x4 v, float rs) const {
        float a = v[0] * rs, b = v[1] * rs, c = v[2] * rs, d = v[3] * rs;
        const int h = n / 96, dd = n - h * 96;
        const int bb = m / TPB, tib = m - bb * TPB;
        if (dd >= 64 && tib >= 256) {
            const int t = tib - 256, row = t >> 6, col = t & 63;
            const int i0 = (dd - 64) >> 1, i1 = i0 + 1;
            rope_rot(a, b, i0 < 8 ? row : col, (float)(i0 & 7), ROPE_L2T / 8.f);
            rope_rot(c, d, i1 < 8 ? row : col, (float)(i1 & 7), ROPE_L2T / 8.f);
        }
        st4(qc + (size_t)m * 384 + n, a, b, c, d);
    }
};
struct EpiUKV {
    bf16_t *kc, *vtc; const float* rsm;
    DI float rowscale(int m) const { return rsm[m * 2 + 1]; }
    DI void operator()(int m, int n, f32x4 v) const { apply(m, n, v, rowscale(m)); }
    DI void apply(int m, int n, f32x4 v, float rs) const {
        const int h = n >> 7, dd = n & 127;
        if (dd < 64) {
            st4(kc + (size_t)m * 384 + h * 96 + dd, v[0] * rs, v[1] * rs, v[2] * rs, v[3] * rs);
        } else {
            const int b = m / TPB, tib = m - b * TPB;
            bf16_t* d = vtc + ((size_t)b * 256 + h * 64 + (dd - 64)) * TPB + tib;
            d[0] = f2bf(v[0] * rs); d[TPB] = f2bf(v[1] * rs); d[2 * TPB] = f2bf(v[2] * rs); d[3 * TPB] = f2bf(v[3] * rs);
        }
    }
};
struct EpiAux {
    bf16_t *dec, *gate; const float *w0, *a0;
    DI f32x4 colvec(int n) const {
        const int j = n >> 8, c = n & 255;
        if (j < 2) return *(const f32x4*)(w0 + j * 256 + c);
        if (j < 4) return *(const f32x4*)(a0 + (j - 2) * 256 + c);
        return (f32x4){0.f, 0.f, 0.f, 0.f};
    }
    DI void operator()(int m, int n, f32x4 v) const { apply(m, n, v, colvec(n)); }
    DI void apply(int m, int n, f32x4 v, f32x4 off) const {
        const int j = n >> 8, c = n & 255;
        float o[4];
        if (j < 2) {
#pragma unroll
            for (int r = 0; r < 4; ++r) {
                const float u = off[r] + v[r];
                const float z = -u;
                const float sp = fmaxf(z, 0.f) + __logf(1.f + __expf(-fabsf(z)));
                const float w = -sp - 0.5f;
                const float e = __expf(w);
                o[r] = 1.f - __expf(-e);
            }
            st4(dec + (size_t)m * 1024 + j * 256 + c, o[0], o[1], o[2], o[3]);
        } else if (j < 4) {
#pragma unroll
            for (int r = 0; r < 4; ++r) o[r] = sigm(off[r] + v[r]);
            st4(dec + (size_t)m * 1024 + 512 + (j - 2) * 256 + c, o[0], o[1], o[2], o[3]);
        } else {
            st4(gate + (size_t)m * 256 + c, v[0], v[1], v[2], v[3]);
        }
    }
};
struct EpiRes {
    const float *srcl, *srcc; float *dstl, *dstc; const float* modg;
    DI void loadxg(int m, int n, f32x4& x, f32x4& g) const {
        const int b = m / TPB, tib = m - b * TPB;
        const float* s; int mr;
        if (tib < 256) { s = srcc + ((size_t)b * 256 + tib) * 1024 + n; mr = 8; }
        else { s = srcl + ((size_t)b * 4096 + (tib - 256)) * 1024 + n; mr = b; }
        g = *(const f32x4*)(modg + mr * 6144 + n);
        x = *(const f32x4*)s;
    }
    DI void storex(int m, int n, const f32x4& x, const f32x4& g, f32x4 v) const {
        const int b = m / TPB, tib = m - b * TPB;
        float* d = (tib < 256) ? dstc + ((size_t)b * 256 + tib) * 1024 + n : dstl + ((size_t)b * 4096 + (tib - 256)) * 1024 + n;
        *(f32x4*)d = x + g * v;
    }
    DI void operator()(int m, int n, f32x4 v) const { f32x4 x, g; loadxg(m, n, x, g); storex(m, n, x, g, v); }
};
template <class T> struct IsRes { static constexpr bool value = false; };
template <class T> struct HasRS { static constexpr bool value = false; };
template <> struct HasRS<EpiUQ> { static constexpr bool value = true; };
template <> struct HasRS<EpiUKV> { static constexpr bool value = true; };
template <class T> struct HasCV { static constexpr bool value = false; };
template <> struct HasCV<EpiAux> { static constexpr bool value = true; };
template <> struct IsRes<EpiRes> { static constexpr bool value = true; };
struct EpiFc1 {
    bf16_t* hid;
    DI void operator()(int m, int n, f32x4 v) const {
        float a = fmaxf(v[0], 0.f), b = fmaxf(v[1], 0.f), c = fmaxf(v[2], 0.f), d = fmaxf(v[3], 0.f);
        st4(hid + (size_t)m * LDHID + n, a * a, b * b, c * c, d * d);
    }
};

DI void phase_mod(const Params& p, char* smem) {
    float* sc = (float*)smem;
    float* red = sc + 9 * 1024;
    const int tid = gtid(), lane = tid & 63, wave = tid >> 6;
    for (int i = tid; i < 9 * 1024; i += 256) { const float v = (i < 8192) ? p.in[I_C][i] : p.in[I_CCTX][i - 8192]; sc[i] = v / (1.f + __expf(-v)); }
    __syncthreads();
    float* mod = (float*)(p.ws + O_MOD);
    for (int item = blockIdx.x; item < 4 * 96; item += gridDim.x) {
        const int l = item / 96, nb = (item % 96) * 64;
        const float* w = p.in[I_WMOD] + (size_t)l * 1024 * 6144 + nb + lane;
        float acc[9];
#pragma unroll
        for (int r = 0; r < 9; ++r) acc[r] = 0.f;
#pragma unroll 8
        for (int k = wave * 256; k < wave * 256 + 256; ++k) {
            const float wv = w[(size_t)k * 6144];
#pragma unroll
            for (int r = 0; r < 9; ++r) acc[r] += sc[r * 1024 + k] * wv;
        }
#pragma unroll
        for (int r = 0; r < 9; ++r) red[(wave * 9 + r) * 64 + lane] = acc[r];
        __syncthreads();
        for (int i = tid; i < 9 * 64; i += 256) {
            const int r = i >> 6, ln = i & 63;
            const float s = red[(0 * 9 + r) * 64 + ln] + red[(1 * 9 + r) * 64 + ln] + red[(2 * 9 + r) * 64 + ln] + red[(3 * 9 + r) * 64 + ln];
            mod[((size_t)l * 9 + r) * 6144 + nb + ln] = s + p.in[I_BMOD][l * 6144 + nb + ln];
        }
        __syncthreads();
    }
}

DI void wconv_tile(const float* src, const float* g, int K, int N, bf16_t* dst, int nkt, int ldd, int t, char* smem) {
    float* tile = (float*)smem;
    const int tid = gtid();
    const int kt = t % nkt, nt = t / nkt, k0 = kt * 64, n0 = nt * 64;
    __syncthreads();
#pragma unroll 4
    for (int i = 0; i < 16; ++i) {
        const int kl = (tid >> 6) + 4 * i, nl = tid & 63, k = k0 + kl, n = n0 + nl;
        float v = 0.f;
        if (k < K && n < N) { v = src[(size_t)k * N + n]; if (g) v *= g[k]; }
        tile[kl * 65 + nl] = v;
    }
    __syncthreads();
#pragma unroll 4
    for (int i = 0; i < 8; ++i) {
        const int nl = (tid >> 5) + 8 * i, kl = (tid & 31) * 2;
        *(unsigned*)(dst + (size_t)(n0 + nl) * ldd + k0 + kl) = pk2(tile[kl * 65 + nl], tile[(kl + 1) * 65 + nl]);
    }
}
DI void wconv(const float* src, const float* g, int K, int N, bf16_t* dst, int Kp, int Np, int ldd, int rot, char* smem) {
    const int nkt = Kp / 64, nnt = Np / 64, G = gridDim.x;
    for (int t = (blockIdx.x + G - (rot % G)) % G; t < nkt * nnt; t += G) wconv_tile(src, g, K, N, dst, nkt, ldd, t, smem);
}
DI void wconv_late(const Params& p, int l, int u, char* smem) {
    char* ws = p.ws;
    if (u < 1024) wconv_tile(p.in[I_FC1] + (size_t)l * 1024 * 4096, nullptr, 1024, 4096, (bf16_t*)(ws + O_WFC1), 16, LDW1, u, smem);
    else if (u < 2048) wconv_tile(p.in[I_FC2] + (size_t)l * 4096 * 1024, nullptr, 4096, 1024, (bf16_t*)(ws + O_WFC2), 64, LDW4, u - 1024, smem);
    else wconv_tile(p.in[I_WOUT] + (size_t)l * 1024 * 1024, nullptr, 1024, 1024, (bf16_t*)(ws + O_WOUT), 16, LDW1, u - 2048, smem);
}
DI void wconv_early(const Params& p, int l, int u, char* smem) {
    char* ws = p.ws;
    if (u < 736) wconv_tile(p.in[I_WIN] + (size_t)l * 1024 * INC, nullptr, 1024, INC, (bf16_t*)(ws + O_WIN), 16, LDW1, u, smem);
    else if (u < 760) wconv_tile(p.in[I_WUQ] + (size_t)l * 256 * 384, p.in[I_MQN] + l * 256, 256, 384, (bf16_t*)(ws + O_WUQ), 4, 256, u - 736, smem);
    else if (u < 776) wconv_tile(p.in[I_WUKV] + (size_t)l * 128 * 512, p.in[I_MKVN] + l * 128, 128, 512, (bf16_t*)(ws + O_WUKV), 2, 128, u - 760, smem);
    else if (u < 792) {
        const int v = u - 776, j = v >> 2, d = j & 1;
        const float* src = (j < 2 ? p.in[I_W2] : p.in[I_A2]) + (size_t)(l * 2 + d) * 64 * 256;
        wconv_tile(src, nullptr, 64, 256, (bf16_t*)(ws + O_WAUX) + (size_t)j * 256 * 64, 1, 64, v & 3, smem);
    } else wconv_tile(p.in[I_G2] + (size_t)l * 160 * 256, nullptr, 160, 256, (bf16_t*)(ws + O_WG2), 3, 192, u - 792, smem);
}

DI void phase_wconv(const Params& p, int l, char* smem) {
    char* ws = p.ws;
    wconv(p.in[I_WIN] + (size_t)l * 1024 * INC, nullptr, 1024, INC, (bf16_t*)(ws + O_WIN), 1024, INP, LDW1, 0, smem);
    wconv(p.in[I_WUQ] + (size_t)l * 256 * 384, p.in[I_MQN] + l * 256, 256, 384, (bf16_t*)(ws + O_WUQ), 256, 384, 256, 3040, smem);
    wconv(p.in[I_WUKV] + (size_t)l * 128 * 512, p.in[I_MKVN] + l * 128, 128, 512, (bf16_t*)(ws + O_WUKV), 128, 512, 128, 3064, smem);
    for (int d = 0; d < 2; ++d) {
        wconv(p.in[I_W2] + (size_t)(l * 2 + d) * 64 * 256, nullptr, 64, 256, (bf16_t*)(ws + O_WAUX) + d * 256 * 64, 64, 256, 64, 3080 + d * 4, smem);
        wconv(p.in[I_A2] + (size_t)(l * 2 + d) * 64 * 256, nullptr, 64, 256, (bf16_t*)(ws + O_WAUX) + (2 + d) * 256 * 64, 64, 256, 64, 3088 + d * 4, smem);
    }
    wconv(p.in[I_G2] + (size_t)l * 160 * 256, nullptr, 160, 256, (bf16_t*)(ws + O_WG2), 192, 256, 192, 3096, smem);
}

DI void phase_norm(const float* xl, const float* xc, const float* g, const float* modl, int shi, int sci, bf16_t* dst) {
    const int tid = gtid(), lane = tid & 63, wave = tid >> 6;
    for (int tok = blockIdx.x * 4 + wave; tok < NT; tok += gridDim.x * 4) {
        const int b = tok / TPB, tib = tok - b * TPB;
        const float* row; int mr;
        if (tib < 256) { row = xc + ((size_t)b * 256 + tib) * 1024; mr = 8; } else { row = xl + ((size_t)b * 4096 + tib - 256) * 1024; mr = b; }
        const float* sh = modl + mr * 6144 + shi * 1024;
        const float* sc = modl + mr * 6144 + sci * 1024;
        f32x4 v[4]; float ss = 0.f;
#pragma unroll
        for (int i = 0; i < 4; ++i) { v[i] = ((const f32x4*)row)[lane + 64 * i]; ss += v[i].x * v[i].x + v[i].y * v[i].y + v[i].z * v[i].z + v[i].w * v[i].w; }
        ss = wsum64(ss);
        const float rs = rsqrtf(ss * (1.f / 1024.f) + 1e-6f);
#pragma unroll
        for (int i = 0; i < 4; ++i) {
            const int c = (lane + 64 * i) * 4;
            const float4 g4 = *(const float4*)(g + c), s4 = *(const float4*)(sc + c), h4 = *(const float4*)(sh + c);
            st4(dst + (size_t)tok * LDH + c, v[i].x * rs * g4.x * (1.f + s4.x) + h4.x, v[i].y * rs * g4.y * (1.f + s4.y) + h4.y,
                v[i].z * rs * g4.z * (1.f + s4.z) + h4.z, v[i].w * rs * g4.w * (1.f + s4.w) + h4.w);
        }
    }
}

DI void phase_post(const Params& p, int l) {
    const int tid = gtid(), lane = tid & 63, wave = tid >> 6;
    char* ws = p.ws;
    bf16_t* gq = (bf16_t*)(ws + O_GQ);
    const bf16_t* mlar = (const bf16_t*)(ws + O_MLAR);
    bf16_t* kc = (bf16_t*)(ws + O_KC);
    float* rsm = (float*)(ws + O_RSM);
    const bf16_t* rwr = (const bf16_t*)(ws + O_RWR);
    bf16_t* rkv = (bf16_t*)(ws + O_RKV);
    bf16_t* acat = (bf16_t*)(ws + O_HBUF);
    float* invn = (float*)(ws + O_INVN);
    const float* gqn = p.in[I_GQN] + l * 64;
    const float* gkn = p.in[I_GKN] + l * 64;
    const float* taps = p.in[I_SHIFT] + (size_t)l * 3 * 1184;
    const float* kkw = p.in[I_KK] + (size_t)l * 512;
    for (int tok = blockIdx.x * 4 + wave; tok < NT; tok += gridDim.x * 4) {
        const int b = tok / TPB, tib = tok - b * TPB;
        const bool lat = tib >= 256;
        const int t = tib - 256, prow = t >> 6, pcol = t & 63;
        unsigned gqu[3];
#pragma unroll
        for (int it = 0; it < 3; ++it) gqu[it] = *(const unsigned*)(gq + (size_t)tok * 384 + (it * 2 + (lane >> 5)) * 64 + (lane & 31) * 2);
        const bf16_t* mr = mlar + (size_t)tok * 416;
        const uint2 uq = *(const uint2*)(mr + lane * 4);
        const unsigned ukv = *(const unsigned*)(mr + 256 + lane * 2);
        const unsigned ukr = *(const unsigned*)(mr + 384 + (lane & 15) * 2);
        {
            const int pair = lane & 31;
#pragma unroll
            for (int it = 0; it < 3; ++it) {
                const int head = it * 2 + (lane >> 5);
                unsigned* ptr = (unsigned*)(gq + (size_t)tok * 384 + head * 64 + pair * 2);
                const unsigned u = gqu[it];
                float x1 = lo2f(u), x2 = hi2f(u);
                float ss = x1 * x1 + x2 * x2;
                ss += __shfl_xor(ss, 1); ss += __shfl_xor(ss, 2); ss += __shfl_xor(ss, 4); ss += __shfl_xor(ss, 8); ss += __shfl_xor(ss, 16);
                const float rs = rsqrtf(ss * (1.f / 64.f) + 1e-6f);
                const float* gg = head < 4 ? gqn : gkn;
                x1 *= rs * gg[pair * 2]; x2 *= rs * gg[pair * 2 + 1];
                if (lat) rope_rot(x1, x2, pair < 16 ? prow : pcol, (float)(pair & 15), ROPE_L2T / 16.f);
                if (head < 4) { x1 *= QS64; x2 *= QS64; }
                *ptr = pk2(x1, x2);
            }
        }
        {
            float a0 = lo2f(uq.x), a1 = hi2f(uq.x), a2 = lo2f(uq.y), a3 = hi2f(uq.y);
            float sq = wsum64(a0 * a0 + a1 * a1 + a2 * a2 + a3 * a3);
            float c0 = lo2f(ukv), c1 = hi2f(ukv);
            float sk = wsum64(c0 * c0 + c1 * c1);
            if (lane == 0) { rsm[tok * 2] = rsqrtf(sq * (1.f / 256.f) + 1e-6f); rsm[tok * 2 + 1] = rsqrtf(sk * (1.f / 128.f) + 1e-6f); }
            if (lane < 16) {
                const unsigned u = ukr;
                float x1 = lo2f(u), x2 = hi2f(u);
                if (lat) rope_rot(x1, x2, lane < 8 ? prow : pcol, (float)(lane & 7), ROPE_L2T / 8.f);
                const unsigned o = pk2(x1, x2);
#pragma unroll
                for (int h = 0; h < 4; ++h) *(unsigned*)(kc + (size_t)tok * 384 + h * 96 + 64 + lane * 2) = o;
            }
        }
        {
            const bool hasp = (tib != 0) && (tib != 256);
            const bool hasn = (tib != 255) && (tib != TPB - 1);
            const bf16_t* r0 = rwr + (size_t)tok * 1184;
#pragma unroll
            for (int hb = 0; hb < 5; ++hb) {
            unsigned X0[2], X1[2], X2[2];
#pragma unroll
            for (int ii = 0; ii < 2; ++ii) {
                const int c = (lane + 64 * (hb * 2 + ii)) * 2;
                X0[ii] = 0u; X1[ii] = 0u; X2[ii] = 0u;
                if (c < 1184) {
                    X1[ii] = *(const unsigned*)(r0 + c);
                    if (hasp) X0[ii] = *(const unsigned*)(r0 + c - 1184);
                    if (hasn) X2[ii] = *(const unsigned*)(r0 + c + 1184);
                }
            }
#pragma unroll
            for (int ii = 0; ii < 2; ++ii) {
                const int i = hb * 2 + ii;
                const int c = (lane + 64 * i) * 2;
                float u0 = 0.f, u1 = 0.f;
                if (c < 1184) {
                    const float2 t1 = *(const float2*)(taps + 1184 + c);
                    u0 = lo2f(X1[ii]) * t1.x; u1 = hi2f(X1[ii]) * t1.y;
                    if (hasp) { const float2 t0 = *(const float2*)(taps + c); u0 += lo2f(X0[ii]) * t0.x; u1 += hi2f(X0[ii]) * t0.y; }
                    if (hasn) { const float2 t2 = *(const float2*)(taps + 2 * 1184 + c); u0 += lo2f(X2[ii]) * t2.x; u1 += hi2f(X2[ii]) * t2.y; }
                }
                if (i < 6) {
                    const unsigned pk = pk2(u0, u1);
                    *(unsigned*)(rkv + (size_t)tok * 768 + c) = pk;
                    if (i == 2 || i == 3) {
                        const float k0 = lo2f(pk), k1 = hi2f(pk);
                        const float2 f0 = *(const float2*)(kkw + c - 256), f1 = *(const float2*)(kkw + 256 + c - 256);
                        float s0 = (k0 * f0.x) * (k0 * f0.x) + (k1 * f0.y) * (k1 * f0.y);
                        float s1 = (k0 * f1.x) * (k0 * f1.x) + (k1 * f1.y) * (k1 * f1.y);
                        s0 = sum16(s0); s1 = sum16(s1);
                        s0 += __shfl_xor(s0, 16); s1 += __shfl_xor(s1, 16);
                        if ((lane & 31) == 0) {
                            const int hd = (i - 2) * 2 + (lane >> 5);
                            invn[tok * 8 + hd] = 1.f / fmaxf(sqrtf(s0), 1e-12f);
                            invn[tok * 8 + 4 + hd] = 1.f / fmaxf(sqrtf(s1), 1e-12f);
                        }
                    }
                } else if (i == 6) {
                    *(unsigned*)(acat + (size_t)tok * 448 + (c - 768)) = pk2(tanhf(u0), tanhf(u1));
                } else if (i == 7) {
                    *(unsigned*)(acat + (size_t)tok * 448 + 128 + (c - 896)) = pk2(u0, u1);
                } else {
                    const int cc = c - 1024;
                    if (cc < 192) *(unsigned*)(acat + (size_t)tok * 448 + 256 + cc) = (cc < 160) ? pk2(sigm(u0), sigm(u1)) : 0u;
                }
            }
            }
        }
    }
}

template <int DK, bool NAM>
DI void attn_item(const bf16_t* __restrict__ Q, int ldq, const bf16_t* __restrict__ Kb, int ldk, const bf16_t* __restrict__ Vt,
                          int s0, int nt0, int s1, int nt1, bf16_t* __restrict__ O, int qr0, const float* rpb_g, char* smem) {
    constexpr int KS = DK + 16, KCH = DK / 8, NKC = 64 * KCH / 256;
    bf16_t* sK = (bf16_t*)smem;
    bf16_t* sV = sK + 64 * 112;
    float* sR = (float*)(sV + 64 * 72);
    const int tid = gtid(), lane = tid & 63, wave = tid >> 6, l15 = lane & 15, quad = lane >> 4;
    const int ntot = nt0 + nt1;
    if (NAM) {
        __syncthreads();
        for (int i = tid; i < 465; i += 256) sR[i] = rpb_g[i] * LOG2E;
    }
    bf16x8 qf[2][DK / 32];
#pragma unroll
    for (int qt = 0; qt < 2; ++qt)
#pragma unroll
        for (int ks = 0; ks < DK / 32; ++ks) qf[qt][ks] = *(const bf16x8*)(Q + (size_t)(wave * 32 + qt * 16 + l15) * ldq + ks * 32 + quad * 8);
    f32x4 Oa[4][2];
#pragma unroll
    for (int i = 0; i < 4; ++i) { Oa[i][0] = (f32x4){0.f, 0.f, 0.f, 0.f}; Oa[i][1] = (f32x4){0.f, 0.f, 0.f, 0.f}; }
    float mrun[2] = {-1e30f, -1e30f}, lrun[2] = {0.f, 0.f};
    u32x4 rk[NKC], rv[2];
    {
        const int key0 = (0 < nt0) ? s0 : s1;
#pragma unroll
        for (int i = 0; i < NKC; ++i) { const int c = tid + 256 * i, row = c / KCH, kc = c % KCH; rk[i] = *(const u32x4*)(Kb + (size_t)(key0 + row) * ldk + kc * 8); }
#pragma unroll
        for (int i = 0; i < 2; ++i) { const int c = tid + 256 * i, row = c >> 3, kc = c & 7; rv[i] = *(const u32x4*)(Vt + (size_t)row * TPB + key0 + kc * 8); }
    }
    for (int j = 0; j < ntot; ++j) {
        __syncthreads();
#pragma unroll
        for (int i = 0; i < NKC; ++i) { const int c = tid + 256 * i, row = c / KCH, kc = c % KCH; *(u32x4*)(sK + row * KS + kc * 8) = rk[i]; }
#pragma unroll
        for (int i = 0; i < 2; ++i) { const int c = tid + 256 * i, row = c >> 3, kc = c & 7; *(u32x4*)(sV + row * 72 + kc * 8) = rv[i]; }
        __syncthreads();
        if (j + 1 < ntot) {
            const int jn = j + 1;
            const int key0 = (jn < nt0) ? (s0 + 64 * jn) : (s1 + 64 * (jn - nt0));
#pragma unroll
            for (int i = 0; i < NKC; ++i) { const int c = tid + 256 * i, row = c / KCH, kc = c % KCH; rk[i] = *(const u32x4*)(Kb + (size_t)(key0 + row) * ldk + kc * 8); }
#pragma unroll
            for (int i = 0; i < 2; ++i) { const int c = tid + 256 * i, row = c >> 3, kc = c & 7; rv[i] = *(const u32x4*)(Vt + (size_t)row * TPB + key0 + kc * 8); }
        }
        f32x4 S[4][2];
#pragma unroll
        for (int kt = 0; kt < 4; ++kt) { S[kt][0] = (f32x4){0.f, 0.f, 0.f, 0.f}; S[kt][1] = (f32x4){0.f, 0.f, 0.f, 0.f}; }
#pragma unroll
        for (int ks = 0; ks < DK / 32; ++ks)
#pragma unroll
            for (int kt = 0; kt < 4; ++kt) {
                const bf16x8 kf = *(const bf16x8*)(sK + (kt * 16 + l15) * KS + ks * 32 + quad * 8);
                S[kt][0] = __builtin_amdgcn_mfma_f32_16x16x32_bf16(kf, qf[0][ks], S[kt][0], 0, 0, 0);
                S[kt][1] = __builtin_amdgcn_mfma_f32_16x16x32_bf16(kf, qf[1][ks], S[kt][1], 0, 0, 0);
            }
        if (NAM) {
            if (j >= nt0) {
                const int kr = (s1 - 256) / 64 + (j - nt0);
#pragma unroll
                for (int qt = 0; qt < 2; ++qt) {
                    const int qi = wave * 32 + qt * 16 + l15, qrow = qr0 + (qi >> 6), qc = qi & 63;
                    const int st = clampi(qrow - 4, 0, 56), cs = clampi(qc - 8, 0, 48);
                    const bool rowok = (kr >= st) && (kr < st + 8);
                    const int rbase = (kr - qrow + 7) * 31 - qc + 15;
#pragma unroll
                    for (int kt = 0; kt < 4; ++kt)
#pragma unroll
                        for (int r = 0; r < 4; ++r) {
                            const int kcx = kt * 16 + quad * 4 + r;
                            const bool ok = rowok && (kcx >= cs) && (kcx < cs + 16);
                            const float bias = sR[ok ? (rbase + kcx) : 0];
                            S[kt][qt][r] = ok ? (S[kt][qt][r] + bias) : -1e30f;
                        }
                }
            }
        }
        bf16x8 pf[2][2];
#pragma unroll
        for (int qt = 0; qt < 2; ++qt) {
            float mx = -1e30f;
#pragma unroll
            for (int kt = 0; kt < 4; ++kt)
#pragma unroll
                for (int r = 0; r < 4; ++r) mx = fmaxf(mx, S[kt][qt][r]);
            mx = fmaxf(mx, __shfl_xor(mx, 16));
            mx = fmaxf(mx, __shfl_xor(mx, 32));
            const float mnew = fmaxf(mrun[qt], mx);
            const float alpha = __builtin_amdgcn_exp2f(mrun[qt] - mnew);
            mrun[qt] = mnew;
            float ps = 0.f;
#pragma unroll
            for (int kt = 0; kt < 4; ++kt)
#pragma unroll
                for (int r = 0; r < 4; ++r) { const float pv = __builtin_amdgcn_exp2f(S[kt][qt][r] - mnew); S[kt][qt][r] = pv; ps += pv; }
            lrun[qt] = lrun[qt] * alpha + ps;
            if (__any(alpha != 1.f)) {
#pragma unroll
                for (int dt = 0; dt < 4; ++dt) { Oa[dt][qt][0] *= alpha; Oa[dt][qt][1] *= alpha; Oa[dt][qt][2] *= alpha; Oa[dt][qt][3] *= alpha; }
            }
#pragma unroll
            for (int s = 0; s < 2; ++s) {
                u32x4 f;
                f[0] = pk2(S[2 * s][qt][0], S[2 * s][qt][1]); f[1] = pk2(S[2 * s][qt][2], S[2 * s][qt][3]);
                f[2] = pk2(S[2 * s + 1][qt][0], S[2 * s + 1][qt][1]); f[3] = pk2(S[2 * s + 1][qt][2], S[2 * s + 1][qt][3]);
                pf[qt][s] = __builtin_bit_cast(bf16x8, f);
            }
        }
#pragma unroll
        for (int s = 0; s < 2; ++s)
#pragma unroll
            for (int dt = 0; dt < 4; ++dt) {
                const bf16x4 v0 = *(const bf16x4*)(sV + (dt * 16 + l15) * 72 + (2 * s) * 16 + quad * 4);
                const bf16x4 v1 = *(const bf16x4*)(sV + (dt * 16 + l15) * 72 + (2 * s + 1) * 16 + quad * 4);
                const bf16x8 vf = __builtin_shufflevector(v0, v1, 0, 1, 2, 3, 4, 5, 6, 7);
                Oa[dt][0] = __builtin_amdgcn_mfma_f32_16x16x32_bf16(vf, pf[0][s], Oa[dt][0], 0, 0, 0);
                Oa[dt][1] = __builtin_amdgcn_mfma_f32_16x16x32_bf16(vf, pf[1][s], Oa[dt][1], 0, 0, 0);
            }
    }
#pragma unroll
    for (int qt = 0; qt < 2; ++qt) {
        float lt = lrun[qt];
        lt += __shfl_xor(lt, 16); lt += __shfl_xor(lt, 32);
        const float inv = 1.f / lt;
#pragma unroll
        for (int dt = 0; dt < 4; ++dt)
            st4(O + (size_t)(wave * 32 + qt * 16 + l15) * LDH + dt * 16 + quad * 4, Oa[dt][qt][0] * inv, Oa[dt][qt][1] * inv, Oa[dt][qt][2] * inv, Oa[dt][qt][3] * inv);
    }
}

DI void scan_item(const Params& p, int l, int item, char* smem) {
    float* sT = (float*)smem;
    float* sVv = sT + 16 * 320;
    float* sY = sVv + 256;
    const int tid = gtid(), lane = tid & 63, wave = tid >> 6;
    const int scan = item >> 2, rg = item & 3;
    const int b = scan >> 3, head = (scan >> 1) & 3, dir = scan & 1;
    const bf16_t* rkv = (const bf16_t*)(p.ws + O_RKV);
    const bf16_t* dec = (const bf16_t*)(p.ws + O_DEC);
    const float* invn = (const float*)(p.ws + O_INVN);
    float* yout = (float*)(p.ws + O_Y) + (size_t)dir * NT * 256;
    const int k2 = (tid & 31) * 2, tq = tid >> 5;
    const float* kkw = p.in[I_KK] + (size_t)(l * 2 + dir) * 256 + head * 64;
    const float* kaw = p.in[I_KA] + (size_t)(l * 2 + dir) * 256 + head * 64;
    const float kkc0 = kkw[k2], kkc1 = kkw[k2 + 1], kac0 = kaw[k2], kac1 = kaw[k2 + 1];
    unsigned rr[2], kr[2], ow[2], as[2]; float inn[2]; bf16_t vv;
    const int tbase = b * TPB;
#define SCAN_TOK(s) (tbase + (dir ? ((s) < 256 ? 255 - (s) : 4607 - (s)) : (s)))
#define SCAN_LOAD(ch)                                                                                          \
    {                                                                                                          \
        _Pragma("unroll") for (int i = 0; i < 2; ++i) {                                                        \
            const int tok = SCAN_TOK((ch) * 16 + tq + 8 * i);                                                  \
            rr[i] = *(const unsigned*)(rkv + (size_t)tok * 768 + head * 64 + k2);                              \
            kr[i] = *(const unsigned*)(rkv + (size_t)tok * 768 + 256 + head * 64 + k2);                        \
            ow[i] = *(const unsigned*)(dec + (size_t)tok * 1024 + dir * 256 + head * 64 + k2);                 \
            as[i] = *(const unsigned*)(dec + (size_t)tok * 1024 + 512 + dir * 256 + head * 64 + k2);           \
            inn[i] = invn[tok * 8 + dir * 4 + head];                                                           \
        }                                                                                                      \
        {                                                                                                      \
            const int tok = SCAN_TOK((ch) * 16 + (tid >> 4));                                                  \
            vv = rkv[(size_t)tok * 768 + 512 + head * 64 + rg * 16 + (tid & 15)];                              \
        }                                                                                                      \
    }
#define SCAN_YRED(ch)                                                                                          \
    {                                                                                                          \
        const int tl = tid >> 4, row = tid & 15;                                                               \
        const float* yp = sY + tl * 256 + (row >> 2) * 64 + (row & 3) * 16;                                    \
        const f32x4 q0 = *(const f32x4*)yp, q1 = *(const f32x4*)(yp + 4), q2 = *(const f32x4*)(yp + 8), q3 = *(const f32x4*)(yp + 12);   \
        const f32x4 qs = (q0 + q1) + (q2 + q3);                                                                \
        yout[(size_t)SCAN_TOK((ch) * 16 + tl) * 256 + head * 64 + rg * 16 + row] = (qs[0] + qs[1]) + (qs[2] + qs[3]);   \
    }
    float S0 = 0.f, S1 = 0.f, S2 = 0.f, S3 = 0.f;
    const int c = lane & 15, rloc = wave * 4 + (lane >> 4);
    __builtin_amdgcn_s_setprio(3);
    SCAN_LOAD(0);
    for (int ch = 0; ch < 272; ++ch) {
        __syncthreads();
        if (ch > 0) SCAN_YRED(ch - 1)
#pragma unroll
        for (int i = 0; i < 2; ++i) {
            float* base = sT + (tq + 8 * i) * 320 + k2;
            const float r0 = lo2f(rr[i]), r1 = hi2f(rr[i]), k0 = lo2f(kr[i]), k1 = hi2f(kr[i]);
            const float o0 = lo2f(ow[i]), o1 = hi2f(ow[i]), a0 = lo2f(as[i]), a1 = hi2f(as[i]);
            const float kk0 = k0 * kkc0 * inn[i], kk1 = k1 * kkc1 * inn[i];
            *(float2*)(base) = make_float2(1.f - o0, 1.f - o1);
            *(float2*)(base + 64) = make_float2(kk0, kk1);
            *(float2*)(base + 128) = make_float2(kk0 * a0, kk1 * a1);
            *(float2*)(base + 192) = make_float2(k0 * (1.f + (a0 - 1.f) * kac0), k1 * (1.f + (a1 - 1.f) * kac1));
            *(float2*)(base + 256) = make_float2(r0, r1);
        }
        sVv[tid] = bf2f(vv);
        __syncthreads();
        if (ch + 1 < 272) SCAN_LOAD(ch + 1);
#define SC_LD(bi, t0)                                                                                   \
    _Pragma("unroll") for (int q = 0; q < 2; ++q) {                                                     \
        const float* bp = sT + ((t0) + q) * 320 + c * 4;                                                \
        W4[bi][q] = *(const f32x4*)bp; K4[bi][q] = *(const f32x4*)(bp + 64); B4[bi][q] = *(const f32x4*)(bp + 128);   \
        D4[bi][q] = *(const f32x4*)(bp + 192); R4[bi][q] = *(const f32x4*)(bp + 256); VX[bi][q] = sVv[((t0) + q) * 16 + rloc];  \
    }
#define SC_CP(bi, t0)                                                                                   \
    _Pragma("unroll") for (int q = 0; q < 2; ++q) {                                                     \
        float sa = (S0 * K4[bi][q][0] + S1 * K4[bi][q][1]) + (S2 * K4[bi][q][2] + S3 * K4[bi][q][3]);   \
        sa = sum16(sa);                                                                                 \
        S0 = S0 * W4[bi][q][0] - sa * B4[bi][q][0] + VX[bi][q] * D4[bi][q][0];                          \
        S1 = S1 * W4[bi][q][1] - sa * B4[bi][q][1] + VX[bi][q] * D4[bi][q][1];                          \
        S2 = S2 * W4[bi][q][2] - sa * B4[bi][q][2] + VX[bi][q] * D4[bi][q][2];                          \
        S3 = S3 * W4[bi][q][3] - sa * B4[bi][q][3] + VX[bi][q] * D4[bi][q][3];                          \
        sY[((t0) + q) * 256 + tid] = (S0 * R4[bi][q][0] + S1 * R4[bi][q][1]) + (S2 * R4[bi][q][2] + S3 * R4[bi][q][3]);  \
    }
        {
            f32x4 W4[2][2], K4[2][2], B4[2][2], D4[2][2], R4[2][2]; float VX[2][2];
            SC_LD(0, 0);
#pragma unroll 1
            for (int it = 0; it < 4; ++it) {
                SC_LD(1, it * 4 + 2);
                SC_CP(0, it * 4);
                if (it < 3) SC_LD(0, it * 4 + 4);
                SC_CP(1, it * 4 + 2);
            }
        }
    }
    __syncthreads();
    SCAN_YRED(271)
#undef SC_LD
#undef SC_CP
#undef SCAN_YRED
#undef SCAN_LOAD
#undef SCAN_TOK
    __builtin_amdgcn_s_setprio(0);
}

DI void phase_mix(const Params& p, int l, char* smem, int* s_item) {
    char* ws = p.ws;
    int* ctr = (int*)(ws + O_CTL) + l;
    const bool want_ctx = l < 3;
    const int nattn = 3072 + (want_ctx ? 192 : 0);
    const int total = nattn + 2304 + (l < 3 ? 804 : 0);
    const bf16_t* naqk = (const bf16_t*)(ws + O_NAQK);
    const bf16_t* vta = (const bf16_t*)(ws + O_VTA);
    const bf16_t* gq = (const bf16_t*)(ws + O_GQ);
    const bf16_t* vtb = (const bf16_t*)(ws + O_VTB);
    const bf16_t* qc = (const bf16_t*)(ws + O_QC);
    const bf16_t* kc = (const bf16_t*)(ws + O_KC);
    const bf16_t* vtc = (const bf16_t*)(ws + O_VTC);
    bf16_t* mix = (bf16_t*)(ws + O_HBUF);
    const float* rpb = p.in[I_RPB] + (size_t)l * 4 * 465;
    {
        const int G = gridDim.x, bb = blockIdx.x;
        for (int sidx = 0; sidx < 256; ++sidx) {
            const int owner = (G == 512) ? ((sidx & 127) + (sidx >> 7) * 256) : (sidx % G);
            if (owner == bb) { for (int rep = 0; rep < REP_SCAN; ++rep) scan_item(p, l, sidx, smem); }
        }
    }
    while (true) {
        if (threadIdx.x == 0) *s_item = atomicAdd(ctr, 1);
        __syncthreads();
        const int item = *s_item;
        __syncthreads();
        if (item >= total) break;
        if (item >= nattn) { const int j = item - nattn; if (j < 2304) wconv_late(p, l, j, smem); else wconv_early(p, l + 1, j - 2304, smem); continue; }
        int type, b, h, qtok0, nkt0, qr0 = 0; bool isctx = false;
        if (item < 3072) {
            const int i1 = item;
            type = i1 >> 10;
            const int r = i1 & 1023;
            b = r >> 7; h = (r >> 5) & 3;
            const int qb = r & 31;
            qtok0 = b * TPB + 256 + qb * 128; nkt0 = 68; qr0 = qb * 2;
        } else {
            const int i2 = item - 3072;
            type = i2 >> 6;
            const int r = i2 & 63;
            b = r >> 3; h = (r >> 1) & 3;
            qtok0 = b * TPB + (r & 1) * 128; nkt0 = 4; isctx = true;
        }
        const size_t kb = (size_t)b * TPB;
        for (int rep = 0; rep < REP_ATTN; ++rep) {
            if (type == 0) {
                attn_item<96, false>(qc + (size_t)qtok0 * 384 + h * 96, 384, kc + kb * 384 + h * 96, 384, vtc + ((size_t)b * 256 + h * 64) * TPB,
                                     0, nkt0, 0, 0, mix + (size_t)qtok0 * LDH + 512 + h * 64, 0, nullptr, smem);
            } else if (type == 2 && !isctx) {
                const int st0 = clampi(qr0 - 4, 0, 56), st1 = clampi(qr0 + 1 - 4, 0, 56);
                attn_item<64, true>(naqk + (size_t)qtok0 * LDNA + h * 64, LDNA, naqk + kb * LDNA + 256 + h * 64, LDNA, vta + ((size_t)b * 256 + h * 64) * TPB,
                                    0, 4, 256 + st0 * 64, st1 + 8 - st0, mix + (size_t)qtok0 * LDH + h * 64, qr0, rpb + h * 465, smem);
            } else {
                const bf16_t *Qp, *Kp, *Vp; bf16_t* Op; int ld;
                if (type == 1) {
                    const int kvh = h >> 1;
                    Qp = gq + (size_t)qtok0 * 384 + h * 64; Kp = gq + kb * 384 + 256 + kvh * 64; Vp = vtb + ((size_t)b * 128 + kvh * 64) * TPB;
                    Op = mix + (size_t)qtok0 * LDH + 256 + h * 64; ld = 384;
                } else {
                    Qp = naqk + (size_t)qtok0 * LDNA + h * 64; Kp = naqk + kb * LDNA + 256 + h * 64; Vp = vta + ((size_t)b * 256 + h * 64) * TPB;
                    Op = mix + (size_t)qtok0 * LDH + h * 64; ld = LDNA;
                }
                attn_item<64, false>(Qp, ld, Kp, ld, Vp, 0, nkt0, 0, 0, Op, 0, nullptr, smem);
            }
        }
    }
}

DI void phase_rwkv_fin(const Params& p, int l) {
    const int tid = gtid(), lane = tid & 63, wave = tid >> 6;
    char* ws = p.ws;
    const float* yf = (const float*)(ws + O_Y);
    const float* yb = yf + (size_t)NT * 256;
    const bf16_t* rkv = (const bf16_t*)(ws + O_RKV);
    const bf16_t* dec = (const bf16_t*)(ws + O_DEC);
    const bf16_t* gate = (const bf16_t*)(ws + O_GATE);
    bf16_t* mix = (bf16_t*)(ws + O_HBUF);
    const int c = lane * 4;
    const float4 ka0 = *(const float4*)(p.in[I_KA] + (size_t)(l * 2) * 256 + c), ka1 = *(const float4*)(p.in[I_KA] + (size_t)(l * 2 + 1) * 256 + c);
    const float4 rk0 = *(const float4*)(p.in[I_RK] + (size_t)(l * 2) * 256 + c), rk1 = *(const float4*)(p.in[I_RK] + (size_t)(l * 2 + 1) * 256 + c);
    const float4 lw = *(const float4*)(p.in[I_LNW] + l * 256 + c), lb = *(const float4*)(p.in[I_LNB] + l * 256 + c);
    for (int tok = blockIdx.x * 4 + wave; tok < NT; tok += gridDim.x * 4) {
        const float4 a = *(const float4*)(yf + (size_t)tok * 256 + c), bb = *(const float4*)(yb + (size_t)tok * 256 + c);
        const float y0 = a.x + bb.x, y1 = a.y + bb.y, y2 = a.z + bb.z, y3 = a.w + bb.w;
        const float mu = sum16(y0 + y1 + y2 + y3) * (1.f / 64.f);
        const float d0 = y0 - mu, d1 = y1 - mu, d2 = y2 - mu, d3 = y3 - mu;
        const float var = sum16(d0 * d0 + d1 * d1 + d2 * d2 + d3 * d3) * (1.f / 64.f);
        const float rstd = rsqrtf(var + 64e-5f);
        const uint2 ur = *(const uint2*)(rkv + (size_t)tok * 768 + c), uk = *(const uint2*)(rkv + (size_t)tok * 768 + 256 + c), uv = *(const uint2*)(rkv + (size_t)tok * 768 + 512 + c);
        const uint2 uaf = *(const uint2*)(dec + (size_t)tok * 1024 + 512 + c), uab = *(const uint2*)(dec + (size_t)tok * 1024 + 768 + c);
        const uint2 ug = *(const uint2*)(gate + (size_t)tok * 256 + c);
        const float r0 = lo2f(ur.x), r1 = hi2f(ur.x), r2 = lo2f(ur.y), r3 = hi2f(ur.y);
        const float k0 = lo2f(uk.x), k1 = hi2f(uk.x), k2 = lo2f(uk.y), k3 = hi2f(uk.y);
        const float v0 = lo2f(uv.x), v1 = hi2f(uv.x), v2 = lo2f(uv.y), v3 = hi2f(uv.y);
        const float f0 = lo2f(uaf.x), f1 = hi2f(uaf.x), f2 = lo2f(uaf.y), f3 = hi2f(uaf.y);
        const float b0 = lo2f(uab.x), b1 = hi2f(uab.x), b2 = lo2f(uab.y), b3 = hi2f(uab.y);
        float bs = r0 * k0 * ((1.f + (f0 - 1.f) * ka0.x) * rk0.x + (1.f + (b0 - 1.f) * ka1.x) * rk1.x)
                 + r1 * k1 * ((1.f + (f1 - 1.f) * ka0.y) * rk0.y + (1.f + (b1 - 1.f) * ka1.y) * rk1.y)
                 + r2 * k2 * ((1.f + (f2 - 1.f) * ka0.z) * rk0.z + (1.f + (b2 - 1.f) * ka1.z) * rk1.z)
                 + r3 * k3 * ((1.f + (f3 - 1.f) * ka0.w) * rk0.w + (1.f + (b3 - 1.f) * ka1.w) * rk1.w);
        bs = sum16(bs);
        const float o0 = (d0 * rstd * lw.x + lb.x + bs * v0) * lo2f(ug.x);
        const float o1 = (d1 * rstd * lw.y + lb.y + bs * v1) * hi2f(ug.x);
        const float o2 = (d2 * rstd * lw.z + lb.z + bs * v2) * lo2f(ug.y);
        const float o3 = (d3 * rstd * lw.w + lb.w + bs * v3) * hi2f(ug.y);
        st4(mix + (size_t)tok * LDH + 768 + c, o0, o1, o2, o3);
    }
}

DI void phase_final(const Params& p) {
    const int tid = gtid(), lane = tid & 63, wave = tid >> 6;
    const float* g = p.in[I_FNG];
    for (int row = blockIdx.x * 4 + wave; row < NB * 4096; row += gridDim.x * 4) {
        float* x = p.out + (size_t)row * 1024;
        f32x4 v[4]; float ss = 0.f;
#pragma unroll
        for (int i = 0; i < 4; ++i) { v[i] = ((const f32x4*)x)[lane + 64 * i]; ss += v[i].x * v[i].x + v[i].y * v[i].y + v[i].z * v[i].z + v[i].w * v[i].w; }
        ss = wsum64(ss);
        const float rs = rsqrtf(ss * (1.f / 1024.f) + 1e-6f);
#pragma unroll
        for (int i = 0; i < 4; ++i) {
            const float4 g4 = ((const float4*)g)[lane + 64 * i];
            float4 o; o.x = v[i].x * rs * g4.x; o.y = v[i].y * rs * g4.y; o.z = v[i].z * rs * g4.z; o.w = v[i].w * rs * g4.w;
            ((float4*)x)[lane + 64 * i] = o;
        }
    }
}

#define XB_TMO      128
#define XB_XCNT(j)  (256  + 64 * (j))
#define XB_XSUB(j)  (1280 + 64 * (j))
#define XB_XGEN(j)  (2304 + 64 * (j))
#define XB_TOP      3328
#define XB_TOPGEN   3392
#define XCD_BAR_WORDS 3456
#define XB_SPIN_CAP (1u << 18)
#define LAS __attribute__((address_space(3)))

__device__ __forceinline__ unsigned xb_ld(unsigned* p)              { return __hip_atomic_load(p, __ATOMIC_RELAXED, __HIP_MEMORY_SCOPE_AGENT); }
__device__ __forceinline__ unsigned xb_add(unsigned* p, unsigned v) { return __hip_atomic_fetch_add(p, v, __ATOMIC_RELAXED, __HIP_MEMORY_SCOPE_AGENT); }
__device__ __forceinline__ unsigned xb_xcc_id() { return (unsigned)__builtin_amdgcn_s_getreg((3 << 11) | 20) & 0xFu; }
#define XB_SPIN(cond, bar) do { unsigned _sp = 0; while (cond) { __builtin_amdgcn_s_sleep(1); \
    if ((++_sp & 255u) == 0u) { if (xb_ld(&(bar)[XB_TMO])) break; if (_sp > XB_SPIN_CAP) { atomicAdd(&(bar)[XB_TMO], 1u); break; } } } } while (0)

struct XcdBarrier {
    unsigned* bar; unsigned x;
    volatile LAS unsigned* st;
};

__device__ __forceinline__ XcdBarrier xcd_barrier_post(unsigned* bar, volatile LAS unsigned* st) {
    XcdBarrier b; b.bar = bar; b.x = xb_xcc_id(); b.st = st;
    if (threadIdx.x == 0) (void)xb_add(&bar[XB_XCNT(b.x)], 1u);
    return b;
}
__device__ __forceinline__ void xcd_barrier_complete(unsigned* bar, unsigned x, unsigned& nloc, unsigned& nx) {
    const unsigned G = gridDim.x * gridDim.y * gridDim.z;
    unsigned sum, cnt, mine, sp = 0u;
    for (;;) {
        sum = 0u; cnt = 0u; mine = 0u;
#pragma unroll
        for (unsigned j = 0; j < 16; ++j) { const unsigned c = xb_ld(&bar[XB_XCNT(j)]); sum += c; cnt += (c > 0u) ? 1u : 0u; mine = (j == x) ? c : mine; }
        if (sum == G) break;
        __builtin_amdgcn_s_sleep(1);
        if ((++sp & 255u) == 0u) { if (xb_ld(&bar[XB_TMO])) break; if (sp > XB_SPIN_CAP) { atomicAdd(&bar[XB_TMO], 1u); break; } }
    }
    nloc = mine > 0u ? mine : 1u; nx = cnt > 0u ? cnt : 1u;
}

__device__ __forceinline__ void xcd_barrier(const XcdBarrier& b) {
    asm volatile("s_waitcnt vmcnt(0)" ::: "memory");
    __syncthreads();
    if (threadIdx.x == 0) {
        unsigned* bar = b.bar;
        __builtin_amdgcn_s_waitcnt(0);
        unsigned nloc = b.st[0], nx = b.st[1];
        if (nloc == 0u) { xcd_barrier_complete(bar, b.x, nloc, nx); b.st[0] = nloc; b.st[1] = nx; }
        const unsigned old = xb_add(&bar[XB_XSUB(b.x)], 1u);
        const unsigned gen = old / nloc;
        if (old + 1u == (gen + 1u) * nloc) {
            __builtin_amdgcn_fence(__ATOMIC_RELEASE, "agent");
            asm volatile("s_waitcnt vmcnt(0)" ::: "memory");
            const unsigned og = xb_add(&bar[XB_TOP], 1u);
            const unsigned tg = og / nx;
            if (og + 1u == (tg + 1u) * nx) xb_add(&bar[XB_TOPGEN], 1u);
            else XB_SPIN(xb_ld(&bar[XB_TOPGEN]) == tg, bar);
            __builtin_amdgcn_fence(__ATOMIC_ACQUIRE, "agent");
            xb_add(&bar[XB_XGEN(b.x)], 1u);
            asm volatile("s_waitcnt vmcnt(0)" ::: "memory");
        } else {
            XB_SPIN(xb_ld(&bar[XB_XGEN(b.x)]) == gen, bar);
            __builtin_amdgcn_fence(__ATOMIC_ACQUIRE, "agent");
            asm volatile("s_waitcnt vmcnt(0)" ::: "memory");
        }
    }
    __syncthreads();
}


__global__ void __launch_bounds__(256, 3) mega(Params p) {
    __shared__ __attribute__((aligned(16))) char smem[49152];
    __shared__ int s_item;
    __shared__ uint4 xb_words;
    cg::grid_group grid = cg::this_grid();
    if (threadIdx.x == 0) xb_words = make_uint4(0u, 0u, 0u, 0u);
    __syncthreads();
    XcdBarrier xb = xcd_barrier_post((unsigned*)(p.ws + O_CTL), (volatile LAS unsigned*)&xb_words);
    char* ws = p.ws;
    const int G = gridDim.x;
    const int pb = ((G & 7) == 0) ? ((int)(blockIdx.x & 7) * (G >> 3) + (int)(blockIdx.x >> 3)) : (int)blockIdx.x;
    float* xc = (float*)(ws + O_XC);
    bf16_t* hbuf = (bf16_t*)(ws + O_HBUF);

    phase_mod(p, smem);
    phase_wconv(p, 0, smem);
    grid.sync();
    for (int step = 0; step < 40; ++step) {
        const int l = step / 10, ph = step - l * 10;
        const float* modl = (const float*)(ws + O_MOD) + (size_t)l * 9 * 6144;
        const float* xl_src = (l == 0) ? p.in[I_X] : p.out;
        const float* xc_src = (l == 0) ? p.in[I_CTX] : xc;
        switch (ph) {
        case 0: {
            for (int rep = 0; rep < REP_EWA; ++rep) phase_norm(xl_src, xc_src, p.in[I_N1G] + l * 1024, modl, 0, 1, hbuf);
        } break;
        case 1: {
            {
                EpiIn e{(bf16_t*)(ws + O_NAQK), (bf16_t*)(ws + O_VTA), (bf16_t*)(ws + O_GQ), (bf16_t*)(ws + O_VTB), (bf16_t*)(ws + O_MLAR), (bf16_t*)(ws + O_RWR)};
                for (int rep = 0; rep < REP_GEMM; ++rep) for (int t = pb; t < 272 * 23; t += G) { int mt, nt; tile_mn(t, 23, mt, nt); gemm_tile(hbuf, LDH, (const bf16_t*)(ws + O_WIN), LDW1, 1024, mt * 128, nt * 128, smem, e); }
            }
        } break;
        case 2: {
            phase_post(p, l);
        } break;
        case 3: {
            {
                EpiUQ e1{(bf16_t*)(ws + O_QC), (const float*)(ws + O_RSM)};
                EpiUKV e2{(bf16_t*)(ws + O_KC), (bf16_t*)(ws + O_VTC), (const float*)(ws + O_RSM)};
                EpiAux e3{(bf16_t*)(ws + O_DEC), (bf16_t*)(ws + O_GATE), p.in[I_W0] + l * 512, p.in[I_A0] + l * 512};
                const bf16_t* mlar = (const bf16_t*)(ws + O_MLAR);
                for (int rep = 0; rep < REP_GEMM; ++rep) for (int t = pb; t < 272 * 17; t += G) {
                    const int mt = t / 17, j = t % 17;
                    if (j < 3) gemm_tile(mlar, 416, (const bf16_t*)(ws + O_WUQ), 256, 256, mt * 128, j * 128, smem, e1);
                    else if (j < 7) gemm_tile(mlar + 256, 416, (const bf16_t*)(ws + O_WUKV), 128, 128, mt * 128, (j - 3) * 128, smem, e2);
                    else {
                        const int n0 = (j - 7) * 128, blk = n0 >> 8;
                        if (blk < 4) {
                            gemm_tile(hbuf + blk * 64, 448, (const bf16_t*)(ws + O_WAUX) + (size_t)blk * 256 * 64 - (size_t)(blk * 256) * 64, 64, 64, mt * 128, n0, smem, e3);
                        } else {
                            gemm_tile(hbuf + 256, 448, (const bf16_t*)(ws + O_WG2) - (size_t)1024 * 192, 192, 192, mt * 128, n0, smem, e3);
                        }
                    }
                }
            }
        } break;
        case 4: {
            phase_mix(p, l, smem, &s_item);
        } break;
        case 5: {
            for (int rep = 0; rep < REP_EW; ++rep) phase_rwkv_fin(p, l);
        } break;
        case 6: {
            {
                EpiRes e{xl_src, xc_src, p.out, xc, modl + 2 * 1024};
                for (int t = pb; t < 272 * 8; t += G) { int mt, nt; tile_mn(t, 8, mt, nt); if (l == 3 && (mt % 34) < 2) continue;
                    gemm_tile(hbuf, LDH, (const bf16_t*)(ws + O_WOUT), LDW1, 1024, mt * 128, nt * 128, smem, e); }
            }
        } break;
        case 7: {
            for (int rep = 0; rep < REP_EW; ++rep) phase_norm(p.out, xc, p.in[I_N2G] + l * 1024, modl, 3, 4, hbuf);
        } break;
        case 8: {
            {
                EpiFc1 e{(bf16_t*)(ws + O_HID)};
                for (int rep = 0; rep < REP_GEMM; ++rep) for (int t = pb; t < 272 * 32; t += G) { int mt, nt; tile_mn(t, 32, mt, nt); if (l == 3 && (mt % 34) < 2) continue;
                    gemm_tile(hbuf, LDH, (const bf16_t*)(ws + O_WFC1), LDW1, 1024, mt * 128, nt * 128, smem, e); }
            }
        } break;
        case 9: {
            {
                EpiRes e{p.out, xc, p.out, xc, modl + 5 * 1024};
                for (int t = pb; t < 272 * 8; t += G) { int mt, nt; tile_mn(t, 8, mt, nt); if (l == 3 && (mt % 34) < 2) continue;
                    gemm_tile((const bf16_t*)(ws + O_HID), LDHID, (const bf16_t*)(ws + O_WFC2), LDW4, 4096, mt * 128, nt * 128, smem, e); }
            }
        } break;
        }
        for (int rep = 0; rep < REP_SYNC; ++rep) xcd_barrier(xb);
    }
    phase_final(p);
}

extern "C" void kernel_launch(void* const* d_in, const int* in_sizes, int n_in, void* d_out, int out_size, void* d_ws, size_t ws_size, hipStream_t stream) {
    static int grid_blocks = 0;
    if (n_in != 31 || ws_size < O_END) { fprintf(stderr, "kernel_launch: bad n_in %d or ws_size %zu < %zu\n", n_in, ws_size, (size_t)O_END); return; }
    if (!grid_blocks) {
        int dev = 0, cus = 0, per_cu = 0;
        hipGetDevice(&dev);
        hipDeviceGetAttribute(&cus, hipDeviceAttributeMultiprocessorCount, dev);
        hipOccupancyMaxActiveBlocksPerMultiprocessor(&per_cu, mega, 256, 0);
        if (per_cu > 3) per_cu = 3;
        if (per_cu < 1) per_cu = 1;
        grid_blocks = cus * per_cu;
    }
    Params p{};
    for (int i = 0; i < 31; ++i) p.in[i] = (const float*)d_in[i];
    p.out = (float*)d_out;
    p.ws = (char*)d_ws;
    (void)hipMemsetAsync(d_ws, 0, 16384, stream);
    void* args[] = {&p};
    hipError_t e = hipLaunchCooperativeKernel((void*)mega, dim3(grid_blocks), dim3(256), args, 0, stream);
    if (e != hipSuccess) fprintf(stderr, "cooperative launch failed: %s (grid %d)\n", hipGetErrorString(e), grid_blocks);
}
```

```cpp
#include <hip/hip_runtime.h>
#include <hip/hip_cooperative_groups.h>
#include <stdint.h>
#include <stdio.h>
namespace cg = cooperative_groups;
#ifndef REP_GEMM
#define REP_GEMM 1
#endif
#ifndef REP_ATTN
#define REP_ATTN 1
#endif
#ifndef REP_EW
#define REP_EW 1
#endif
#ifndef REP_SYNC
#define REP_SYNC 1
#endif
#ifndef REP_EWA
#define REP_EWA 1
#endif
#ifndef REP_SCAN
#define REP_SCAN 1
#endif

#define DI __device__ __forceinline__
typedef unsigned short bf16_t;
typedef short bf16x8 __attribute__((ext_vector_type(8)));
typedef short bf16x4 __attribute__((ext_vector_type(4)));
typedef float f32x4 __attribute__((ext_vector_type(4)));
typedef unsigned u32x4 __attribute__((ext_vector_type(4)));

constexpr int NB = 8, TPB = 4352, NT = NB * TPB;
constexpr int INC = 2880, INP = 2944;
constexpr int LDH = 1088, LDHID = 4160, LDW1 = 1088, LDW4 = 4160, LDNA = 576;
constexpr float LOG2E = 1.4426950408889634f;
constexpr float QS64 = 0.125f * LOG2E;
constexpr float QS96 = 0.10206207261596577f * LOG2E;
constexpr float ROPE_L2T = 13.287712379549449f;

constexpr size_t al(size_t x) { return (x + 255) & ~size_t(255); }
constexpr size_t O_CTL = 0;
constexpr size_t O_MOD = 16384;
constexpr size_t O_XC = O_MOD + al((size_t)4 * 9 * 6144 * 4);
constexpr size_t O_WIN = O_XC + al((size_t)2048 * 1024 * 4);
constexpr size_t O_WOUT = O_WIN + al((size_t)INP * LDW1 * 2);
constexpr size_t O_WFC1 = O_WOUT + al((size_t)1024 * LDW1 * 2);
constexpr size_t O_WFC2 = O_WFC1 + al((size_t)4096 * LDW1 * 2);
constexpr size_t O_WUQ = O_WFC2 + al((size_t)1024 * LDW4 * 2);
constexpr size_t O_WUKV = O_WUQ + al((size_t)384 * 256 * 2);
constexpr size_t O_WAUX = O_WUKV + al((size_t)512 * 128 * 2);
constexpr size_t O_WG2 = O_WAUX + al((size_t)4 * 256 * 64 * 2);
constexpr size_t O_HBUF = O_WG2 + al((size_t)256 * 192 * 2);
constexpr size_t O_BIG = O_HBUF + al((size_t)NT * LDH * 2);
constexpr size_t O_NAQK = O_BIG;
constexpr size_t O_VTA = O_NAQK + al((size_t)NT * LDNA * 2);
constexpr size_t O_GQ = O_VTA + al((size_t)NB * 256 * TPB * 2);
constexpr size_t O_VTB = O_GQ + al((size_t)NT * 384 * 2);
constexpr size_t O_MLAR = O_VTB + al((size_t)NB * 128 * TPB * 2);
constexpr size_t O_RWR = O_MLAR + al((size_t)NT * 416 * 2);
constexpr size_t O_QC = O_RWR + al((size_t)NT * 1184 * 2);
constexpr size_t O_KC = O_QC + al((size_t)NT * 384 * 2);
constexpr size_t O_VTC = O_KC + al((size_t)NT * 384 * 2);
constexpr size_t O_RKV = O_VTC + al((size_t)NB * 256 * TPB * 2);
constexpr size_t O_DEC = O_RKV + al((size_t)NT * 768 * 2);
constexpr size_t O_GATE = O_DEC + al((size_t)NT * 1024 * 2);
constexpr size_t O_INVN = O_GATE + al((size_t)NT * 256 * 2);
constexpr size_t O_RSM = O_INVN + al((size_t)NT * 8 * 4);
constexpr size_t O_END = O_RSM + al((size_t)NT * 2 * 4);
constexpr size_t O_HID = O_BIG;
constexpr size_t O_Y = O_RWR;
static_assert(O_HID + (size_t)NT * LDHID * 2 <= O_END, "hidden overlay");
static_assert(O_END <= (size_t)512 * 1024 * 1024, "workspace");
static_assert((size_t)2 * NT * 256 * 4 <= (size_t)NT * 1184 * 2, "y overlay");

struct Params {
    const float* in[31];
    float* out;
    char* ws;
};

enum { I_X = 0, I_C, I_CTX, I_CCTX, I_WMOD, I_BMOD, I_N1G, I_N2G, I_WIN, I_SHIFT, I_RPB, I_GQN, I_GKN, I_MQN, I_MKVN, I_WUQ, I_WUKV,
       I_W0, I_W2, I_A0, I_A2, I_KK, I_KA, I_RK, I_G2, I_LNW, I_LNB, I_WOUT, I_FC1, I_FC2, I_FNG };

typedef __bf16 hwbf16x2 __attribute__((ext_vector_type(2)));
typedef float f32x2 __attribute__((ext_vector_type(2)));
DI unsigned pk2(float a, float b) { f32x2 v = {a, b}; hwbf16x2 r = __builtin_convertvector(v, hwbf16x2); return __builtin_bit_cast(unsigned, r); }
DI bf16_t f2bf(float x) { return (bf16_t)(pk2(x, x) & 0xffffu); }
DI float bf2f(bf16_t b) { return __uint_as_float(((unsigned)b) << 16); }
DI float lo2f(unsigned u) { return __uint_as_float(u << 16); }
DI float hi2f(unsigned u) { return __uint_as_float(u & 0xffff0000u); }
DI void st4(bf16_t* p, float a, float b, float c, float d) { uint2 u; u.x = pk2(a, b); u.y = pk2(c, d); *(uint2*)p = u; }
template <int CTRL> DI float dppf(float v) { return __int_as_float(__builtin_amdgcn_update_dpp(0, __float_as_int(v), CTRL, 0xF, 0xF, true)); }
DI float sum16(float v) { v += dppf<0xB1>(v); v += dppf<0x4E>(v); v += dppf<0x141>(v); v += dppf<0x140>(v); return v; }
DI float wsum64(float v) { v = sum16(v); v += __shfl_xor(v, 16); v += __shfl_xor(v, 32); return v; }
DI float sigm(float x) { return 1.f / (1.f + __expf(-x)); }
DI int gtid() { int t = threadIdx.x; asm volatile("" : "+v"(t)); return t; }
DI int clampi(int v, int lo, int hi) { return v < lo ? lo : (v > hi ? hi : v); }

template <class T> struct IsRes;
template <class T> struct HasRS;
template <class T> struct HasCV;
template <class Epi>
DI void gemm_tile(const bf16_t* __restrict__ A, int lda, const bf16_t* __restrict__ Bt, int ldb, int K, int m0, int n0, char* smem, const Epi& epi) {
    char* sA = smem;
    char* sB = smem + 16384;
    const int tid = gtid(), lane = tid & 63, wave = tid >> 6;
    const int wm = wave >> 1, wn = wave & 1, l15 = lane & 15, quad = lane >> 4;
    f32x4 acc[4][4];
#pragma unroll
    for (int i = 0; i < 4; ++i)
#pragma unroll
        for (int j = 0; j < 4; ++j) acc[i][j] = (f32x4){0.f, 0.f, 0.f, 0.f};
    const int srow = lane >> 3, skc = (lane & 7) ^ (lane >> 3);
    const bf16_t* Ag = A + (size_t)(m0 + wave * 8 + srow) * lda + skc * 8;
    const bf16_t* Bg = Bt + (size_t)(n0 + wave * 8 + srow) * ldb + skc * 8;
    const size_t a32 = (size_t)32 * lda, b32 = (size_t)32 * ldb;
    const int sw = l15 & 7;
    for (int k0 = 0; k0 < K; k0 += 64) {
        __syncthreads();
#pragma unroll
        for (int i = 0; i < 4; ++i) {
            __builtin_amdgcn_global_load_lds((const unsigned*)(Ag + i * a32 + k0), (__attribute__((address_space(3))) unsigned*)(sA + (i * 4 + wave) * 1024), 16, 0, 0);
            __builtin_amdgcn_global_load_lds((const unsigned*)(Bg + i * b32 + k0), (__attribute__((address_space(3))) unsigned*)(sB + (i * 4 + wave) * 1024), 16, 0, 0);
        }
        asm volatile("s_waitcnt vmcnt(0)" ::: "memory");
        __syncthreads();
#pragma unroll
        for (int ks = 0; ks < 2; ++ks) {
            bf16x8 wf[4], xf[4];
            const int co = ((ks * 4 + quad) ^ sw) * 16;
#pragma unroll
            for (int t = 0; t < 4; ++t) {
                wf[t] = *(const bf16x8*)(sB + (wn * 64 + t * 16 + l15) * 128 + co);
                xf[t] = *(const bf16x8*)(sA + (wm * 64 + t * 16 + l15) * 128 + co);
            }
#pragma unroll
            for (int nt = 0; nt < 4; ++nt)
#pragma unroll
                for (int mt = 0; mt < 4; ++mt) acc[nt][mt] = __builtin_amdgcn_mfma_f32_16x16x32_bf16(wf[nt], xf[mt], acc[nt][mt], 0, 0, 0);
        }
    }
    if constexpr (IsRes<Epi>::value) {
#pragma unroll
        for (int nt = 0; nt < 4; ++nt) {
            f32x4 xv[4], gv[4];
#pragma unroll
            for (int mt = 0; mt < 4; ++mt) epi.loadxg(m0 + wm * 64 + mt * 16 + l15, n0 + wn * 64 + nt * 16 + quad * 4, xv[mt], gv[mt]);
#pragma unroll
            for (int mt = 0; mt < 4; ++mt) epi.storex(m0 + wm * 64 + mt * 16 + l15, n0 + wn * 64 + nt * 16 + quad * 4, xv[mt], gv[mt], acc[nt][mt]);
        }
    } else if constexpr (HasCV<Epi>::value) {
        f32x4 cv4[4];
#pragma unroll
        for (int nt = 0; nt < 4; ++nt) cv4[nt] = epi.colvec(n0 + wn * 64 + nt * 16 + quad * 4);
#pragma unroll
        for (int nt = 0; nt < 4; ++nt)
#pragma unroll
            for (int mt = 0; mt < 4; ++mt) epi.apply(m0 + wm * 64 + mt * 16 + l15, n0 + wn * 64 + nt * 16 + quad * 4, acc[nt][mt], cv4[nt]);
    } else if constexpr (HasRS<Epi>::value) {
        float rs4[4];
#pragma unroll
        for (int mt = 0; mt < 4; ++mt) rs4[mt] = epi.rowscale(m0 + wm * 64 + mt * 16 + l15);
#pragma unroll
        for (int nt = 0; nt < 4; ++nt)
#pragma unroll
            for (int mt = 0; mt < 4; ++mt) epi.apply(m0 + wm * 64 + mt * 16 + l15, n0 + wn * 64 + nt * 16 + quad * 4, acc[nt][mt], rs4[mt]);
    } else {
#pragma unroll
        for (int nt = 0; nt < 4; ++nt)
#pragma unroll
            for (int mt = 0; mt < 4; ++mt) epi(m0 + wm * 64 + mt * 16 + l15, n0 + wn * 64 + nt * 16 + quad * 4, acc[nt][mt]);
    }
}

DI void tile_mn(int t, int nn, int& mt, int& nt) { const int sup = t / (8 * nn), tin = t - sup * 8 * nn; mt = sup * 8 + (tin & 7); nt = tin >> 3; }

struct EpiIn {
    bf16_t *naqk, *vta, *gq, *vtb, *mlar, *rwr;
    DI void operator()(int m, int n, f32x4 v) const {
        if (n >= INC) return;
        if (n < 512) {
            const float s = (n < 256) ? QS64 : 1.f;
            st4(naqk + (size_t)m * LDNA + n, v[0] * s, v[1] * s, v[2] * s, v[3] * s);
        } else if (n < 768) {
            const int b = m / TPB, tib = m - b * TPB;
            bf16_t* d = vta + ((size_t)b * 256 + (n - 512)) * TPB + tib;
            d[0] = f2bf(v[0]); d[TPB] = f2bf(v[1]); d[2 * TPB] = f2bf(v[2]); d[3 * TPB] = f2bf(v[3]);
        } else if (n < 1152) {
            st4(gq + (size_t)m * 384 + (n - 768), v[0], v[1], v[2], v[3]);
        } else if (n < 1280) {
            const int b = m / TPB, tib = m - b * TPB;
            bf16_t* d = vtb + ((size_t)b * 128 + (n - 1152)) * TPB + tib;
            d[0] = f2bf(v[0]); d[TPB] = f2bf(v[1]); d[2 * TPB] = f2bf(v[2]); d[3 * TPB] = f2bf(v[3]);
        } else if (n < 1696) {
            st4(mlar + (size_t)m * 416 + (n - 1280), v[0], v[1], v[2], v[3]);
        } else {
            st4(rwr + (size_t)m * 1184 + (n - 1696), v[0], v[1], v[2], v[3]);
        }
    }
};

DI void rope_rot(float& a, float& b, int pos, float fidx, float fscale) {
    const float ang = (float)pos * __builtin_amdgcn_exp2f(-fidx * fscale);
    const float c = __cosf(ang), s = __sinf(ang);
    const float a2 = a * c - b * s, b2 = a * s + b * c;
    a = a2; b = b2;
}

struct EpiUQ {
    bf16_t* qc; const float* rsm;
    DI float rowscale(int m) const { return rsm[m * 2] * QS96; }
    DI void operator()(int m, int n, f32x4 v) const { apply(m, n, v, rowscale(m)); }
    DI void apply(int m, int n, f32x4 v, float rs) const {
        float a = v[0] * rs, b = v[1] * rs, c = v[2] * rs, d = v[3] * rs;
        const int h = n / 96, dd = n - h * 96;
        const int bb = m / TPB, tib = m - bb * TPB;
        if (dd >= 64 && tib >= 256) {
            const int t = tib - 256, row = t >> 6, col = t & 63;
            const int i0 = (dd - 64) >> 1, i1 = i0 + 1;
            rope_rot(a, b, i0 < 8 ? row : col, (float)(i0 & 7), ROPE_L2T / 8.f);
            rope_rot(c, d, i1 < 8 ? row : col, (float)(i1 & 7), ROPE_L2T / 8.f);
        }
        st4(qc + (size_t)m * 384 + n, a, b, c, d);
    }
};
struct EpiUKV {
    bf16_t *kc, *vtc; const float* rsm;
    DI float rowscale(int m) const { return rsm[m * 2 + 1]; }
    DI void operator()(int m, int n, f32x4 v) const { apply(m, n, v, rowscale(m)); }
    DI void apply(int m, int n, f32x4 v, float rs) const {
        const int h = n >> 7, dd = n & 127;
        if (dd < 64) {
            st4(kc + (size_t)m * 384 + h * 96 + dd, v[0] * rs, v[1] * rs, v[2] * rs, v[3] * rs);
        } else {
            const int b = m / TPB, tib = m - b * TPB;
            bf16_t* d = vtc + ((size_t)b * 256 + h * 64 + (dd - 64)) * TPB + tib;
            d[0] = f2bf(v[0] * rs); d[TPB] = f2bf(v[1] * rs); d[2 * TPB] = f2bf(v[2] * rs); d[3 * TPB] = f2bf(v[3] * rs);
        }
    }
};
struct EpiAux {
    bf16_t *dec, *gate; const float *w0, *a0;
    DI f32x4 colvec(int n) const {
        const int j = n >> 8, c = n & 255;
        if (j < 2) return *(const f32x4*)(w0 + j * 256 + c);
        if (j < 4) return *(const f32x4*)(a0 + (j - 2) * 256 + c);
        return (f32x4){0.f, 0.f, 0.f, 0.f};
    }
    DI void operator()(int m, int n, f32x4 v) const { apply(m, n, v, colvec(n)); }
    DI void apply(int m, int n, f32x4 v, f32x4 off) const {
        const int j = n >> 8, c = n & 255;
        float o[4];
        if (j < 2) {
#pragma unroll
            for (int r = 0; r < 4; ++r) {
                const float u = off[r] + v[r];
                const float z = -u;
                const float sp = fmaxf(z, 0.f) + __logf(1.f + __expf(-fabsf(z)));
                const float w = -sp - 0.5f;
                const float e = __expf(w);
                o[r] = 1.f - __expf(-e);
            }
            st4(dec + (size_t)m * 1024 + j * 256 + c, o[0], o[1], o[2], o[3]);
        } else if (j < 4) {
#pragma unroll
            for (int r = 0; r < 4; ++r) o[r] = sigm(off[r] + v[r]);
            st4(dec + (size_t)m * 1024 + 512 + (j - 2) * 256 + c, o[0], o[1], o[2], o[3]);
        } else {
            st4(gate + (size_t)m * 256 + c, v[0], v[1], v[2], v[3]);
        }
    }
};
struct EpiRes {
    const float *srcl, *srcc; float *dstl, *dstc; const float* modg;
    DI void loadxg(int m, int n, f32x4& x, f32x4& g) const {
        const int b = m / TPB, tib = m - b * TPB;
        const float* s; int mr;
        if (tib < 256) { s = srcc + ((size_t)b * 256 + tib) * 1024 + n; mr = 8; }
        else { s = srcl + ((size_t)b * 4096 + (tib - 256)) * 1024 + n; mr = b; }
        g = *(const f32x4*)(modg + mr * 6144 + n);
        x = *(const f32x4*)s;
    }
    DI void storex(int m, int n, const f32x4& x, const f32x4& g, f32x4 v) const {
        const int b = m / TPB, tib = m - b * TPB;
        float* d = (tib < 256) ? dstc + ((size_t)b * 256 + tib) * 1024 + n : dstl + ((size_t)b * 4096 + (tib - 256)) * 1024 + n;
        *(f32x4*)d = x + g * v;
    }
    DI void operator()(int m, int n, f32x4 v) const { f32x4 x, g; loadxg(m, n, x, g); storex(m, n, x, g, v); }
};
template <class T> struct IsRes { static constexpr bool value = false; };
template <class T> struct HasRS { static constexpr bool value = false; };
template <> struct HasRS<EpiUQ> { static constexpr bool value = true; };
template <> struct HasRS<EpiUKV> { static constexpr bool value = true; };
template <class T> struct HasCV { static constexpr bool value = false; };
template <> struct HasCV<EpiAux> { static constexpr bool value = true; };
template <> struct IsRes<EpiRes> { static constexpr bool value = true; };
struct EpiFc1 {
    bf16_t* hid;
    DI void operator()(int m, int n, f32x4 v) const {
        float a = fmaxf(v[0], 0.f), b = fmaxf(v[1], 0.f), c = fmaxf(v[2], 0.f), d = fmaxf(v[3], 0.f);
        st4(hid + (size_t)m * LDHID + n, a * a, b * b, c * c, d * d);
    }
};

DI void phase_mod(const Params& p, char* smem) {
    float* sc = (float*)smem;
    float* red = sc + 9 * 1024;
    const int tid = gtid(), lane = tid & 63, wave = tid >> 6;
    for (int i = tid; i < 9 * 1024; i += 256) { const float v = (i < 8192) ? p.in[I_C][i] : p.in[I_CCTX][i - 8192]; sc[i] = v / (1.f + __expf(-v)); }
    __syncthreads();
    float* mod = (float*)(p.ws + O_MOD);
    for (int item = blockIdx.x; item < 4 * 96; item += gridDim.x) {
        const int l = item / 96, nb = (item % 96) * 64;
        const float* w = p.in[I_WMOD] + (size_t)l * 1024 * 6144 + nb + lane;
        float acc[9];
#pragma unroll
        for (int r = 0; r < 9; ++r) acc[r] = 0.f;
#pragma unroll 8
        for (int k = wave * 256; k < wave * 256 + 256; ++k) {
            const float wv = w[(size_t)k * 6144];
#pragma unroll
            for (int r = 0; r < 9; ++r) acc[r] += sc[r * 1024 + k] * wv;
        }
#pragma unroll
        for (int r = 0; r < 9; ++r) red[(wave * 9 + r) * 64 + lane] = acc[r];
        __syncthreads();
        for (int i = tid; i < 9 * 64; i += 256) {
            const int r = i >> 6, ln = i & 63;
            const float s = red[(0 * 9 + r) * 64 + ln] + red[(1 * 9 + r) * 64 + ln] + red[(2 * 9 + r) * 64 + ln] + red[(3 * 9 + r) * 64 + ln];
            mod[((size_t)l * 9 + r) * 6144 + nb + ln] = s + p.in[I_BMOD][l * 6144 + nb + ln];
        }
        __syncthreads();
    }
}

DI void wconv_tile(const float* src, const float* g, int K, int N, bf16_t* dst, int nkt, int ldd, int t, char* smem) {
    float* tile = (float*)smem;
    const int tid = gtid();
    const int kt = t % nkt, nt = t / nkt, k0 = kt * 64, n0 = nt * 64;
    __syncthreads();
#pragma unroll 4
    for (int i = 0; i < 16; ++i) {
        const int kl = (tid >> 6) + 4 * i, nl = tid & 63, k = k0 + kl, n = n0 + nl;
        float v = 0.f;
        if (k < K && n < N) { v = src[(size_t)k * N + n]; if (g) v *= g[k]; }
        tile[kl * 65 + nl] = v;
    }
    __syncthreads();
#pragma unroll 4
    for (int i = 0; i < 8; ++i) {
        const int nl = (tid >> 5) + 8 * i, kl = (tid & 31) * 2;
        *(unsigned*)(dst + (size_t)(n0 + nl) * ldd + k0 + kl) = pk2(tile[kl * 65 + nl], tile[(kl + 1) * 65 + nl]);
    }
}
DI void wconv(const float* src, const float* g, int K, int N, bf16_t* dst, int Kp, int Np, int ldd, int rot, char* smem) {
    const int nkt = Kp / 64, nnt = Np / 64, G = gridDim.x;
    for (int t = (blockIdx.x + G - (rot % G)) % G; t < nkt * nnt; t += G) wconv_tile(src, g, K, N, dst, nkt, ldd, t, smem);
}
DI void wconv_late(const Params& p, int l, int u, char* smem) {
    char* ws = p.ws;
    if (u < 1024) wconv_tile(p.in[I_FC1] + (size_t)l * 1024 * 4096, nullptr, 1024, 4096, (bf16_t*)(ws + O_WFC1), 16, LDW1, u, smem);
    else if (u < 2048) wconv_tile(p.in[I_FC2] + (size_t)l * 4096 * 1024, nullptr, 4096, 1024, (bf16_t*)(ws + O_WFC2), 64, LDW4, u - 1024, smem);
    else wconv_tile(p.in[I_WOUT] + (size_t)l * 1024 * 1024, nullptr, 1024, 1024, (bf16_t*)(ws + O_WOUT), 16, LDW1, u - 2048, smem);
}
DI void wconv_early(const Params& p, int l, int u, char* smem) {
    char* ws = p.ws;
    if (u < 736) wconv_tile(p.in[I_WIN] + (size_t)l * 1024 * INC, nullptr, 1024, INC, (bf16_t*)(ws + O_WIN), 16, LDW1, u, smem);
    else if (u < 760) wconv_tile(p.in[I_WUQ] + (size_t)l * 256 * 384, p.in[I_MQN] + l * 256, 256, 384, (bf16_t*)(ws + O_WUQ), 4, 256, u - 736, smem);
    else if (u < 776) wconv_tile(p.in[I_WUKV] + (size_t)l * 128 * 512, p.in[I_MKVN] + l * 128, 128, 512, (bf16_t*)(ws + O_WUKV), 2, 128, u - 760, smem);
    else if (u < 792) {
        const int v = u - 776, j = v >> 2, d = j & 1;
        const float* src = (j < 2 ? p.in[I_W2] : p.in[I_A2]) + (size_t)(l * 2 + d) * 64 * 256;
        wconv_tile(src, nullptr, 64, 256, (bf16_t*)(ws + O_WAUX) + (size_t)j * 256 * 64, 1, 64, v & 3, smem);
    } else wconv_tile(p.in[I_G2] + (size_t)l * 160 * 256, nullptr, 160, 256, (bf16_t*)(ws + O_WG2), 3, 192, u - 792, smem);
}

DI void phase_wconv(const Params& p, int l, char* smem) {
    char* ws = p.ws;
    wconv(p.in[I_WIN] + (size_t)l * 1024 * INC, nullptr, 1024, INC, (bf16_t*)(ws + O_WIN), 1024, INP, LDW1, 0, smem);
    wconv(p.in[I_WUQ] + (size_t)l * 256 * 384, p.in[I_MQN] + l * 256, 256, 384, (bf16_t*)(ws + O_WUQ), 256, 384, 256, 3040, smem);
    wconv(p.in[I_WUKV] + (size_t)l * 128 * 512, p.in[I_MKVN] + l * 128, 128, 512, (bf16_t*)(ws + O_WUKV), 128, 512, 128, 3064, smem);
    for (int d = 0; d < 2; ++d) {
        wconv(p.in[I_W2] + (size_t)(l * 2 + d) * 64 * 256, nullptr, 64, 256, (bf16_t*)(ws + O_WAUX) + d * 256 * 64, 64, 256, 64, 3080 + d * 4, smem);
        wconv(p.in[I_A2] + (size_t)(l * 2 + d) * 64 * 256, nullptr, 64, 256, (bf16_t*)(ws + O_WAUX) + (2 + d) * 256 * 64, 64, 256, 64, 3088 + d * 4, smem);
    }
    wconv(p.in[I_G2] + (size_t)l * 160 * 256, nullptr, 160, 256, (bf16_t*)(ws + O_WG2), 192, 256, 192, 3096, smem);
}

DI void phase_norm(const float* xl, const float* xc, const float* g, const float* modl, int shi, int sci, bf16_t* dst) {
    const int tid = gtid(), lane = tid & 63, wave = tid >> 6;
    for (int tok = blockIdx.x * 4 + wave; tok < NT; tok += gridDim.x * 4) {
        const int b = tok / TPB, tib = tok - b * TPB;
        const float* row; int mr;
        if (tib < 256) { row = xc + ((size_t)b * 256 + tib) * 1024; mr = 8; } else { row = xl + ((size_t)b * 4096 + tib - 256) * 1024; mr = b; }
        const float* sh = modl + mr * 6144 + shi * 1024;
        const float* sc = modl + mr * 6144 + sci * 1024;
        f32x4 v[4]; float ss = 0.f;
#pragma unroll
        for (int i = 0; i < 4; ++i) { v[i] = ((const f32x4*)row)[lane + 64 * i]; ss += v[i].x * v[i].x + v[i].y * v[i].y + v[i].z * v[i].z + v[i].w * v[i].w; }
        ss = wsum64(ss);
        const float rs = rsqrtf(ss * (1.f / 1024.f) + 1e-6f);
#pragma unroll
        for (int i = 0; i < 4; ++i) {
            const int c = (lane + 64 * i) * 4;
            const float4 g4 = *(const float4*)(g + c), s4 = *(const float4*)(sc + c), h4 = *(const float4*)(sh + c);
            st4(dst + (size_t)tok * LDH + c, v[i].x * rs * g4.x * (1.f + s4.x) + h4.x, v[i].y * rs * g4.y * (1.f + s4.y) + h4.y,
                v[i].z * rs * g4.z * (1.f + s4.z) + h4.z, v[i].w * rs * g4.w * (1.f + s4.w) + h4.w);
        }
    }
}

DI void phase_post(const Params& p, int l) {
    const int tid = gtid(), lane = tid & 63, wave = tid >> 6;
    char* ws = p.ws;
    bf16_t* gq = (bf16_t*)(ws + O_GQ);
    const bf16_t* mlar = (const bf16_t*)(ws + O_MLAR);
    bf16_t* kc = (bf16_t*)(ws + O_KC);
    float* rsm = (float*)(ws + O_RSM);
    const bf16_t* rwr = (const bf16_t*)(ws + O_RWR);
    bf16_t* rkv = (bf16_t*)(ws + O_RKV);
    bf16_t* acat = (bf16_t*)(ws + O_HBUF);
    float* invn = (float*)(ws + O_INVN);
    const float* gqn = p.in[I_GQN] + l * 64;
    const float* gkn = p.in[I_GKN] + l * 64;
    const float* taps = p.in[I_SHIFT] + (size_t)l * 3 * 1184;
    const float* kkw = p.in[I_KK] + (size_t)l * 512;
    for (int tok = blockIdx.x * 4 + wave; tok < NT; tok += gridDim.x * 4) {
        const int b = tok / TPB, tib = tok - b * TPB;
        const bool lat = tib >= 256;
        const int t = tib - 256, prow = t >> 6, pcol = t & 63;
        unsigned gqu[3];
#pragma unroll
        for (int it = 0; it < 3; ++it) gqu[it] = *(const unsigned*)(gq + (size_t)tok * 384 + (it * 2 + (lane >> 5)) * 64 + (lane & 31) * 2);
        const bf16_t* mr = mlar + (size_t)tok * 416;
        const uint2 uq = *(const uint2*)(mr + lane * 4);
        const unsigned ukv = *(const unsigned*)(mr + 256 + lane * 2);
        const unsigned ukr = *(const unsigned*)(mr + 384 + (lane & 15) * 2);
        {
            const int pair = lane & 31;
#pragma unroll
            for (int it = 0; it < 3; ++it) {
                const int head = it * 2 + (lane >> 5);
                unsigned* ptr = (unsigned*)(gq + (size_t)tok * 384 + head * 64 + pair * 2);
                const unsigned u = gqu[it];
                float x1 = lo2f(u), x2 = hi2f(u);
                float ss = x1 * x1 + x2 * x2;
                ss += __shfl_xor(ss, 1); ss += __shfl_xor(ss, 2); ss += __shfl_xor(ss, 4); ss += __shfl_xor(ss, 8); ss += __shfl_xor(ss, 16);
                const float rs = rsqrtf(ss * (1.f / 64.f) + 1e-6f);
                const float* gg = head < 4 ? gqn : gkn;
                x1 *= rs * gg[pair * 2]; x2 *= rs * gg[pair * 2 + 1];
                if (lat) rope_rot(x1, x2, pair < 16 ? prow : pcol, (float)(pair & 15), ROPE_L2T / 16.f);
                if (head < 4) { x1 *= QS64; x2 *= QS64; }
                *ptr = pk2(x1, x2);
            }
        }
        {
            float a0 = lo2f(uq.x), a1 = hi2f(uq.x), a2 = lo2f(uq.y), a3 = hi2f(uq.y);
            float sq = wsum64(a0 * a0 + a1 * a1 + a2 * a2 + a3 * a3);
            float c0 = lo2f(ukv), c1 = hi2f(ukv);
            float sk = wsum64(c0 * c0 + c1 * c1);
            if (lane == 0) { rsm[tok * 2] = rsqrtf(sq * (1.f / 256.f) + 1e-6f); rsm[tok * 2 + 1] = rsqrtf(sk * (1.f / 128.f) + 1e-6f); }
            if (lane < 16) {
                const unsigned u = ukr;
                float x1 = lo2f(u), x2 = hi2f(u);
                if (lat) rope_rot(x1, x2, lane < 8 ? prow : pcol, (float)(lane & 7), ROPE_L2T / 8.f);
                const unsigned o = pk2(x1, x2);
#pragma unroll
                for (int h = 0; h < 4; ++h) *(unsigned*)(kc + (size_t)tok * 384 + h * 96 + 64 + lane * 2) = o;
            }
        }
        {
            const bool hasp = (tib != 0) && (tib != 256);
            const bool hasn = (tib != 255) && (tib != TPB - 1);
            const bf16_t* r0 = rwr + (size_t)tok * 1184;
#pragma unroll
            for (int hb = 0; hb < 5; ++hb) {
            unsigned X0[2], X1[2], X2[2]; f32x2 T0[2], T1[2], T2[2];
#pragma unroll
            for (int ii = 0; ii < 2; ++ii) {
                const int c = (lane + 64 * (hb * 2 + ii)) * 2;
                X0[ii] = 0u; X1[ii] = 0u; X2[ii] = 0u; T0[ii] = (f32x2){0.f, 0.f}; T1[ii] = T0[ii]; T2[ii] = T0[ii];
                if (c < 1184) {
                    X1[ii] = *(const unsigned*)(r0 + c); T1[ii] = *(const f32x2*)(taps + 1184 + c);
                    if (hasp) { X0[ii] = *(const unsigned*)(r0 + c - 1184); T0[ii] = *(const f32x2*)(taps + c); }
                    if (hasn) { X2[ii] = *(const unsigned*)(r0 + c + 1184); T2[ii] = *(const f32x2*)(taps + 2 * 1184 + c); }
                }
            }
#pragma unroll
            for (int ii = 0; ii < 2; ++ii) {
                const int i = hb * 2 + ii;
                const int c = (lane + 64 * i) * 2;
                float u0 = 0.f, u1 = 0.f;
                if (c < 1184) {
                    u0 = lo2f(X1[ii]) * T1[ii][0]; u1 = hi2f(X1[ii]) * T1[ii][1];
                    u0 += lo2f(X0[ii]) * T0[ii][0]; u1 += hi2f(X0[ii]) * T0[ii][1];
                    u0 += lo2f(X2[ii]) * T2[ii][0]; u1 += hi2f(X2[ii]) * T2[ii][1];
                }
                if (i < 6) {
                    const unsigned pk = pk2(u0, u1);
                    *(unsigned*)(rkv + (size_t)tok * 768 + c) = pk;
                    if (i == 2 || i == 3) {
                        const float k0 = lo2f(pk), k1 = hi2f(pk);
                        const float2 f0 = *(const float2*)(kkw + c - 256), f1 = *(const float2*)(kkw + 256 + c - 256);
                        float s0 = (k0 * f0.x) * (k0 * f0.x) + (k1 * f0.y) * (k1 * f0.y);
                        float s1 = (k0 * f1.x) * (k0 * f1.x) + (k1 * f1.y) * (k1 * f1.y);
                        s0 = sum16(s0); s1 = sum16(s1);
                        s0 += __shfl_xor(s0, 16); s1 += __shfl_xor(s1, 16);
                        if ((lane & 31) == 0) {
                            const int hd = (i - 2) * 2 + (lane >> 5);
                            invn[tok * 8 + hd] = 1.f / fmaxf(sqrtf(s0), 1e-12f);
                            invn[tok * 8 + 4 + hd] = 1.f / fmaxf(sqrtf(s1), 1e-12f);
                        }
                    }
                } else if (i == 6) {
                    *(unsigned*)(acat + (size_t)tok * 448 + (c - 768)) = pk2(tanhf(u0), tanhf(u1));
                } else if (i == 7) {
                    *(unsigned*)(acat + (size_t)tok * 448 + 128 + (c - 896)) = pk2(u0, u1);
                } else {
                    const int cc = c - 1024;
                    if (cc < 192) *(unsigned*)(acat + (size_t)tok * 448 + 256 + cc) = (cc < 160) ? pk2(sigm(u0), sigm(u1)) : 0u;
                }
            }
            }
        }
    }
}

template <int DK, bool NAM>
DI void attn_item(const bf16_t* __restrict__ Q, int ldq, const bf16_t* __restrict__ Kb, int ldk, const bf16_t* __restrict__ Vt,
                          int s0, int nt0, int s1, int nt1, bf16_t* __restrict__ O, int qr0, const float* rpb_g, char* smem) {
    constexpr int KS = DK + 16, KCH = DK / 8, NKC = 64 * KCH / 256;
    bf16_t* sK = (bf16_t*)smem;
    bf16_t* sV = sK + 64 * 112;
    float* sR = (float*)(sV + 64 * 72);
    const int tid = gtid(), lane = tid & 63, wave = tid >> 6, l15 = lane & 15, quad = lane >> 4;
    const int ntot = nt0 + nt1;
    if (NAM) {
        __syncthreads();
        for (int i = tid; i < 465; i += 256) sR[i] = rpb_g[i] * LOG2E;
    }
    bf16x8 qf[2][DK / 32];
#pragma unroll
    for (int qt = 0; qt < 2; ++qt)
#pragma unroll
        for (int ks = 0; ks < DK / 32; ++ks) qf[qt][ks] = *(const bf16x8*)(Q + (size_t)(wave * 32 + qt * 16 + l15) * ldq + ks * 32 + quad * 8);
    f32x4 Oa[4][2];
#pragma unroll
    for (int i = 0; i < 4; ++i) { Oa[i][0] = (f32x4){0.f, 0.f, 0.f, 0.f}; Oa[i][1] = (f32x4){0.f, 0.f, 0.f, 0.f}; }
    float mrun[2] = {-1e30f, -1e30f}, lrun[2] = {0.f, 0.f};
    u32x4 rk[NKC], rv[2];
    {
        const int key0 = (0 < nt0) ? s0 : s1;
#pragma unroll
        for (int i = 0; i < NKC; ++i) { const int c = tid + 256 * i, row = c / KCH, kc = c % KCH; rk[i] = *(const u32x4*)(Kb + (size_t)(key0 + row) * ldk + kc * 8); }
#pragma unroll
        for (int i = 0; i < 2; ++i) { const int c = tid + 256 * i, row = c >> 3, kc = c & 7; rv[i] = *(const u32x4*)(Vt + (size_t)row * TPB + key0 + kc * 8); }
    }
    for (int j = 0; j < ntot; ++j) {
        __syncthreads();
#pragma unroll
        for (int i = 0; i < NKC; ++i) { const int c = tid + 256 * i, row = c / KCH, kc = c % KCH; *(u32x4*)(sK + row * KS + kc * 8) = rk[i]; }
#pragma unroll
        for (int i = 0; i < 2; ++i) { const int c = tid + 256 * i, row = c >> 3, kc = c & 7; *(u32x4*)(sV + row * 72 + kc * 8) = rv[i]; }
        __syncthreads();
        if (j + 1 < ntot) {
            const int jn = j + 1;
            const int key0 = (jn < nt0) ? (s0 + 64 * jn) : (s1 + 64 * (jn - nt0));
#pragma unroll
            for (int i = 0; i < NKC; ++i) { const int c = tid + 256 * i, row = c / KCH, kc = c % KCH; rk[i] = *(const u32x4*)(Kb + (size_t)(key0 + row) * ldk + kc * 8); }
#pragma unroll
            for (int i = 0; i < 2; ++i) { const int c = tid + 256 * i, row = c >> 3, kc = c & 7; rv[i] = *(const u32x4*)(Vt + (size_t)row * TPB + key0 + kc * 8); }
        }
        f32x4 S[4][2];
#pragma unroll
        for (int kt = 0; kt < 4; ++kt) { S[kt][0] = (f32x4){0.f, 0.f, 0.f, 0.f}; S[kt][1] = (f32x4){0.f, 0.f, 0.f, 0.f}; }
#pragma unroll
        for (int ks = 0; ks < DK / 32; ++ks)
#pragma unroll
            for (int kt = 0; kt < 4; ++kt) {
                const bf16x8 kf = *(const bf16x8*)(sK + (kt * 16 + l15) * KS + ks * 32 + quad * 8);
                S[kt][0] = __builtin_amdgcn_mfma_f32_16x16x32_bf16(kf, qf[0][ks], S[kt][0], 0, 0, 0);
                S[kt][1] = __builtin_amdgcn_mfma_f32_16x16x32_bf16(kf, qf[1][ks], S[kt][1], 0, 0, 0);
            }
        if (NAM) {
            if (j >= nt0) {
                const int kr = (s1 - 256) / 64 + (j - nt0);
#pragma unroll
                for (int qt = 0; qt < 2; ++qt) {
                    const int qi = wave * 32 + qt * 16 + l15, qrow = qr0 + (qi >> 6), qc = qi & 63;
                    const int st = clampi(qrow - 4, 0, 56), cs = clampi(qc - 8, 0, 48);
                    const bool rowok = (kr >= st) && (kr < st + 8);
                    const int rbase = (kr - qrow + 7) * 31 - qc + 15;
#pragma unroll
                    for (int kt = 0; kt < 4; ++kt)
#pragma unroll
                        for (int r = 0; r < 4; ++r) {
                            const int kcx = kt * 16 + quad * 4 + r;
                            const bool ok = rowok && (kcx >= cs) && (kcx < cs + 16);
                            const float bias = sR[ok ? (rbase + kcx) : 0];
                            S[kt][qt][r] = ok ? (S[kt][qt][r] + bias) : -1e30f;
                        }
                }
            }
        }
        bf16x8 pf[2][2];
#pragma unroll
        for (int qt = 0; qt < 2; ++qt) {
            float mx = -1e30f;
#pragma unroll
            for (int kt = 0; kt < 4; ++kt)
#pragma unroll
                for (int r = 0; r < 4; ++r) mx = fmaxf(mx, S[kt][qt][r]);
            mx = fmaxf(mx, __shfl_xor(mx, 16));
            mx = fmaxf(mx, __shfl_xor(mx, 32));
            const float mnew = fmaxf(mrun[qt], mx);
            const float alpha = __builtin_amdgcn_exp2f(mrun[qt] - mnew);
            mrun[qt] = mnew;
            float ps = 0.f;
#pragma unroll
            for (int kt = 0; kt < 4; ++kt)
#pragma unroll
                for (int r = 0; r < 4; ++r) { const float pv = __builtin_amdgcn_exp2f(S[kt][qt][r] - mnew); S[kt][qt][r] = pv; ps += pv; }
            lrun[qt] = lrun[qt] * alpha + ps;
            if (__any(alpha != 1.f)) {
#pragma unroll
                for (int dt = 0; dt < 4; ++dt) { Oa[dt][qt][0] *= alpha; Oa[dt][qt][1] *= alpha; Oa[dt][qt][2] *= alpha; Oa[dt][qt][3] *= alpha; }
            }
#pragma unroll
            for (int s = 0; s < 2; ++s) {
                u32x4 f;
                f[0] = pk2(S[2 * s][qt][0], S[2 * s][qt][1]); f[1] = pk2(S[2 * s][qt][2], S[2 * s][qt][3]);
                f[2] = pk2(S[2 * s + 1][qt][0], S[2 * s + 1][qt][1]); f[3] = pk2(S[2 * s + 1][qt][2], S[2 * s + 1][qt][3]);
                pf[qt][s] = __builtin_bit_cast(bf16x8, f);
            }
        }
#pragma unroll
        for (int s = 0; s < 2; ++s)
#pragma unroll
            for (int dt = 0; dt < 4; ++dt) {
                const bf16x4 v0 = *(const bf16x4*)(sV + (dt * 16 + l15) * 72 + (2 * s) * 16 + quad * 4);
                const bf16x4 v1 = *(const bf16x4*)(sV + (dt * 16 + l15) * 72 + (2 * s + 1) * 16 + quad * 4);
                const bf16x8 vf = __builtin_shufflevector(v0, v1, 0, 1, 2, 3, 4, 5, 6, 7);
                Oa[dt][0] = __builtin_amdgcn_mfma_f32_16x16x32_bf16(vf, pf[0][s], Oa[dt][0], 0, 0, 0);
                Oa[dt][1] = __builtin_amdgcn_mfma_f32_16x16x32_bf16(vf, pf[1][s], Oa[dt][1], 0, 0, 0);
            }
    }
#pragma unroll
    for (int qt = 0; qt < 2; ++qt) {
        float lt = lrun[qt];
        lt += __shfl_xor(lt, 16); lt += __shfl_xor(lt, 32);
        const float inv = 1.f / lt;
#pragma unroll
        for (int dt = 0; dt < 4; ++dt)
            st4(O + (size_t)(wave * 32 + qt * 16 + l15) * LDH + dt * 16 + quad * 4, Oa[dt][qt][0] * inv, Oa[dt][qt][1] * inv, Oa[dt][qt][2] * inv, Oa[dt][qt][3] * inv);
    }
}

DI void scan_item(const Params& p, int l, int item, char* smem) {
    float* sT = (float*)smem;
    float* sVv = sT + 16 * 320;
    float* sY = sVv + 256;
    const int tid = gtid(), lane = tid & 63, wave = tid >> 6;
    const int scan = item >> 2, rg = item & 3;
    const int b = scan >> 3, head = (scan >> 1) & 3, dir = scan & 1;
    const bf16_t* rkv = (const bf16_t*)(p.ws + O_RKV);
    const bf16_t* dec = (const bf16_t*)(p.ws + O_DEC);
    const float* invn = (const float*)(p.ws + O_INVN);
    float* yout = (float*)(p.ws + O_Y) + (size_t)dir * NT * 256;
    const int k2 = (tid & 31) * 2, tq = tid >> 5;
    const float* kkw = p.in[I_KK] + (size_t)(l * 2 + dir) * 256 + head * 64;
    const float* kaw = p.in[I_KA] + (size_t)(l * 2 + dir) * 256 + head * 64;
    const float kkc0 = kkw[k2], kkc1 = kkw[k2 + 1], kac0 = kaw[k2], kac1 = kaw[k2 + 1];
    unsigned rr[2], kr[2], ow[2], as[2]; float inn[2]; bf16_t vv;
    const int tbase = b * TPB;
#define SCAN_TOK(s) (tbase + (dir ? ((s) < 256 ? 255 - (s) : 4607 - (s)) : (s)))
#define SCAN_LOAD(ch)                                                                                          \
    {                                                                                                          \
        _Pragma("unroll") for (int i = 0; i < 2; ++i) {                                                        \
            const int tok = SCAN_TOK((ch) * 16 + tq + 8 * i);                                                  \
            rr[i] = *(const unsigned*)(rkv + (size_t)tok * 768 + head * 64 + k2);                              \
            kr[i] = *(const unsigned*)(rkv + (size_t)tok * 768 + 256 + head * 64 + k2);                        \
            ow[i] = *(const unsigned*)(dec + (size_t)tok * 1024 + dir * 256 + head * 64 + k2);                 \
            as[i] = *(const unsigned*)(dec + (size_t)tok * 1024 + 512 + dir * 256 + head * 64 + k2);           \
            inn[i] = invn[tok * 8 + dir * 4 + head];                                                           \
        }                                                                                                      \
        {                                                                                                      \
            const int tok = SCAN_TOK((ch) * 16 + (tid >> 4));                                                  \
            vv = rkv[(size_t)tok * 768 + 512 + head * 64 + rg * 16 + (tid & 15)];                              \
        }                                                                                                      \
    }
#define SCAN_YRED(ch)                                                                                          \
    {                                                                                                          \
        const int tl = tid >> 4, row = tid & 15;                                                               \
        const float* yp = sY + tl * 256 + (row >> 2) * 64 + (row & 3) * 16;                                    \
        const f32x4 q0 = *(const f32x4*)yp, q1 = *(const f32x4*)(yp + 4), q2 = *(const f32x4*)(yp + 8), q3 = *(const f32x4*)(yp + 12);   \
        const f32x4 qs = (q0 + q1) + (q2 + q3);                                                                \
        yout[(size_t)SCAN_TOK((ch) * 16 + tl) * 256 + head * 64 + rg * 16 + row] = (qs[0] + qs[1]) + (qs[2] + qs[3]);   \
    }
    float S0 = 0.f, S1 = 0.f, S2 = 0.f, S3 = 0.f;
    const int c = lane & 15, rloc = wave * 4 + (lane >> 4);
    __builtin_amdgcn_s_setprio(3);
    SCAN_LOAD(0);
    for (int ch = 0; ch < 272; ++ch) {
        __syncthreads();
        if (ch > 0) SCAN_YRED(ch - 1)
#pragma unroll
        for (int i = 0; i < 2; ++i) {
            float* base = sT + (tq + 8 * i) * 320 + k2;
            const float r0 = lo2f(rr[i]), r1 = hi2f(rr[i]), k0 = lo2f(kr[i]), k1 = hi2f(kr[i]);
            const float o0 = lo2f(ow[i]), o1 = hi2f(ow[i]), a0 = lo2f(as[i]), a1 = hi2f(as[i]);
            const float kk0 = k0 * kkc0 * inn[i], kk1 = k1 * kkc1 * inn[i];
            *(float2*)(base) = make_float2(1.f - o0, 1.f - o1);
            *(float2*)(base + 64) = make_float2(kk0, kk1);
            *(float2*)(base + 128) = make_float2(kk0 * a0, kk1 * a1);
            *(float2*)(base + 192) = make_float2(k0 * (1.f + (a0 - 1.f) * kac0), k1 * (1.f + (a1 - 1.f) * kac1));
            *(float2*)(base + 256) = make_float2(r0, r1);
        }
        sVv[tid] = bf2f(vv);
        __syncthreads();
        if (ch + 1 < 272) SCAN_LOAD(ch + 1);
#define SC_LD(bi, t0)                                                                                   \
    _Pragma("unroll") for (int q = 0; q < 2; ++q) {                                                     \
        const float* bp = sT + ((t0) + q) * 320 + c * 4;                                                \
        W4[bi][q] = *(const f32x4*)bp; K4[bi][q] = *(const f32x4*)(bp + 64); B4[bi][q] = *(const f32x4*)(bp + 128);   \
        D4[bi][q] = *(const f32x4*)(bp + 192); R4[bi][q] = *(const f32x4*)(bp + 256); VX[bi][q] = sVv[((t0) + q) * 16 + rloc];  \
    }
#define SC_CP(bi, t0)                                                                                   \
    _Pragma("unroll") for (int q = 0; q < 2; ++q) {                                                     \
        float sa = (S0 * K4[bi][q][0] + S1 * K4[bi][q][1]) + (S2 * K4[bi][q][2] + S3 * K4[bi][q][3]);   \
        sa = sum16(sa);                                                                                 \
        S0 = S0 * W4[bi][q][0] - sa * B4[bi][q][0] + VX[bi][q] * D4[bi][q][0];                          \
        S1 = S1 * W4[bi][q][1] - sa * B4[bi][q][1] + VX[bi][q] * D4[bi][q][1];                          \
        S2 = S2 * W4[bi][q][2] - sa * B4[bi][q][2] + VX[bi][q] * D4[bi][q][2];                          \
        S3 = S3 * W4[bi][q][3] - sa * B4[bi][q][3] + VX[bi][q] * D4[bi][q][3];                          \
        sY[((t0) + q) * 256 + tid] = (S0 * R4[bi][q][0] + S1 * R4[bi][q][1]) + (S2 * R4[bi][q][2] + S3 * R4[bi][q][3]);  \
    }
        {
            f32x4 W4[2][2], K4[2][2], B4[2][2], D4[2][2], R4[2][2]; float VX[2][2];
            SC_LD(0, 0);
#pragma unroll 1
            for (int it = 0; it < 4; ++it) {
                SC_LD(1, it * 4 + 2);
                SC_CP(0, it * 4);
                if (it < 3) SC_LD(0, it * 4 + 4);
                SC_CP(1, it * 4 + 2);
            }
        }
    }
    __syncthreads();
    SCAN_YRED(271)
#undef SC_LD
#undef SC_CP
#undef SCAN_YRED
#undef SCAN_LOAD
#undef SCAN_TOK
    __builtin_amdgcn_s_setprio(0);
}

DI void phase_mix(const Params& p, int l, char* smem, int* s_item) {
    char* ws = p.ws;
    int* ctr = (int*)(ws + O_CTL) + l;
    const bool want_ctx = l < 3;
    const int nattn = 3072 + (want_ctx ? 192 : 0);
    const int total = nattn + 2304 + (l < 3 ? 804 : 0);
    const bf16_t* naqk = (const bf16_t*)(ws + O_NAQK);
    const bf16_t* vta = (const bf16_t*)(ws + O_VTA);
    const bf16_t* gq = (const bf16_t*)(ws + O_GQ);
    const bf16_t* vtb = (const bf16_t*)(ws + O_VTB);
    const bf16_t* qc = (const bf16_t*)(ws + O_QC);
    const bf16_t* kc = (const bf16_t*)(ws + O_KC);
    const bf16_t* vtc = (const bf16_t*)(ws + O_VTC);
    bf16_t* mix = (bf16_t*)(ws + O_HBUF);
    const float* rpb = p.in[I_RPB] + (size_t)l * 4 * 465;
    {
        const int G = gridDim.x, bb = blockIdx.x;
        for (int sidx = 0; sidx < 256; ++sidx) {
            const int owner = (G == 512) ? ((sidx & 127) + (sidx >> 7) * 256) : (sidx % G);
            if (owner == bb) { for (int rep = 0; rep < REP_SCAN; ++rep) scan_item(p, l, sidx, smem); }
        }
    }
    while (true) {
        if (threadIdx.x == 0) *s_item = atomicAdd(ctr, 1);
        __syncthreads();
        const int item = *s_item;
        __syncthreads();
        if (item >= total) break;
        if (item >= nattn) { const int j = item - nattn; if (j < 2304) wconv_late(p, l, j, smem); else wconv_early(p, l + 1, j - 2304, smem); continue; }
        int type, b, h, qtok0, nkt0, qr0 = 0; bool isctx = false;
        if (item < 3072) {
            const int i1 = item;
            type = i1 >> 10;
            const int r = i1 & 1023;
            b = r >> 7; h = (r >> 5) & 3;
            const int qb = r & 31;
            qtok0 = b * TPB + 256 + qb * 128; nkt0 = 68; qr0 = qb * 2;
        } else {
            const int i2 = item - 3072;
            type = i2 >> 6;
            const int r = i2 & 63;
            b = r >> 3; h = (r >> 1) & 3;
            qtok0 = b * TPB + (r & 1) * 128; nkt0 = 4; isctx = true;
        }
        const size_t kb = (size_t)b * TPB;
        for (int rep = 0; rep < REP_ATTN; ++rep) {
            if (type == 0) {
                attn_item<96, false>(qc + (size_t)qtok0 * 384 + h * 96, 384, kc + kb * 384 + h * 96, 384, vtc + ((size_t)b * 256 + h * 64) * TPB,
                                     0, nkt0, 0, 0, mix + (size_t)qtok0 * LDH + 512 + h * 64, 0, nullptr, smem);
            } else if (type == 2 && !isctx) {
                const int st0 = clampi(qr0 - 4, 0, 56), st1 = clampi(qr0 + 1 - 4, 0, 56);
                attn_item<64, true>(naqk + (size_t)qtok0 * LDNA + h * 64, LDNA, naqk + kb * LDNA + 256 + h * 64, LDNA, vta + ((size_t)b * 256 + h * 64) * TPB,
                                    0, 4, 256 + st0 * 64, st1 + 8 - st0, mix + (size_t)qtok0 * LDH + h * 64, qr0, rpb + h * 465, smem);
            } else {
                const bf16_t *Qp, *Kp, *Vp; bf16_t* Op; int ld;
                if (type == 1) {
                    const int kvh = h >> 1;
                    Qp = gq + (size_t)qtok0 * 384 + h * 64; Kp = gq + kb * 384 + 256 + kvh * 64; Vp = vtb + ((size_t)b * 128 + kvh * 64) * TPB;
                    Op = mix + (size_t)qtok0 * LDH + 256 + h * 64; ld = 384;
                } else {
                    Qp = naqk + (size_t)qtok0 * LDNA + h * 64; Kp = naqk + kb * LDNA + 256 + h * 64; Vp = vta + ((size_t)b * 256 + h * 64) * TPB;
                    Op = mix + (size_t)qtok0 * LDH + h * 64; ld = LDNA;
                }
                attn_item<64, false>(Qp, ld, Kp, ld, Vp, 0, nkt0, 0, 0, Op, 0, nullptr, smem);
            }
        }
    }
}

DI void phase_rwkv_fin(const Params& p, int l) {
    const int tid = gtid(), lane = tid & 63, wave = tid >> 6;
    char* ws = p.ws;
    const float* yf = (const float*)(ws + O_Y);
    const float* yb = yf + (size_t)NT * 256;
    const bf16_t* rkv = (const bf16_t*)(ws + O_RKV);
    const bf16_t* dec = (const bf16_t*)(ws + O_DEC);
    const bf16_t* gate = (const bf16_t*)(ws + O_GATE);
    bf16_t* mix = (bf16_t*)(ws + O_HBUF);
    const int c = lane * 4;
    const float4 ka0 = *(const float4*)(p.in[I_KA] + (size_t)(l * 2) * 256 + c), ka1 = *(const float4*)(p.in[I_KA] + (size_t)(l * 2 + 1) * 256 + c);
    const float4 rk0 = *(const float4*)(p.in[I_RK] + (size_t)(l * 2) * 256 + c), rk1 = *(const float4*)(p.in[I_RK] + (size_t)(l * 2 + 1) * 256 + c);
    const float4 lw = *(const float4*)(p.in[I_LNW] + l * 256 + c), lb = *(const float4*)(p.in[I_LNB] + l * 256 + c);
    for (int tok = blockIdx.x * 4 + wave; tok < NT; tok += gridDim.x * 4) {
        const float4 a = *(const float4*)(yf + (size_t)tok * 256 + c), bb = *(const float4*)(yb + (size_t)tok * 256 + c);
        const float y0 = a.x + bb.x, y1 = a.y + bb.y, y2 = a.z + bb.z, y3 = a.w + bb.w;
        const float mu = sum16(y0 + y1 + y2 + y3) * (1.f / 64.f);
        const float d0 = y0 - mu, d1 = y1 - mu, d2 = y2 - mu, d3 = y3 - mu;
        const float var = sum16(d0 * d0 + d1 * d1 + d2 * d2 + d3 * d3) * (1.f / 64.f);
        const float rstd = rsqrtf(var + 64e-5f);
        const uint2 ur = *(const uint2*)(rkv + (size_t)tok * 768 + c), uk = *(const uint2*)(rkv + (size_t)tok * 768 + 256 + c), uv = *(const uint2*)(rkv + (size_t)tok * 768 + 512 + c);
        const uint2 uaf = *(const uint2*)(dec + (size_t)tok * 1024 + 512 + c), uab = *(const uint2*)(dec + (size_t)tok * 1024 + 768 + c);
        const uint2 ug = *(const uint2*)(gate + (size_t)tok * 256 + c);
        const float r0 = lo2f(ur.x), r1 = hi2f(ur.x), r2 = lo2f(ur.y), r3 = hi2f(ur.y);
        const float k0 = lo2f(uk.x), k1 = hi2f(uk.x), k2 = lo2f(uk.y), k3 = hi2f(uk.y);
        const float v0 = lo2f(uv.x), v1 = hi2f(uv.x), v2 = lo2f(uv.y), v3 = hi2f(uv.y);
        const float f0 = lo2f(uaf.x), f1 = hi2f(uaf.x), f2 = lo2f(uaf.y), f3 = hi2f(uaf.y);
        const float b0 = lo2f(uab.x), b1 = hi2f(uab.x), b2 = lo2f(uab.y), b3 = hi2f(uab.y);
        float bs = r0 * k0 * ((1.f + (f0 - 1.f) * ka0.x) * rk0.x + (1.f + (b0 - 1.f) * ka1.x) * rk1.x)
                 + r1 * k1 * ((1.f + (f1 - 1.f) * ka0.y) * rk0.y + (1.f + (b1 - 1.f) * ka1.y) * rk1.y)
                 + r2 * k2 * ((1.f + (f2 - 1.f) * ka0.z) * rk0.z + (1.f + (b2 - 1.f) * ka1.z) * rk1.z)
                 + r3 * k3 * ((1.f + (f3 - 1.f) * ka0.w) * rk0.w + (1.f + (b3 - 1.f) * ka1.w) * rk1.w);
        bs = sum16(bs);
        const float o0 = (d0 * rstd * lw.x + lb.x + bs * v0) * lo2f(ug.x);
        const float o1 = (d1 * rstd * lw.y + lb.y + bs * v1) * hi2f(ug.x);
        const float o2 = (d2 * rstd * lw.z + lb.z + bs * v2) * lo2f(ug.y);
        const float o3 = (d3 * rstd * lw.w + lb.w + bs * v3) * hi2f(ug.y);
        st4(mix + (size_t)tok * LDH + 768 + c, o0, o1, o2, o3);
    }
}

DI void phase_final(const Params& p) {
    const int tid = gtid(), lane = tid & 63, wave = tid >> 6;
    const float* g = p.in[I_FNG];
    for (int row = blockIdx.x * 4 + wave; row < NB * 4096; row += gridDim.x * 4) {
        float* x = p.out + (size_t)row * 1024;
        f32x4 v[4]; float ss = 0.f;
#pragma unroll
        for (int i = 0; i < 4; ++i) { v[i] = ((const f32x4*)x)[lane + 64 * i]; ss += v[i].x * v[i].x + v[i].y * v[i].y + v[i].z * v[i].z + v[i].w * v[i].w; }
        ss = wsum64(ss);
        const float rs = rsqrtf(ss * (1.f / 1024.f) + 1e-6f);
#pragma unroll
        for (int i = 0; i < 4; ++i) {
            const float4 g4 = ((const float4*)g)[lane + 64 * i];
            float4 o; o.x = v[i].x * rs * g4.x; o.y = v[i].y * rs * g4.y; o.z = v[i].z * rs * g4.z; o.w = v[i].w * rs * g4.w;
            ((float4*)x)[lane + 64 * i] = o;
        }
    }
}

#define XB_TMO      128
#define XB_XCNT(j)  (256  + 64 * (j))
#define XB_XSUB(j)  (1280 + 64 * (j))
#define XB_XGEN(j)  (2304 + 64 * (j))
#define XB_TOP      3328
#define XB_TOPGEN   3392
#define XCD_BAR_WORDS 3456
#define XB_SPIN_CAP (1u << 18)
#define LAS __attribute__((address_space(3)))

__device__ __forceinline__ unsigned xb_ld(unsigned* p)              { return __hip_atomic_load(p, __ATOMIC_RELAXED, __HIP_MEMORY_SCOPE_AGENT); }
__device__ __forceinline__ unsigned xb_add(unsigned* p, unsigned v) { return __hip_atomic_fetch_add(p, v, __ATOMIC_RELAXED, __HIP_MEMORY_SCOPE_AGENT); }
__device__ __forceinline__ unsigned xb_xcc_id() { return (unsigned)__builtin_amdgcn_s_getreg((3 << 11) | 20) & 0xFu; }
#define XB_SPIN(cond, bar) do { unsigned _sp = 0; while (cond) { __builtin_amdgcn_s_sleep(1); \
    if ((++_sp & 255u) == 0u) { if (xb_ld(&(bar)[XB_TMO])) break; if (_sp > XB_SPIN_CAP) { atomicAdd(&(bar)[XB_TMO], 1u); break; } } } } while (0)

struct XcdBarrier {
    unsigned* bar; unsigned x;
    volatile LAS unsigned* st;
};

__device__ __forceinline__ XcdBarrier xcd_barrier_post(unsigned* bar, volatile LAS unsigned* st) {
    XcdBarrier b; b.bar = bar; b.x = xb_xcc_id(); b.st = st;
    if (threadIdx.x == 0) (void)xb_add(&bar[XB_XCNT(b.x)], 1u);
    return b;
}
__device__ __forceinline__ void xcd_barrier_complete(unsigned* bar, unsigned x, unsigned& nloc, unsigned& nx) {
    const unsigned G = gridDim.x * gridDim.y * gridDim.z;
    unsigned sum, cnt, mine, sp = 0u;
    for (;;) {
        sum = 0u; cnt = 0u; mine = 0u;
#pragma unroll
        for (unsigned j = 0; j < 16; ++j) { const unsigned c = xb_ld(&bar[XB_XCNT(j)]); sum += c; cnt += (c > 0u) ? 1u : 0u; mine = (j == x) ? c : mine; }
        if (sum == G) break;
        __builtin_amdgcn_s_sleep(1);
        if ((++sp & 255u) == 0u) { if (xb_ld(&bar[XB_TMO])) break; if (sp > XB_SPIN_CAP) { atomicAdd(&bar[XB_TMO], 1u); break; } }
    }
    nloc = mine > 0u ? mine : 1u; nx = cnt > 0u ? cnt : 1u;
}

__device__ __forceinline__ void xcd_barrier(const XcdBarrier& b) {
    asm volatile("s_waitcnt vmcnt(0)" ::: "memory");
    __syncthreads();
    if (threadIdx.x == 0) {
        unsigned* bar = b.bar;
        __builtin_amdgcn_s_waitcnt(0);
        unsigned nloc = b.st[0], nx = b.st[1];
        if (nloc == 0u) { xcd_barrier_complete(bar, b.x, nloc, nx); b.st[0] = nloc; b.st[1] = nx; }
        const unsigned old = xb_add(&bar[XB_XSUB(b.x)], 1u);
        const unsigned gen = old / nloc;
        if (old + 1u == (gen + 1u) * nloc) {
            __builtin_amdgcn_fence(__ATOMIC_RELEASE, "agent");
            asm volatile("s_waitcnt vmcnt(0)" ::: "memory");
            const unsigned og = xb_add(&bar[XB_TOP], 1u);
            const unsigned tg = og / nx;
            if (og + 1u == (tg + 1u) * nx) xb_add(&bar[XB_TOPGEN], 1u);
            else XB_SPIN(xb_ld(&bar[XB_TOPGEN]) == tg, bar);
            __builtin_amdgcn_fence(__ATOMIC_ACQUIRE, "agent");
            xb_add(&bar[XB_XGEN(b.x)], 1u);
            asm volatile("s_waitcnt vmcnt(0)" ::: "memory");
        } else {
            XB_SPIN(xb_ld(&bar[XB_XGEN(b.x)]) == gen, bar);
            __builtin_amdgcn_fence(__ATOMIC_ACQUIRE, "agent");
            asm volatile("s_waitcnt vmcnt(0)" ::: "memory");
        }
    }
    __syncthreads();
}


__global__ void __launch_bounds__(256, 3) mega(Params p) {
    __shared__ __attribute__((aligned(16))) char smem[49152];
    __shared__ int s_item;
    __shared__ uint4 xb_words;
    cg::grid_group grid = cg::this_grid();
    if (threadIdx.x == 0) xb_words = make_uint4(0u, 0u, 0u, 0u);
    __syncthreads();
    XcdBarrier xb = xcd_barrier_post((unsigned*)(p.ws + O_CTL), (volatile LAS unsigned*)&xb_words);
    char* ws = p.ws;
    const int G = gridDim.x;
    const int pb = ((G & 7) == 0) ? ((int)(blockIdx.x & 7) * (G >> 3) + (int)(blockIdx.x >> 3)) : (int)blockIdx.x;
    float* xc = (float*)(ws + O_XC);
    bf16_t* hbuf = (bf16_t*)(ws + O_HBUF);

    phase_mod(p, smem);
    phase_wconv(p, 0, smem);
    grid.sync();
    for (int step = 0; step < 40; ++step) {
        const int l = step / 10, ph = step - l * 10;
        const float* modl = (const float*)(ws + O_MOD) + (size_t)l * 9 * 6144;
        const float* xl_src = (l == 0) ? p.in[I_X] : p.out;
        const float* xc_src = (l == 0) ? p.in[I_CTX] : xc;
        switch (ph) {
        case 0: {
            for (int rep = 0; rep < REP_EWA; ++rep) phase_norm(xl_src, xc_src, p.in[I_N1G] + l * 1024, modl, 0, 1, hbuf);
        } break;
        case 1: {
            {
                EpiIn e{(bf16_t*)(ws + O_NAQK), (bf16_t*)(ws + O_VTA), (bf16_t*)(ws + O_GQ), (bf16_t*)(ws + O_VTB), (bf16_t*)(ws + O_MLAR), (bf16_t*)(ws + O_RWR)};
                for (int rep = 0; rep < REP_GEMM; ++rep) for (int t = pb; t < 272 * 23; t += G) { int mt, nt; tile_mn(t, 23, mt, nt); gemm_tile(hbuf, LDH, (const bf16_t*)(ws + O_WIN), LDW1, 1024, mt * 128, nt * 128, smem, e); }
            }
        } break;
        case 2: {
            phase_post(p, l);
        } break;
        case 3: {
            {
                EpiUQ e1{(bf16_t*)(ws + O_QC), (const float*)(ws + O_RSM)};
                EpiUKV e2{(bf16_t*)(ws + O_KC), (bf16_t*)(ws + O_VTC), (const float*)(ws + O_RSM)};
                EpiAux e3{(bf16_t*)(ws + O_DEC), (bf16_t*)(ws + O_GATE), p.in[I_W0] + l * 512, p.in[I_A0] + l * 512};
                const bf16_t* mlar = (const bf16_t*)(ws + O_MLAR);
                for (int rep = 0; rep < REP_GEMM; ++rep) for (int t = pb; t < 272 * 17; t += G) {
                    const int mt = t / 17, j = t % 17;
                    if (j < 3) gemm_tile(mlar, 416, (const bf16_t*)(ws + O_WUQ), 256, 256, mt * 128, j * 128, smem, e1);
                    else if (j < 7) gemm_tile(mlar + 256, 416, (const bf16_t*)(ws + O_WUKV), 128, 128, mt * 128, (j - 3) * 128, smem, e2);
                    else {
                        const int n0 = (j - 7) * 128, blk = n0 >> 8;
                        if (blk < 4) {
                            gemm_tile(hbuf + blk * 64, 448, (const bf16_t*)(ws + O_WAUX) + (size_t)blk * 256 * 64 - (size_t)(blk * 256) * 64, 64, 64, mt * 128, n0, smem, e3);
                        } else {
                            gemm_tile(hbuf + 256, 448, (const bf16_t*)(ws + O_WG2) - (size_t)1024 * 192, 192, 192, mt * 128, n0, smem, e3);
                        }
                    }
                }
            }
        } break;
        case 4: {
            phase_mix(p, l, smem, &s_item);
        } break;
        case 5: {
            for (int rep = 0; rep < REP_EW; ++rep) phase_rwkv_fin(p, l);
        } break;
        case 6: {
            {
                EpiRes e{xl_src, xc_src, p.out, xc, modl + 2 * 1024};
                for (int t = pb; t < 272 * 8; t += G) { int mt, nt; tile_mn(t, 8, mt, nt); if (l == 3 && (mt % 34) < 2) continue;
                    gemm_tile(hbuf, LDH, (const bf16_t*)(ws + O_WOUT), LDW1, 1024, mt * 128, nt * 128, smem, e); }
            }
        } break;
        case 7: {
            for (int rep = 0; rep < REP_EW; ++rep) phase_norm(p.out, xc, p.in[I_N2G] + l * 1024, modl, 3, 4, hbuf);
        } break;
        case 8: {
            {
                EpiFc1 e{(bf16_t*)(ws + O_HID)};
                for (int rep = 0; rep < REP_GEMM; ++rep) for (int t = pb; t < 272 * 32; t += G) { int mt, nt; tile_mn(t, 32, mt, nt); if (l == 3 && (mt % 34) < 2) continue;
                    gemm_tile(hbuf, LDH, (const bf16_t*)(ws + O_WFC1), LDW1, 1024, mt * 128, nt * 128, smem, e); }
            }
        } break;
        case 9: {
            {
                EpiRes e{p.out, xc, p.out, xc, modl + 5 * 1024};
                for (int t = pb; t < 272 * 8; t += G) { int mt, nt; tile_mn(t, 8, mt, nt); if (l == 3 && (mt % 34) < 2) continue;
                    gemm_tile((const bf16_t*)(ws + O_HID), LDHID, (const bf16_t*)(ws + O_WFC2), LDW4, 4096, mt * 128, nt * 128, smem, e); }
            }
        } break;
        }
        for (int rep = 0; rep < REP_SYNC; ++rep) xcd_barrier(xb);
    }
    phase_final(p);
}

extern "C" void kernel_launch(void* const* d_in, const int* in_sizes, int n_in, void* d_out, int out_size, void* d_ws, size_t ws_size, hipStream_t stream) {
    static int grid_blocks = 0;
    if (n_in != 31 || ws_size < O_END) { fprintf(stderr, "kernel_launch: bad n_in %d or ws_size %zu < %zu\n", n_in, ws_size, (size_t)O_END); return; }
    if (!grid_blocks) {
        int dev = 0, cus = 0, per_cu = 0;
        hipGetDevice(&dev);
        hipDeviceGetAttribute(&cus, hipDeviceAttributeMultiprocessorCount, dev);
        hipOccupancyMaxActiveBlocksPerMultiprocessor(&per_cu, mega, 256, 0);
        if (per_cu > 3) per_cu = 3;
        if (per_cu < 1) per_cu = 1;
        grid_blocks = cus * per_cu;
    }
    Params p{};
    for (int i = 0; i < 31; ++i) p.in[i] = (const float*)d_in[i];
    p.out = (float*)d_out;
    p.ws = (char*)d_ws;
    (void)hipMemsetAsync(d_ws, 0, 16384, stream);
    void* args[] = {&p};
    hipError_t e = hipLaunchCooperativeKernel((void*)mega, dim3(grid_blocks), dim3(256), args, 0, stream);
    if (e != hipSuccess) fprintf(stderr, "cooperative launch failed: %s (grid %d)\n", hipGetErrorString(e), grid_blocks);
}
```

```cpp
#include <hip/hip_runtime.h>
#include <hip/hip_cooperative_groups.h>
#include <stdint.h>
#include <stdio.h>
namespace cg = cooperative_groups;
#ifndef REP_GEMM
#define REP_GEMM 1
#endif
#ifndef REP_ATTN
#define REP_ATTN 1
#endif
#ifndef REP_EW
#define REP_EW 1
#endif
#ifndef REP_SYNC
#define REP_SYNC 1
#endif
#ifndef REP_EWA
#define REP_EWA 1
#endif
#ifndef REP_SCAN
#define REP_SCAN 1
#endif

#define DI __device__ __forceinline__
typedef unsigned short bf16_t;
typedef short bf16x8 __attribute__((ext_vector_type(8)));
typedef short bf16x4 __attribute__((ext_vector_type(4)));
typedef float f32x4 __attribute__((ext_vector_type(4)));
typedef unsigned u32x4 __attribute__((ext_vector_type(4)));

constexpr int NB = 8, TPB = 4352, NT = NB * TPB;
constexpr int INC = 2880, INP = 2944;
constexpr int LDH = 1088, LDHID = 4160, LDW1 = 1088, LDW4 = 4160, LDNA = 576;
constexpr float LOG2E = 1.4426950408889634f;
constexpr float QS64 = 0.125f * LOG2E;
constexpr float QS96 = 0.10206207261596577f * LOG2E;
constexpr float ROPE_L2T = 13.287712379549449f;

constexpr size_t al(size_t x) { return (x + 255) & ~size_t(255); }
constexpr size_t O_CTL = 0;
constexpr size_t O_MOD = 16384;
constexpr size_t O_XC = O_MOD + al((size_t)4 * 9 * 6144 * 4);
constexpr size_t O_WIN = O_XC + al((size_t)2048 * 1024 * 4);
constexpr size_t O_WOUT = O_WIN + al((size_t)INP * LDW1 * 2);
constexpr size_t O_WFC1 = O_WOUT + al((size_t)1024 * LDW1 * 2);
constexpr size_t O_WFC2 = O_WFC1 + al((size_t)4096 * LDW1 * 2);
constexpr size_t O_WUQ = O_WFC2 + al((size_t)1024 * LDW4 * 2);
constexpr size_t O_WUKV = O_WUQ + al((size_t)384 * 256 * 2);
constexpr size_t O_WAUX = O_WUKV + al((size_t)512 * 128 * 2);
constexpr size_t O_WG2 = O_WAUX + al((size_t)4 * 256 * 64 * 2);
constexpr size_t O_HBUF = O_WG2 + al((size_t)256 * 192 * 2);
constexpr size_t O_BIG = O_HBUF + al((size_t)NT * LDH * 2);
constexpr size_t O_NAQK = O_BIG;
constexpr size_t O_VTA = O_NAQK + al((size_t)NT * LDNA * 2);
constexpr size_t O_GQ = O_VTA + al((size_t)NB * 256 * TPB * 2);
constexpr size_t O_VTB = O_GQ + al((size_t)NT * 384 * 2);
constexpr size_t O_MLAR = O_VTB + al((size_t)NB * 128 * TPB * 2);
constexpr size_t O_RWR = O_MLAR + al((size_t)NT * 416 * 2);
constexpr size_t O_QC = O_RWR + al((size_t)NT * 1184 * 2);
constexpr size_t O_KC = O_QC + al((size_t)NT * 384 * 2);
constexpr size_t O_VTC = O_KC + al((size_t)NT * 384 * 2);
constexpr size_t O_RKV = O_VTC + al((size_t)NB * 256 * TPB * 2);
constexpr size_t O_DEC = O_RKV + al((size_t)NT * 768 * 2);
constexpr size_t O_GATE = O_DEC + al((size_t)NT * 1024 * 2);
constexpr size_t O_INVN = O_GATE + al((size_t)NT * 256 * 2);
constexpr size_t O_RSM = O_INVN + al((size_t)NT * 8 * 4);
constexpr size_t O_END = O_RSM + al((size_t)NT * 2 * 4);
constexpr size_t O_HID = O_BIG;
constexpr size_t O_Y = O_RWR;
static_assert(O_HID + (size_t)NT * LDHID * 2 <= O_END, "hidden overlay");
static_assert(O_END <= (size_t)512 * 1024 * 1024, "workspace");
static_assert((size_t)2 * NT * 256 * 4 <= (size_t)NT * 1184 * 2, "y overlay");

struct Params {
    const float* in[31];
    float* out;
    char* ws;
};

enum { I_X = 0, I_C, I_CTX, I_CCTX, I_WMOD, I_BMOD, I_N1G, I_N2G, I_WIN, I_SHIFT, I_RPB, I_GQN, I_GKN, I_MQN, I_MKVN, I_WUQ, I_WUKV,
       I_W0, I_W2, I_A0, I_A2, I_KK, I_KA, I_RK, I_G2, I_LNW, I_LNB, I_WOUT, I_FC1, I_FC2, I_FNG };

typedef __bf16 hwbf16x2 __attribute__((ext_vector_type(2)));
typedef float f32x2 __attribute__((ext_vector_type(2)));
DI unsigned pk2(float a, float b) { f32x2 v = {a, b}; hwbf16x2 r = __builtin_convertvector(v, hwbf16x2); return __builtin_bit_cast(unsigned, r); }
DI bf16_t f2bf(float x) { return (bf16_t)(pk2(x, x) & 0xffffu); }
DI float bf2f(bf16_t b) { return __uint_as_float(((unsigned)b) << 16); }
DI float lo2f(unsigned u) { return __uint_as_float(u << 16); }
DI float hi2f(unsigned u) { return __uint_as_float(u & 0xffff0000u); }
DI void st4(bf16_t* p, float a, float b, float c, float d) { uint2 u; u.x = pk2(a, b); u.y = pk2(c, d); *(uint2*)p = u; }
template <int CTRL> DI float dppf(float v) { return __int_as_float(__builtin_amdgcn_update_dpp(0, __float_as_int(v), CTRL, 0xF, 0xF, true)); }
DI float sum16(float v) { v += dppf<0xB1>(v); v += dppf<0x4E>(v); v += dppf<0x141>(v); v += dppf<0x140>(v); return v; }
DI float wsum64(float v) { v = sum16(v); v += __shfl_xor(v, 16); v += __shfl_xor(v, 32); return v; }
DI float sigm(float x) { return 1.f / (1.f + __expf(-x)); }
DI int gtid() { int t = threadIdx.x; asm volatile("" : "+v"(t)); return t; }
DI int clampi(int v, int lo, int hi) { return v < lo ? lo : (v > hi ? hi : v); }

template <class T> struct IsRes;
template <class T> struct HasRS;
template <class T> struct HasCV;
template <class Epi>
DI void gemm_tile(const bf16_t* __restrict__ A, int lda, const bf16_t* __restrict__ Bt, int ldb, int K, int m0, int n0, char* smem, const Epi& epi) {
    char* sA = smem;
    char* sB = smem + 16384;
    const int tid = gtid(), lane = tid & 63, wave = tid >> 6;
    const int wm = wave >> 1, wn = wave & 1, l15 = lane & 15, quad = lane >> 4;
    f32x4 acc[4][4];
#pragma unroll
    for (int i = 0; i < 4; ++i)
#pragma unroll
        for (int j = 0; j < 4; ++j) acc[i][j] = (f32x4){0.f, 0.f, 0.f, 0.f};
    const int srow = lane >> 3, skc = (lane & 7) ^ (lane >> 3);
    const bf16_t* Ag = A + (size_t)(m0 + wave * 8 + srow) * lda + skc * 8;
    const bf16_t* Bg = Bt + (size_t)(n0 + wave * 8 + srow) * ldb + skc * 8;
    const size_t a32 = (size_t)32 * lda, b32 = (size_t)32 * ldb;
    const int sw = l15 & 7;
    for (int k0 = 0; k0 < K; k0 += 64) {
        __syncthreads();
#pragma unroll
        for (int i = 0; i < 4; ++i) {
            __builtin_amdgcn_global_load_lds((const unsigned*)(Ag + i * a32 + k0), (__attribute__((address_space(3))) unsigned*)(sA + (i * 4 + wave) * 1024), 16, 0, 0);
            __builtin_amdgcn_global_load_lds((const unsigned*)(Bg + i * b32 + k0), (__attribute__((address_space(3))) unsigned*)(sB + (i * 4 + wave) * 1024), 16, 0, 0);
        }
        asm volatile("s_waitcnt vmcnt(0)" ::: "memory");
        __syncthreads();
#pragma unroll
        for (int ks = 0; ks < 2; ++ks) {
            bf16x8 wf[4], xf[4];
            const int co = ((ks * 4 + quad) ^ sw) * 16;
#pragma unroll
            for (int t = 0; t < 4; ++t) {
                wf[t] = *(const bf16x8*)(sB + (wn * 64 + t * 16 + l15) * 128 + co);
                xf[t] = *(const bf16x8*)(sA + (wm * 64 + t * 16 + l15) * 128 + co);
            }
#pragma unroll
            for (int nt = 0; nt < 4; ++nt)
#pragma unroll
                for (int mt = 0; mt < 4; ++mt) acc[nt][mt] = __builtin_amdgcn_mfma_f32_16x16x32_bf16(wf[nt], xf[mt], acc[nt][mt], 0, 0, 0);
        }
    }
    if constexpr (IsRes<Epi>::value) {
#pragma unroll
        for (int nt = 0; nt < 4; ++nt) {
            f32x4 xv[4], gv[4];
#pragma unroll
            for (int mt = 0; mt < 4; ++mt) epi.loadxg(m0 + wm * 64 + mt * 16 + l15, n0 + wn * 64 + nt * 16 + quad * 4, xv[mt], gv[mt]);
#pragma unroll
            for (int mt = 0; mt < 4; ++mt) epi.storex(m0 + wm * 64 + mt * 16 + l15, n0 + wn * 64 + nt * 16 + quad * 4, xv[mt], gv[mt], acc[nt][mt]);
        }
    } else if constexpr (HasCV<Epi>::value) {
        f32x4 cv4[4];
#pragma unroll
        for (int nt = 0; nt < 4; ++nt) cv4[nt] = epi.colvec(n0 + wn * 64 + nt * 16 + quad * 4);
#pragma unroll
        for (int nt = 0; nt < 4; ++nt)
#pragma unroll
            for (int mt = 0; mt < 4; ++mt) epi.apply(m0 + wm * 64 + mt * 16 + l15, n0 + wn * 64 + nt * 16 + quad * 4, acc[nt][mt], cv4[nt]);
    } else if constexpr (HasRS<Epi>::value) {
        float rs4[4];
#pragma unroll
        for (int mt = 0; mt < 4; ++mt) rs4[mt] = epi.rowscale(m0 + wm * 64 + mt * 16 + l15);
#pragma unroll
        for (int nt = 0; nt < 4; ++nt)
#pragma unroll
            for (int mt = 0; mt < 4; ++mt) epi.apply(m0 + wm * 64 + mt * 16 + l15, n0 + wn * 64 + nt * 16 + quad * 4, acc[nt][mt], rs4[mt]);
    } else {
#pragma unroll
        for (int nt = 0; nt < 4; ++nt)
#pragma unroll
            for (int mt = 0; mt < 4; ++mt) epi(m0 + wm * 64 + mt * 16 + l15, n0 + wn * 64 + nt * 16 + quad * 4, acc[nt][mt]);
    }
}

DI void tile_mn(int t, int nn, int& mt, int& nt) { const int sup = t / (8 * nn), tin = t - sup * 8 * nn; mt = sup * 8 + (tin & 7); nt = tin >> 3; }

struct EpiIn {
    bf16_t *naqk, *vta, *gq, *vtb, *mlar, *rwr;
    DI void operator()(int m, int n, f32x4 v) const {
        if (n >= INC) return;
        if (n < 512) {
            const float s = (n < 256) ? QS64 : 1.f;
            st4(naqk + (size_t)m * LDNA + n, v[0] * s, v[1] * s, v[2] * s, v[3] * s);
        } else if (n < 768) {
            const int b = m / TPB, tib = m - b * TPB;
            bf16_t* d = vta + ((size_t)b * 256 + (n - 512)) * TPB + tib;
            d[0] = f2bf(v[0]); d[TPB] = f2bf(v[1]); d[2 * TPB] = f2bf(v[2]); d[3 * TPB] = f2bf(v[3]);
        } else if (n < 1152) {
            st4(gq + (size_t)m * 384 + (n - 768), v[0], v[1], v[2], v[3]);
        } else if (n < 1280) {
            const int b = m / TPB, tib = m - b * TPB;
            bf16_t* d = vtb + ((size_t)b * 128 + (n - 1152)) * TPB + tib;
            d[0] = f2bf(v[0]); d[TPB] = f2bf(v[1]); d[2 * TPB] = f2bf(v[2]); d[3 * TPB] = f2bf(v[3]);
        } else if (n < 1696) {
            st4(mlar + (size_t)m * 416 + (n - 1280), v[0], v[1], v[2], v[3]);
        } else {
            st4(rwr + (size_t)m * 1184 + (n - 1696), v[0], v[1], v[2], v[3]);
        }
    }
};

DI void rope_rot(float& a, float& b, int pos, float fidx, float fscale) {
    const float ang = (float)pos * __builtin_amdgcn_exp2f(-fidx * fscale);
    const float c = __cosf(ang), s = __sinf(ang);
    const float a2 = a * c - b * s, b2 = a * s + b * c;
    a = a2; b = b2;
}

struct EpiUQ {
    bf16_t* qc; const float* rsm;
    DI float rowscale(int m) const { return rsm[m * 2] * QS96; }
    DI void operator()(int m, int n, f32x4 v) const { apply(m, n, v, rowscale(m)); }
    DI void apply(int m, int n, f32x4 v, float rs) const {
        float a = v[0] * rs, b = v[1] * rs, c = v[2] * rs, d = v[3] * rs;
        const int h = n / 96, dd = n - h * 96;
        const int bb = m / TPB, tib = m - bb * TPB;
        if (dd >= 64 && tib >= 256) {
            const int t = tib - 256, row = t >> 6, col = t & 63;
            const int i0 = (dd - 64) >> 1, i1 = i0 + 1;
            rope_rot(a, b, i0 < 8 ? row : col, (float)(i0 & 7), ROPE_L2T / 8.f);
            rope_rot(c, d, i1 < 8 ? row : col, (float)(i1 & 7), ROPE_L2T / 8.f);
        }
        st4(qc + (size_t)m * 384 + n, a, b, c, d);
    }
};
struct EpiUKV {
    bf16_t *kc, *vtc; const float* rsm;
    DI float rowscale(int m) const { return rsm[m * 2 + 1]; }
    DI void operator()(int m, int n, f32x4 v) const { apply(m, n, v, rowscale(m)); }
    DI void apply(int m, int n, f32x4 v, float rs) const {
        const int h = n >> 7, dd = n & 127;
        if (dd < 64) {
            st4(kc + (size_t)m * 384 + h * 96 + dd, v[0] * rs, v[1] * rs, v[2] * rs, v[3] * rs);
        } else {
            const int b = m / TPB, tib = m - b * TPB;
            bf16_t* d = vtc + ((size_t)b * 256 + h * 64 + (dd - 64)) * TPB + tib;
            d[0] = f2bf(v[0] * rs); d[TPB] = f2bf(v[1] * rs); d[2 * TPB] = f2bf(v[2] * rs); d[3 * TPB] = f2bf(v[3] * rs);
        }
    }
};
struct EpiAux {
    bf16_t *dec, *gate; const float *w0, *a0;
    DI f32x4 colvec(int n) const {
        const int j = n >> 8, c = n & 255;
        if (j < 2) return *(const f32x4*)(w0 + j * 256 + c);
        if (j < 4) return *(const f32x4*)(a0 + (j - 2) * 256 + c);
        return (f32x4){0.f, 0.f, 0.f, 0.f};
    }
    DI void operator()(int m, int n, f32x4 v) const { apply(m, n, v, colvec(n)); }
    DI void apply(int m, int n, f32x4 v, f32x4 off) const {
        const int j = n >> 8, c = n & 255;
        float o[4];
        if (j < 2) {
#pragma unroll
            for (int r = 0; r < 4; ++r) {
                const float u = off[r] + v[r];
                const float z = -u;
                const float sp = fmaxf(z, 0.f) + __logf(1.f + __expf(-fabsf(z)));
                const float w = -sp - 0.5f;
                const float e = __expf(w);
                o[r] = 1.f - __expf(-e);
            }
            st4(dec + (size_t)m * 1024 + j * 256 + c, o[0], o[1], o[2], o[3]);
        } else if (j < 4) {
#pragma unroll
            for (int r = 0; r < 4; ++r) o[r] = sigm(off[r] + v[r]);
            st4(dec + (size_t)m * 1024 + 512 + (j - 2) * 256 + c, o[0], o[1], o[2], o[3]);
        } else {
            st4(gate + (size_t)m * 256 + c, v[0], v[1], v[2], v[3]);
        }
    }
};
struct EpiRes {
    const float *srcl, *srcc; float *dstl, *dstc; const float* modg;
    DI void loadxg(int m, int n, f32x4& x, f32x4& g) const {
        const int b = m / TPB, tib = m - b * TPB;
        const float* s; int mr;
        if (tib < 256) { s = srcc + ((size_t)b * 256 + tib) * 1024 + n; mr = 8; }
        else { s = srcl + ((size_t)b * 4096 + (tib - 256)) * 1024 + n; mr = b; }
        g = *(const f32x4*)(modg + mr * 6144 + n);
        x = *(const f32x4*)s;
    }
    DI void storex(int m, int n, const f32x4& x, const f32x4& g, f32x4 v) const {
        const int b = m / TPB, tib = m - b * TPB;
        float* d = (tib < 256) ? dstc + ((size_t)b * 256 + tib) * 1024 + n : dstl + ((size_t)b * 4096 + (tib - 256)) * 1024 + n;
        *(f32x4*)d = x + g * v;
    }
    DI void operator()(int m, int n, f32x4 v) const { f32x4 x, g; loadxg(m, n, x, g); storex(m, n, x, g, v); }
};
template <class T> struct IsRes { static constexpr bool value = false; };
template <class T> struct HasRS { static constexpr bool value = false; };
template <> struct HasRS<EpiUQ> { static constexpr bool value = true; };
template <> struct HasRS<EpiUKV> { static constexpr bool value = true; };
template <class T> struct HasCV { static constexpr bool value = false; };
template <> struct HasCV<EpiAux> { static constexpr bool value = true; };
template <> struct IsRes<EpiRes> { static constexpr bool value = true; };
struct EpiFc1 {
    bf16_t* hid;
    DI void operator()(int m, int n, f32x4 v) const {
        float a = fmaxf(v[0], 0.f), b = fmaxf(v[1], 0.f), c = fmaxf(v[2], 0.f), d = fmaxf(v[3], 0.f);
        st4(hid + (size_t)m * LDHID + n, a * a, b * b, c * c, d * d);
    }
};

DI void phase_mod(const Params& p, char* smem) {
    float* sc = (float*)smem;
    float* red = sc + 9 * 1024;
    const int tid = gtid(), lane = tid & 63, wave = tid >> 6;
    for (int i = tid; i < 9 * 1024; i += 256) { const float v = (i < 8192) ? p.in[I_C][i] : p.in[I_CCTX][i - 8192]; sc[i] = v / (1.f + __expf(-v)); }
    __syncthreads();
    float* mod = (float*)(p.ws + O_MOD);
    for (int item = blockIdx.x; item < 4 * 96; item += gridDim.x) {
        const int l = item / 96, nb = (item % 96) * 64;
        const float* w = p.in[I_WMOD] + (size_t)l * 1024 * 6144 + nb + lane;
        float acc[9];
#pragma unroll
        for (int r = 0; r < 9; ++r) acc[r] = 0.f;
#pragma unroll 8
        for (int k = wave * 256; k < wave * 256 + 256; ++k) {
            const float wv = w[(size_t)k * 6144];
#pragma unroll
            for (int r = 0; r < 9; ++r) acc[r] += sc[r * 1024 + k] * wv;
        }
#pragma unroll
        for (int r = 0; r < 9; ++r) red[(wave * 9 + r) * 64 + lane] = acc[r];
        __syncthreads();
        for (int i = tid; i < 9 * 64; i += 256) {
            const int r = i >> 6, ln = i & 63;
            const float s = red[(0 * 9 + r) * 64 + ln] + red[(1 * 9 + r) * 64 + ln] + red[(2 * 9 + r) * 64 + ln] + red[(3 * 9 + r) * 64 + ln];
            mod[((size_t)l * 9 + r) * 6144 + nb + ln] = s + p.in[I_BMOD][l * 6144 + nb + ln];
        }
        __syncthreads();
    }
}

DI void wconv_tile(const float* src, const float* g, int K, int N, bf16_t* dst, int nkt, int ldd, int t, char* smem) {
    float* tile = (float*)smem;
    const int tid = gtid();
    const int kt = t % nkt, nt = t / nkt, k0 = kt * 64, n0 = nt * 64;
    __syncthreads();
#pragma unroll 4
    for (int i = 0; i < 16; ++i) {
        const int kl = (tid >> 6) + 4 * i, nl = tid & 63, k = k0 + kl, n = n0 + nl;
        float v = 0.f;
        if (k < K && n < N) { v = src[(size_t)k * N + n]; if (g) v *= g[k]; }
        tile[kl * 65 + nl] = v;
    }
    __syncthreads();
#pragma unroll 4
    for (int i = 0; i < 8; ++i) {
        const int nl = (tid >> 5) + 8 * i, kl = (tid & 31) * 2;
        *(unsigned*)(dst + (size_t)(n0 + nl) * ldd + k0 + kl) = pk2(tile[kl * 65 + nl], tile[(kl + 1) * 65 + nl]);
    }
}
DI void wconv(const float* src, const float* g, int K, int N, bf16_t* dst, int Kp, int Np, int ldd, int rot, char* smem) {
    const int nkt = Kp / 64, nnt = Np / 64, G = gridDim.x;
    for (int t = (blockIdx.x + G - (rot % G)) % G; t < nkt * nnt; t += G) wconv_tile(src, g, K, N, dst, nkt, ldd, t, smem);
}
DI void wconv_late(const Params& p, int l, int u, char* smem) {
    char* ws = p.ws;
    if (u < 1024) wconv_tile(p.in[I_FC1] + (size_t)l * 1024 * 4096, nullptr, 1024, 4096, (bf16_t*)(ws + O_WFC1), 16, LDW1, u, smem);
    else if (u < 2048) wconv_tile(p.in[I_FC2] + (size_t)l * 4096 * 1024, nullptr, 4096, 1024, (bf16_t*)(ws + O_WFC2), 64, LDW4, u - 1024, smem);
    else wconv_tile(p.in[I_WOUT] + (size_t)l * 1024 * 1024, nullptr, 1024, 1024, (bf16_t*)(ws + O_WOUT), 16, LDW1, u - 2048, smem);
}
DI void wconv_early(const Params& p, int l, int u, char* smem) {
    char* ws = p.ws;
    if (u < 736) wconv_tile(p.in[I_WIN] + (size_t)l * 1024 * INC, nullptr, 1024, INC, (bf16_t*)(ws + O_WIN), 16, LDW1, u, smem);
    else if (u < 760) wconv_tile(p.in[I_WUQ] + (size_t)l * 256 * 384, p.in[I_MQN] + l * 256, 256, 384, (bf16_t*)(ws + O_WUQ), 4, 256, u - 736, smem);
    else if (u < 776) wconv_tile(p.in[I_WUKV] + (size_t)l * 128 * 512, p.in[I_MKVN] + l * 128, 128, 512, (bf16_t*)(ws + O_WUKV), 2, 128, u - 760, smem);
    else if (u < 792) {
        const int v = u - 776, j = v >> 2, d = j & 1;
        const float* src = (j < 2 ? p.in[I_W2] : p.in[I_A2]) + (size_t)(l * 2 + d) * 64 * 256;
        wconv_tile(src, nullptr, 64, 256, (bf16_t*)(ws + O_WAUX) + (size_t)j * 256 * 64, 1, 64, v & 3, smem);
    } else wconv_tile(p.in[I_G2] + (size_t)l * 160 * 256, nullptr, 160, 256, (bf16_t*)(ws + O_WG2), 3, 192, u - 792, smem);
}

DI void phase_wconv(const Params& p, int l, char* smem) {
    char* ws = p.ws;
    wconv(p.in[I_WIN] + (size_t)l * 1024 * INC, nullptr, 1024, INC, (bf16_t*)(ws + O_WIN), 1024, INP, LDW1, 0, smem);
    wconv(p.in[I_WUQ] + (size_t)l * 256 * 384, p.in[I_MQN] + l * 256, 256, 384, (bf16_t*)(ws + O_WUQ), 256, 384, 256, 3040, smem);
    wconv(p.in[I_WUKV] + (size_t)l * 128 * 512, p.in[I_MKVN] + l * 128, 128, 512, (bf16_t*)(ws + O_WUKV), 128, 512, 128, 3064, smem);
    for (int d = 0; d < 2; ++d) {
        wconv(p.in[I_W2] + (size_t)(l * 2 + d) * 64 * 256, nullptr, 64, 256, (bf16_t*)(ws + O_WAUX) + d * 256 * 64, 64, 256, 64, 3080 + d * 4, smem);
        wconv(p.in[I_A2] + (size_t)(l * 2 + d) * 64 * 256, nullptr, 64, 256, (bf16_t*)(ws + O_WAUX) + (2 + d) * 256 * 64, 64, 256, 64, 3088 + d * 4, smem);
    }
    wconv(p.in[I_G2] + (size_t)l * 160 * 256, nullptr, 160, 256, (bf16_t*)(ws + O_WG2), 192, 256, 192, 3096, smem);
}

DI void phase_norm(const float* xl, const float* xc, const float* g, const float* modl, int shi, int sci, bf16_t* dst) {
    const int tid = gtid(), lane = tid & 63, wave = tid >> 6;
    for (int tok = blockIdx.x * 4 + wave; tok < NT; tok += gridDim.x * 4) {
        const int b = tok / TPB, tib = tok - b * TPB;
        const float* row; int mr;
        if (tib < 256) { row = xc + ((size_t)b * 256 + tib) * 1024; mr = 8; } else { row = xl + ((size_t)b * 4096 + tib - 256) * 1024; mr = b; }
        const float* sh = modl + mr * 6144 + shi * 1024;
        const float* sc = modl + mr * 6144 + sci * 1024;
        f32x4 v[4]; float ss = 0.f;
#pragma unroll
        for (int i = 0; i < 4; ++i) { v[i] = ((const f32x4*)row)[lane + 64 * i]; ss += v[i].x * v[i].x + v[i].y * v[i].y + v[i].z * v[i].z + v[i].w * v[i].w; }
        ss = wsum64(ss);
        const float rs = rsqrtf(ss * (1.f / 1024.f) + 1e-6f);
#pragma unroll
        for (int i = 0; i < 4; ++i) {
            const int c = (lane + 64 * i) * 4;
            const float4 g4 = *(const float4*)(g + c), s4 = *(const float4*)(sc + c), h4 = *(const float4*)(sh + c);
            st4(dst + (size_t)tok * LDH + c, v[i].x * rs * g4.x * (1.f + s4.x) + h4.x, v[i].y * rs * g4.y * (1.f + s4.y) + h4.y,
                v[i].z * rs * g4.z * (1.f + s4.z) + h4.z, v[i].w * rs * g4.w * (1.f + s4.w) + h4.w);
        }
    }
}

DI void phase_post(const Params& p, int l) {
    const int tid = gtid(), lane = tid & 63, wave = tid >> 6;
    char* ws = p.ws;
    bf16_t* gq = (bf16_t*)(ws + O_GQ);
    const bf16_t* mlar = (const bf16_t*)(ws + O_MLAR);
    bf16_t* kc = (bf16_t*)(ws + O_KC);
    float* rsm = (float*)(ws + O_RSM);
    const bf16_t* rwr = (const bf16_t*)(ws + O_RWR);
    bf16_t* rkv = (bf16_t*)(ws + O_RKV);
    bf16_t* acat = (bf16_t*)(ws + O_HBUF);
    float* invn = (float*)(ws + O_INVN);
    const float* gqn = p.in[I_GQN] + l * 64;
    const float* gkn = p.in[I_GKN] + l * 64;
    const float* taps = p.in[I_SHIFT] + (size_t)l * 3 * 1184;
    const float* kkw = p.in[I_KK] + (size_t)l * 512;
    const f32x2 KF20 = *(const f32x2*)(kkw + (lane + 128) * 2 - 256), KF21 = *(const f32x2*)(kkw + 256 + (lane + 128) * 2 - 256);
    const f32x2 KF30 = *(const f32x2*)(kkw + (lane + 192) * 2 - 256), KF31 = *(const f32x2*)(kkw + 256 + (lane + 192) * 2 - 256);
    for (int tok = blockIdx.x * 4 + wave; tok < NT; tok += gridDim.x * 4) {
        const int b = tok / TPB, tib = tok - b * TPB;
        const bool lat = tib >= 256;
        const int t = tib - 256, prow = t >> 6, pcol = t & 63;
        unsigned gqu[3];
#pragma unroll
        for (int it = 0; it < 3; ++it) gqu[it] = *(const unsigned*)(gq + (size_t)tok * 384 + (it * 2 + (lane >> 5)) * 64 + (lane & 31) * 2);
        const bf16_t* mr = mlar + (size_t)tok * 416;
        const uint2 uq = *(const uint2*)(mr + lane * 4);
        const unsigned ukv = *(const unsigned*)(mr + 256 + lane * 2);
        const unsigned ukr = *(const unsigned*)(mr + 384 + (lane & 15) * 2);
        {
            const int pair = lane & 31;
#pragma unroll
            for (int it = 0; it < 3; ++it) {
                const int head = it * 2 + (lane >> 5);
                unsigned* ptr = (unsigned*)(gq + (size_t)tok * 384 + head * 64 + pair * 2);
                const unsigned u = gqu[it];
                float x1 = lo2f(u), x2 = hi2f(u);
                float ss = x1 * x1 + x2 * x2;
                ss += __shfl_xor(ss, 1); ss += __shfl_xor(ss, 2); ss += __shfl_xor(ss, 4); ss += __shfl_xor(ss, 8); ss += __shfl_xor(ss, 16);
                const float rs = rsqrtf(ss * (1.f / 64.f) + 1e-6f);
                const float* gg = head < 4 ? gqn : gkn;
                x1 *= rs * gg[pair * 2]; x2 *= rs * gg[pair * 2 + 1];
                if (lat) rope_rot(x1, x2, pair < 16 ? prow : pcol, (float)(pair & 15), ROPE_L2T / 16.f);
                if (head < 4) { x1 *= QS64; x2 *= QS64; }
                *ptr = pk2(x1, x2);
            }
        }
        {
            float a0 = lo2f(uq.x), a1 = hi2f(uq.x), a2 = lo2f(uq.y), a3 = hi2f(uq.y);
            float sq = wsum64(a0 * a0 + a1 * a1 + a2 * a2 + a3 * a3);
            float c0 = lo2f(ukv), c1 = hi2f(ukv);
            float sk = wsum64(c0 * c0 + c1 * c1);
            if (lane == 0) { rsm[tok * 2] = rsqrtf(sq * (1.f / 256.f) + 1e-6f); rsm[tok * 2 + 1] = rsqrtf(sk * (1.f / 128.f) + 1e-6f); }
            if (lane < 16) {
                const unsigned u = ukr;
                float x1 = lo2f(u), x2 = hi2f(u);
                if (lat) rope_rot(x1, x2, lane < 8 ? prow : pcol, (float)(lane & 7), ROPE_L2T / 8.f);
                const unsigned o = pk2(x1, x2);
#pragma unroll
                for (int h = 0; h < 4; ++h) *(unsigned*)(kc + (size_t)tok * 384 + h * 96 + 64 + lane * 2) = o;
            }
        }
        {
            const bool hasp = (tib != 0) && (tib != 256);
            const bool hasn = (tib != 255) && (tib != TPB - 1);
            const bf16_t* r0 = rwr + (size_t)tok * 1184;
#pragma unroll
            for (int hb = 0; hb < 5; ++hb) {
            unsigned X0[2], X1[2], X2[2]; f32x2 T0[2], T1[2], T2[2];
#pragma unroll
            for (int ii = 0; ii < 2; ++ii) {
                const int c = (lane + 64 * (hb * 2 + ii)) * 2;
                X0[ii] = 0u; X1[ii] = 0u; X2[ii] = 0u; T0[ii] = (f32x2){0.f, 0.f}; T1[ii] = T0[ii]; T2[ii] = T0[ii];
                if (c < 1184) {
                    X1[ii] = *(const unsigned*)(r0 + c); T1[ii] = *(const f32x2*)(taps + 1184 + c);
                    if (hasp) { X0[ii] = *(const unsigned*)(r0 + c - 1184); T0[ii] = *(const f32x2*)(taps + c); }
                    if (hasn) { X2[ii] = *(const unsigned*)(r0 + c + 1184); T2[ii] = *(const f32x2*)(taps + 2 * 1184 + c); }
                }
            }
#pragma unroll
            for (int ii = 0; ii < 2; ++ii) {
                const int i = hb * 2 + ii;
                const int c = (lane + 64 * i) * 2;
                float u0 = 0.f, u1 = 0.f;
                if (c < 1184) {
                    u0 = lo2f(X1[ii]) * T1[ii][0]; u1 = hi2f(X1[ii]) * T1[ii][1];
                    u0 += lo2f(X0[ii]) * T0[ii][0]; u1 += hi2f(X0[ii]) * T0[ii][1];
                    u0 += lo2f(X2[ii]) * T2[ii][0]; u1 += hi2f(X2[ii]) * T2[ii][1];
                }
                if (i < 6) {
                    const unsigned pk = pk2(u0, u1);
                    *(unsigned*)(rkv + (size_t)tok * 768 + c) = pk;
                    if (i == 2 || i == 3) {
                        const float k0 = lo2f(pk), k1 = hi2f(pk);
                        const f32x2 f0 = (i == 2) ? KF20 : KF30, f1 = (i == 2) ? KF21 : KF31;
                        float s0 = (k0 * f0[0]) * (k0 * f0[0]) + (k1 * f0[1]) * (k1 * f0[1]);
                        float s1 = (k0 * f1[0]) * (k0 * f1[0]) + (k1 * f1[1]) * (k1 * f1[1]);
                        s0 = sum16(s0); s1 = sum16(s1);
                        s0 += __shfl_xor(s0, 16); s1 += __shfl_xor(s1, 16);
                        if ((lane & 31) == 0) {
                            const int hd = (i - 2) * 2 + (lane >> 5);
                            invn[tok * 8 + hd] = 1.f / fmaxf(sqrtf(s0), 1e-12f);
                            invn[tok * 8 + 4 + hd] = 1.f / fmaxf(sqrtf(s1), 1e-12f);
                        }
                    }
                } else if (i == 6) {
                    *(unsigned*)(acat + (size_t)tok * 448 + (c - 768)) = pk2(tanhf(u0), tanhf(u1));
                } else if (i == 7) {
                    *(unsigned*)(acat + (size_t)tok * 448 + 128 + (c - 896)) = pk2(u0, u1);
                } else {
                    const int cc = c - 1024;
                    if (cc < 192) *(unsigned*)(acat + (size_t)tok * 448 + 256 + cc) = (cc < 160) ? pk2(sigm(u0), sigm(u1)) : 0u;
                }
            }
            }
        }
    }
}

template <int DK, bool NAM>
DI void attn_item(const bf16_t* __restrict__ Q, int ldq, const bf16_t* __restrict__ Kb, int ldk, const bf16_t* __restrict__ Vt,
                          int s0, int nt0, int s1, int nt1, bf16_t* __restrict__ O, int qr0, const float* rpb_g, char* smem) {
    constexpr int KS = DK + 16, KCH = DK / 8, NKC = 64 * KCH / 256;
    bf16_t* sK = (bf16_t*)smem;
    bf16_t* sV = sK + 64 * 112;
    float* sR = (float*)(sV + 64 * 72);
    const int tid = gtid(), lane = tid & 63, wave = tid >> 6, l15 = lane & 15, quad = lane >> 4;
    const int ntot = nt0 + nt1;
    if (NAM) {
        __syncthreads();
        for (int i = tid; i < 465; i += 256) sR[i] = rpb_g[i] * LOG2E;
    }
    bf16x8 qf[2][DK / 32];
#pragma unroll
    for (int qt = 0; qt < 2; ++qt)
#pragma unroll
        for (int ks = 0; ks < DK / 32; ++ks) qf[qt][ks] = *(const bf16x8*)(Q + (size_t)(wave * 32 + qt * 16 + l15) * ldq + ks * 32 + quad * 8);
    f32x4 Oa[4][2];
#pragma unroll
    for (int i = 0; i < 4; ++i) { Oa[i][0] = (f32x4){0.f, 0.f, 0.f, 0.f}; Oa[i][1] = (f32x4){0.f, 0.f, 0.f, 0.f}; }
    float mrun[2] = {-1e30f, -1e30f}, lrun[2] = {0.f, 0.f};
    u32x4 rk[NKC], rv[2];
    {
        const int key0 = (0 < nt0) ? s0 : s1;
#pragma unroll
        for (int i = 0; i < NKC; ++i) { const int c = tid + 256 * i, row = c / KCH, kc = c % KCH; rk[i] = *(const u32x4*)(Kb + (size_t)(key0 + row) * ldk + kc * 8); }
#pragma unroll
        for (int i = 0; i < 2; ++i) { const int c = tid + 256 * i, row = c >> 3, kc = c & 7; rv[i] = *(const u32x4*)(Vt + (size_t)row * TPB + key0 + kc * 8); }
    }
    for (int j = 0; j < ntot; ++j) {
        __syncthreads();
#pragma unroll
        for (int i = 0; i < NKC; ++i) { const int c = tid + 256 * i, row = c / KCH, kc = c % KCH; *(u32x4*)(sK + row * KS + kc * 8) = rk[i]; }
#pragma unroll
        for (int i = 0; i < 2; ++i) { const int c = tid + 256 * i, row = c >> 3, kc = c & 7; *(u32x4*)(sV + row * 72 + kc * 8) = rv[i]; }
        __syncthreads();
        if (j + 1 < ntot) {
            const int jn = j + 1;
            const int key0 = (jn < nt0) ? (s0 + 64 * jn) : (s1 + 64 * (jn - nt0));
#pragma unroll
            for (int i = 0; i < NKC; ++i) { const int c = tid + 256 * i, row = c / KCH, kc = c % KCH; rk[i] = *(const u32x4*)(Kb + (size_t)(key0 + row) * ldk + kc * 8); }
#pragma unroll
            for (int i = 0; i < 2; ++i) { const int c = tid + 256 * i, row = c >> 3, kc = c & 7; rv[i] = *(const u32x4*)(Vt + (size_t)row * TPB + key0 + kc * 8); }
        }
        f32x4 S[4][2];
#pragma unroll
        for (int kt = 0; kt < 4; ++kt) { S[kt][0] = (f32x4){0.f, 0.f, 0.f, 0.f}; S[kt][1] = (f32x4){0.f, 0.f, 0.f, 0.f}; }
#pragma unroll
        for (int ks = 0; ks < DK / 32; ++ks)
#pragma unroll
            for (int kt = 0; kt < 4; ++kt) {
                const bf16x8 kf = *(const bf16x8*)(sK + (kt * 16 + l15) * KS + ks * 32 + quad * 8);
                S[kt][0] = __builtin_amdgcn_mfma_f32_16x16x32_bf16(kf, qf[0][ks], S[kt][0], 0, 0, 0);
                S[kt][1] = __builtin_amdgcn_mfma_f32_16x16x32_bf16(kf, qf[1][ks], S[kt][1], 0, 0, 0);
            }
        if (NAM) {
            if (j >= nt0) {
                const int kr = (s1 - 256) / 64 + (j - nt0);
#pragma unroll
                for (int qt = 0; qt < 2; ++qt) {
                    const int qi = wave * 32 + qt * 16 + l15, qrow = qr0 + (qi >> 6), qc = qi & 63;
                    const int st = clampi(qrow - 4, 0, 56), cs = clampi(qc - 8, 0, 48);
                    const bool rowok = (kr >= st) && (kr < st + 8);
                    const int rbase = (kr - qrow + 7) * 31 - qc + 15;
#pragma unroll
                    for (int kt = 0; kt < 4; ++kt)
#pragma unroll
                        for (int r = 0; r < 4; ++r) {
                            const int kcx = kt * 16 + quad * 4 + r;
                            const bool ok = rowok && (kcx >= cs) && (kcx < cs + 16);
                            const float bias = sR[ok ? (rbase + kcx) : 0];
                            S[kt][qt][r] = ok ? (S[kt][qt][r] + bias) : -1e30f;
                        }
                }
            }
        }
        bf16x8 pf[2][2];
#pragma unroll
        for (int qt = 0; qt < 2; ++qt) {
            float mx = -1e30f;
#pragma unroll
            for (int kt = 0; kt < 4; ++kt)
#pragma unroll
                for (int r = 0; r < 4; ++r) mx = fmaxf(mx, S[kt][qt][r]);
            mx = fmaxf(mx, __shfl_xor(mx, 16));
            mx = fmaxf(mx, __shfl_xor(mx, 32));
            const float mnew = fmaxf(mrun[qt], mx);
            const float alpha = __builtin_amdgcn_exp2f(mrun[qt] - mnew);
            mrun[qt] = mnew;
            float ps = 0.f;
#pragma unroll
            for (int kt = 0; kt < 4; ++kt)
#pragma unroll
                for (int r = 0; r < 4; ++r) { const float pv = __builtin_amdgcn_exp2f(S[kt][qt][r] - mnew); S[kt][qt][r] = pv; ps += pv; }
            lrun[qt] = lrun[qt] * alpha + ps;
            if (__any(alpha != 1.f)) {
#pragma unroll
                for (int dt = 0; dt < 4; ++dt) { Oa[dt][qt][0] *= alpha; Oa[dt][qt][1] *= alpha; Oa[dt][qt][2] *= alpha; Oa[dt][qt][3] *= alpha; }
            }
#pragma unroll
            for (int s = 0; s < 2; ++s) {
                u32x4 f;
                f[0] = pk2(S[2 * s][qt][0], S[2 * s][qt][1]); f[1] = pk2(S[2 * s][qt][2], S[2 * s][qt][3]);
                f[2] = pk2(S[2 * s + 1][qt][0], S[2 * s + 1][qt][1]); f[3] = pk2(S[2 * s + 1][qt][2], S[2 * s + 1][qt][3]);
                pf[qt][s] = __builtin_bit_cast(bf16x8, f);
            }
        }
#pragma unroll
        for (int s = 0; s < 2; ++s)
#pragma unroll
            for (int dt = 0; dt < 4; ++dt) {
                const bf16x4 v0 = *(const bf16x4*)(sV + (dt * 16 + l15) * 72 + (2 * s) * 16 + quad * 4);
                const bf16x4 v1 = *(const bf16x4*)(sV + (dt * 16 + l15) * 72 + (2 * s + 1) * 16 + quad * 4);
                const bf16x8 vf = __builtin_shufflevector(v0, v1, 0, 1, 2, 3, 4, 5, 6, 7);
                Oa[dt][0] = __builtin_amdgcn_mfma_f32_16x16x32_bf16(vf, pf[0][s], Oa[dt][0], 0, 0, 0);
                Oa[dt][1] = __builtin_amdgcn_mfma_f32_16x16x32_bf16(vf, pf[1][s], Oa[dt][1], 0, 0, 0);
            }
    }
#pragma unroll
    for (int qt = 0; qt < 2; ++qt) {
        float lt = lrun[qt];
        lt += __shfl_xor(lt, 16); lt += __shfl_xor(lt, 32);
        const float inv = 1.f / lt;
#pragma unroll
        for (int dt = 0; dt < 4; ++dt)
            st4(O + (size_t)(wave * 32 + qt * 16 + l15) * LDH + dt * 16 + quad * 4, Oa[dt][qt][0] * inv, Oa[dt][qt][1] * inv, Oa[dt][qt][2] * inv, Oa[dt][qt][3] * inv);
    }
}

DI void scan_item(const Params& p, int l, int item, char* smem) {
    float* sT = (float*)smem;
    float* sVv = sT + 16 * 320;
    float* sY = sVv + 256;
    const int tid = gtid(), lane = tid & 63, wave = tid >> 6;
    const int scan = item >> 2, rg = item & 3;
    const int b = scan >> 3, head = (scan >> 1) & 3, dir = scan & 1;
    const bf16_t* rkv = (const bf16_t*)(p.ws + O_RKV);
    const bf16_t* dec = (const bf16_t*)(p.ws + O_DEC);
    const float* invn = (const float*)(p.ws + O_INVN);
    float* yout = (float*)(p.ws + O_Y) + (size_t)dir * NT * 256;
    const int k2 = (tid & 31) * 2, tq = tid >> 5;
    const float* kkw = p.in[I_KK] + (size_t)(l * 2 + dir) * 256 + head * 64;
    const float* kaw = p.in[I_KA] + (size_t)(l * 2 + dir) * 256 + head * 64;
    const float kkc0 = kkw[k2], kkc1 = kkw[k2 + 1], kac0 = kaw[k2], kac1 = kaw[k2 + 1];
    unsigned rr[2], kr[2], ow[2], as[2]; float inn[2]; bf16_t vv;
    const int tbase = b * TPB;
#define SCAN_TOK(s) (tbase + (dir ? ((s) < 256 ? 255 - (s) : 4607 - (s)) : (s)))
#define SCAN_LOAD(ch)                                                                                          \
    {                                                                                                          \
        _Pragma("unroll") for (int i = 0; i < 2; ++i) {                                                        \
            const int tok = SCAN_TOK((ch) * 16 + tq + 8 * i);                                                  \
            rr[i] = *(const unsigned*)(rkv + (size_t)tok * 768 + head * 64 + k2);                              \
            kr[i] = *(const unsigned*)(rkv + (size_t)tok * 768 + 256 + head * 64 + k2);                        \
            ow[i] = *(const unsigned*)(dec + (size_t)tok * 1024 + dir * 256 + head * 64 + k2);                 \
            as[i] = *(const unsigned*)(dec + (size_t)tok * 1024 + 512 + dir * 256 + head * 64 + k2);           \
            inn[i] = invn[tok * 8 + dir * 4 + head];                                                           \
        }                                                                                                      \
        {                                                                                                      \
            const int tok = SCAN_TOK((ch) * 16 + (tid >> 4));                                                  \
            vv = rkv[(size_t)tok * 768 + 512 + head * 64 + rg * 16 + (tid & 15)];                              \
        }                                                                                                      \
    }
#define SCAN_YRED(ch)                                                                                          \
    {                                                                                                          \
        const int tl = tid >> 4, row = tid & 15;                                                               \
        const float* yp = sY + tl * 256 + (row >> 2) * 64 + (row & 3) * 16;                                    \
        const f32x4 q0 = *(const f32x4*)yp, q1 = *(const f32x4*)(yp + 4), q2 = *(const f32x4*)(yp + 8), q3 = *(const f32x4*)(yp + 12);   \
        const f32x4 qs = (q0 + q1) + (q2 + q3);                                                                \
        yout[(size_t)SCAN_TOK((ch) * 16 + tl) * 256 + head * 64 + rg * 16 + row] = (qs[0] + qs[1]) + (qs[2] + qs[3]);   \
    }
    float S0 = 0.f, S1 = 0.f, S2 = 0.f, S3 = 0.f;
    const int c = lane & 15, rloc = wave * 4 + (lane >> 4);
    __builtin_amdgcn_s_setprio(3);
    SCAN_LOAD(0);
    for (int ch = 0; ch < 272; ++ch) {
        __syncthreads();
        if (ch > 0) SCAN_YRED(ch - 1)
#pragma unroll
        for (int i = 0; i < 2; ++i) {
            float* base = sT + (tq + 8 * i) * 320 + k2;
            const float r0 = lo2f(rr[i]), r1 = hi2f(rr[i]), k0 = lo2f(kr[i]), k1 = hi2f(kr[i]);
            const float o0 = lo2f(ow[i]), o1 = hi2f(ow[i]), a0 = lo2f(as[i]), a1 = hi2f(as[i]);
            const float kk0 = k0 * kkc0 * inn[i], kk1 = k1 * kkc1 * inn[i];
            *(float2*)(base) = make_float2(1.f - o0, 1.f - o1);
            *(float2*)(base + 64) = make_float2(kk0, kk1);
            *(float2*)(base + 128) = make_float2(kk0 * a0, kk1 * a1);
            *(float2*)(base + 192) = make_float2(k0 * (1.f + (a0 - 1.f) * kac0), k1 * (1.f + (a1 - 1.f) * kac1));
            *(float2*)(base + 256) = make_float2(r0, r1);
        }
        sVv[tid] = bf2f(vv);
        __syncthreads();
        if (ch + 1 < 272) SCAN_LOAD(ch + 1);
#define SC_LD(bi, t0)                                                                                   \
    _Pragma("unroll") for (int q = 0; q < 2; ++q) {                                                     \
        const float* bp = sT + ((t0) + q) * 320 + c * 4;                                                \
        W4[bi][q] = *(const f32x4*)bp; K4[bi][q] = *(const f32x4*)(bp + 64); B4[bi][q] = *(const f32x4*)(bp + 128);   \
        D4[bi][q] = *(const f32x4*)(bp + 192); R4[bi][q] = *(const f32x4*)(bp + 256); VX[bi][q] = sVv[((t0) + q) * 16 + rloc];  \
    }
#define SC_CP(bi, t0)                                                                                   \
    _Pragma("unroll") for (int q = 0; q < 2; ++q) {                                                     \
        float sa = (S0 * K4[bi][q][0] + S1 * K4[bi][q][1]) + (S2 * K4[bi][q][2] + S3 * K4[bi][q][3]);   \
        sa = sum16(sa);                                                                                 \
        S0 = S0 * W4[bi][q][0] - sa * B4[bi][q][0] + VX[bi][q] * D4[bi][q][0];                          \
        S1 = S1 * W4[bi][q][1] - sa * B4[bi][q][1] + VX[bi][q] * D4[bi][q][1];                          \
        S2 = S2 * W4[bi][q][2] - sa * B4[bi][q][2] + VX[bi][q] * D4[bi][q][2];                          \
        S3 = S3 * W4[bi][q][3] - sa * B4[bi][q][3] + VX[bi][q] * D4[bi][q][3];                          \
        sY[((t0) + q) * 256 + tid] = (S0 * R4[bi][q][0] + S1 * R4[bi][q][1]) + (S2 * R4[bi][q][2] + S3 * R4[bi][q][3]);  \
    }
        {
            f32x4 W4[2][2], K4[2][2], B4[2][2], D4[2][2], R4[2][2]; float VX[2][2];
            SC_LD(0, 0);
#pragma unroll 1
            for (int it = 0; it < 4; ++it) {
                SC_LD(1, it * 4 + 2);
                SC_CP(0, it * 4);
                if (it < 3) SC_LD(0, it * 4 + 4);
                SC_CP(1, it * 4 + 2);
            }
        }
    }
    __syncthreads();
    SCAN_YRED(271)
#undef SC_LD
#undef SC_CP
#undef SCAN_YRED
#undef SCAN_LOAD
#undef SCAN_TOK
    __builtin_amdgcn_s_setprio(0);
}

DI void phase_mix(const Params& p, int l, char* smem, int* s_item) {
    char* ws = p.ws;
    int* ctr = (int*)(ws + O_CTL) + l;
    const bool want_ctx = l < 3;
    const int nattn = 3072 + (want_ctx ? 192 : 0);
    const int total = nattn + 2304 + (l < 3 ? 804 : 0);
    const bf16_t* naqk = (const bf16_t*)(ws + O_NAQK);
    const bf16_t* vta = (const bf16_t*)(ws + O_VTA);
    const bf16_t* gq = (const bf16_t*)(ws + O_GQ);
    const bf16_t* vtb = (const bf16_t*)(ws + O_VTB);
    const bf16_t* qc = (const bf16_t*)(ws + O_QC);
    const bf16_t* kc = (const bf16_t*)(ws + O_KC);
    const bf16_t* vtc = (const bf16_t*)(ws + O_VTC);
    bf16_t* mix = (bf16_t*)(ws + O_HBUF);
    const float* rpb = p.in[I_RPB] + (size_t)l * 4 * 465;
    {
        const int G = gridDim.x, bb = blockIdx.x;
        for (int sidx = 0; sidx < 256; ++sidx) {
            const int owner = (G == 512) ? ((sidx & 127) + (sidx >> 7) * 256) : (sidx % G);
            if (owner == bb) { for (int rep = 0; rep < REP_SCAN; ++rep) scan_item(p, l, sidx, smem); }
        }
    }
    while (true) {
        if (threadIdx.x == 0) *s_item = atomicAdd(ctr, 1);
        __syncthreads();
        const int item = *s_item;
        __syncthreads();
        if (item >= total) break;
        if (item >= nattn) { const int j = item - nattn; if (j < 2304) wconv_late(p, l, j, smem); else wconv_early(p, l + 1, j - 2304, smem); continue; }
        int type, b, h, qtok0, nkt0, qr0 = 0; bool isctx = false;
        if (item < 3072) {
            const int i1 = item;
            type = i1 >> 10;
            const int r = i1 & 1023;
            b = r >> 7; h = (r >> 5) & 3;
            const int qb = r & 31;
            qtok0 = b * TPB + 256 + qb * 128; nkt0 = 68; qr0 = qb * 2;
        } else {
            const int i2 = item - 3072;
            type = i2 >> 6;
            const int r = i2 & 63;
            b = r >> 3; h = (r >> 1) & 3;
            qtok0 = b * TPB + (r & 1) * 128; nkt0 = 4; isctx = true;
        }
        const size_t kb = (size_t)b * TPB;
        for (int rep = 0; rep < REP_ATTN; ++rep) {
            if (type == 0) {
                attn_item<96, false>(qc + (size_t)qtok0 * 384 + h * 96, 384, kc + kb * 384 + h * 96, 384, vtc + ((size_t)b * 256 + h * 64) * TPB,
                                     0, nkt0, 0, 0, mix + (size_t)qtok0 * LDH + 512 + h * 64, 0, nullptr, smem);
            } else if (type == 2 && !isctx) {
                const int st0 = clampi(qr0 - 4, 0, 56), st1 = clampi(qr0 + 1 - 4, 0, 56);
                attn_item<64, true>(naqk + (size_t)qtok0 * LDNA + h * 64, LDNA, naqk + kb * LDNA + 256 + h * 64, LDNA, vta + ((size_t)b * 256 + h * 64) * TPB,
                                    0, 4, 256 + st0 * 64, st1 + 8 - st0, mix + (size_t)qtok0 * LDH + h * 64, qr0, rpb + h * 465, smem);
            } else {
                const bf16_t *Qp, *Kp, *Vp; bf16_t* Op; int ld;
                if (type == 1) {
                    const int kvh = h >> 1;
                    Qp = gq + (size_t)qtok0 * 384 + h * 64; Kp = gq + kb * 384 + 256 + kvh * 64; Vp = vtb + ((size_t)b * 128 + kvh * 64) * TPB;
                    Op = mix + (size_t)qtok0 * LDH + 256 + h * 64; ld = 384;
                } else {
                    Qp = naqk + (size_t)qtok0 * LDNA + h * 64; Kp = naqk + kb * LDNA + 256 + h * 64; Vp = vta + ((size_t)b * 256 + h * 64) * TPB;
                    Op = mix + (size_t)qtok0 * LDH + h * 64; ld = LDNA;
                }
                attn_item<64, false>(Qp, ld, Kp, ld, Vp, 0, nkt0, 0, 0, Op, 0, nullptr, smem);
            }
        }
    }
}

DI void phase_rwkv_fin(const Params& p, int l) {
    const int tid = gtid(), lane = tid & 63, wave = tid >> 6;
    char* ws = p.ws;
    const float* yf = (const float*)(ws + O_Y);
    const float* yb = yf + (size_t)NT * 256;
    const bf16_t* rkv = (const bf16_t*)(ws + O_RKV);
    const bf16_t* dec = (const bf16_t*)(ws + O_DEC);
    const bf16_t* gate = (const bf16_t*)(ws + O_GATE);
    bf16_t* mix = (bf16_t*)(ws + O_HBUF);
    const int c = lane * 4;
    const float4 ka0 = *(const float4*)(p.in[I_KA] + (size_t)(l * 2) * 256 + c), ka1 = *(const float4*)(p.in[I_KA] + (size_t)(l * 2 + 1) * 256 + c);
    const float4 rk0 = *(const float4*)(p.in[I_RK] + (size_t)(l * 2) * 256 + c), rk1 = *(const float4*)(p.in[I_RK] + (size_t)(l * 2 + 1) * 256 + c);
    const float4 lw = *(const float4*)(p.in[I_LNW] + l * 256 + c), lb = *(const float4*)(p.in[I_LNB] + l * 256 + c);
    for (int tok = blockIdx.x * 4 + wave; tok < NT; tok += gridDim.x * 4) {
        const float4 a = *(const float4*)(yf + (size_t)tok * 256 + c), bb = *(const float4*)(yb + (size_t)tok * 256 + c);
        const float y0 = a.x + bb.x, y1 = a.y + bb.y, y2 = a.z + bb.z, y3 = a.w + bb.w;
        const float mu = sum16(y0 + y1 + y2 + y3) * (1.f / 64.f);
        const float d0 = y0 - mu, d1 = y1 - mu, d2 = y2 - mu, d3 = y3 - mu;
        const float var = sum16(d0 * d0 + d1 * d1 + d2 * d2 + d3 * d3) * (1.f / 64.f);
        const float rstd = rsqrtf(var + 64e-5f);
        const uint2 ur = *(const uint2*)(rkv + (size_t)tok * 768 + c), uk = *(const uint2*)(rkv + (size_t)tok * 768 + 256 + c), uv = *(const uint2*)(rkv + (size_t)tok * 768 + 512 + c);
        const uint2 uaf = *(const uint2*)(dec + (size_t)tok * 1024 + 512 + c), uab = *(const uint2*)(dec + (size_t)tok * 1024 + 768 + c);
        const uint2 ug = *(const uint2*)(gate + (size_t)tok * 256 + c);
        const float r0 = lo2f(ur.x), r1 = hi2f(ur.x), r2 = lo2f(ur.y), r3 = hi2f(ur.y);
        const float k0 = lo2f(uk.x), k1 = hi2f(uk.x), k2 = lo2f(uk.y), k3 = hi2f(uk.y);
        const float v0 = lo2f(uv.x), v1 = hi2f(uv.x), v2 = lo2f(uv.y), v3 = hi2f(uv.y);
        const float f0 = lo2f(uaf.x), f1 = hi2f(uaf.x), f2 = lo2f(uaf.y), f3 = hi2f(uaf.y);
        const float b0 = lo2f(uab.x), b1 = hi2f(uab.x), b2 = lo2f(uab.y), b3 = hi2f(uab.y);
        float bs = r0 * k0 * ((1.f + (f0 - 1.f) * ka0.x) * rk0.x + (1.f + (b0 - 1.f) * ka1.x) * rk1.x)
                 + r1 * k1 * ((1.f + (f1 - 1.f) * ka0.y) * rk0.y + (1.f + (b1 - 1.f) * ka1.y) * rk1.y)
                 + r2 * k2 * ((1.f + (f2 - 1.f) * ka0.z) * rk0.z + (1.f + (b2 - 1.f) * ka1.z) * rk1.z)
                 + r3 * k3 * ((1.f + (f3 - 1.f) * ka0.w) * rk0.w + (1.f + (b3 - 1.f) * ka1.w) * rk1.w);
        bs = sum16(bs);
        const float o0 = (d0 * rstd * lw.x + lb.x + bs * v0) * lo2f(ug.x);
        const float o1 = (d1 * rstd * lw.y + lb.y + bs * v1) * hi2f(ug.x);
        const float o2 = (d2 * rstd * lw.z + lb.z + bs * v2) * lo2f(ug.y);
        const float o3 = (d3 * rstd * lw.w + lb.w + bs * v3) * hi2f(ug.y);
        st4(mix + (size_t)tok * LDH + 768 + c, o0, o1, o2, o3);
    }
}

DI void phase_final(const Params& p) {
    const int tid = gtid(), lane = tid & 63, wave = tid >> 6;
    const float* g = p.in[I_FNG];
    for (int row = blockIdx.x * 4 + wave; row < NB * 4096; row += gridDim.x * 4) {
        float* x = p.out + (size_t)row * 1024;
        f32x4 v[4]; float ss = 0.f;
#pragma unroll
        for (int i = 0; i < 4; ++i) { v[i] = ((const f32x4*)x)[lane + 64 * i]; ss += v[i].x * v[i].x + v[i].y * v[i].y + v[i].z * v[i].z + v[i].w * v[i].w; }
        ss = wsum64(ss);
        const float rs = rsqrtf(ss * (1.f / 1024.f) + 1e-6f);
#pragma unroll
        for (int i = 0; i < 4; ++i) {
            const float4 g4 = ((const float4*)g)[lane + 64 * i];
            float4 o; o.x = v[i].x * rs * g4.x; o.y = v[i].y * rs * g4.y; o.z = v[i].z * rs * g4.z; o.w = v[i].w * rs * g4.w;
            ((float4*)x)[lane + 64 * i] = o;
        }
    }
}

#define XB_TMO      128
#define XB_XCNT(j)  (256  + 64 * (j))
#define XB_XSUB(j)  (1280 + 64 * (j))
#define XB_XGEN(j)  (2304 + 64 * (j))
#define XB_TOP      3328
#define XB_TOPGEN   3392
#define XCD_BAR_WORDS 3456
#define XB_SPIN_CAP (1u << 18)
#define LAS __attribute__((address_space(3)))

__device__ __forceinline__ unsigned xb_ld(unsigned* p)              { return __hip_atomic_load(p, __ATOMIC_RELAXED, __HIP_MEMORY_SCOPE_AGENT); }
__device__ __forceinline__ unsigned xb_add(unsigned* p, unsigned v) { return __hip_atomic_fetch_add(p, v, __ATOMIC_RELAXED, __HIP_MEMORY_SCOPE_AGENT); }
__device__ __forceinline__ unsigned xb_xcc_id() { return (unsigned)__builtin_amdgcn_s_getreg((3 << 11) | 20) & 0xFu; }
#define XB_SPIN(cond, bar) do { unsigned _sp = 0; while (cond) { __builtin_amdgcn_s_sleep(1); \
    if ((++_sp & 255u) == 0u) { if (xb_ld(&(bar)[XB_TMO])) break; if (_sp > XB_SPIN_CAP) { atomicAdd(&(bar)[XB_TMO], 1u); break; } } } } while (0)

struct XcdBarrier {
    unsigned* bar; unsigned x;
    volatile LAS unsigned* st;
};

__device__ __forceinline__ XcdBarrier xcd_barrier_post(unsigned* bar, volatile LAS unsigned* st) {
    XcdBarrier b; b.bar = bar; b.x = xb_xcc_id(); b.st = st;
    if (threadIdx.x == 0) (void)xb_add(&bar[XB_XCNT(b.x)], 1u);
    return b;
}
__device__ __forceinline__ void xcd_barrier_complete(unsigned* bar, unsigned x, unsigned& nloc, unsigned& nx) {
    const unsigned G = gridDim.x * gridDim.y * gridDim.z;
    unsigned sum, cnt, mine, sp = 0u;
    for (;;) {
        sum = 0u; cnt = 0u; mine = 0u;
#pragma unroll
        for (unsigned j = 0; j < 16; ++j) { const unsigned c = xb_ld(&bar[XB_XCNT(j)]); sum += c; cnt += (c > 0u) ? 1u : 0u; mine = (j == x) ? c : mine; }
        if (sum == G) break;
        __builtin_amdgcn_s_sleep(1);
        if ((++sp & 255u) == 0u) { if (xb_ld(&bar[XB_TMO])) break; if (sp > XB_SPIN_CAP) { atomicAdd(&bar[XB_TMO], 1u); break; } }
    }
    nloc = mine > 0u ? mine : 1u; nx = cnt > 0u ? cnt : 1u;
}

__device__ __forceinline__ void xcd_barrier(const XcdBarrier& b) {
    asm volatile("s_waitcnt vmcnt(0)" ::: "memory");
    __syncthreads();
    if (threadIdx.x == 0) {
        unsigned* bar = b.bar;
        __builtin_amdgcn_s_waitcnt(0);
        unsigned nloc = b.st[0], nx = b.st[1];
        if (nloc == 0u) { xcd_barrier_complete(bar, b.x, nloc, nx); b.st[0] = nloc; b.st[1] = nx; }
        const unsigned old = xb_add(&bar[XB_XSUB(b.x)], 1u);
        const unsigned gen = old / nloc;
        if (old + 1u == (gen + 1u) * nloc) {
            __builtin_amdgcn_fence(__ATOMIC_RELEASE, "agent");
            asm volatile("s_waitcnt vmcnt(0)" ::: "memory");
            const unsigned og = xb_add(&bar[XB_TOP], 1u);
            const unsigned tg = og / nx;
            if (og + 1u == (tg + 1u) * nx) xb_add(&bar[XB_TOPGEN], 1u);
            else XB_SPIN(xb_ld(&bar[XB_TOPGEN]) == tg, bar);
            __builtin_amdgcn_fence(__ATOMIC_ACQUIRE, "agent");
            xb_add(&bar[XB_XGEN(b.x)], 1u);
            asm volatile("s_waitcnt vmcnt(0)" ::: "memory");
        } else {
            XB_SPIN(xb_ld(&bar[XB_XGEN(b.x)]) == gen, bar);
            __builtin_amdgcn_fence(__ATOMIC_ACQUIRE, "agent");
            asm volatile("s_waitcnt vmcnt(0)" ::: "memory");
        }
    }
    __syncthreads();
}


__global__ void __launch_bounds__(256, 3) mega(Params p) {
    __shared__ __attribute__((aligned(16))) char smem[49152];
    __shared__ int s_item;
    __shared__ uint4 xb_words;
    cg::grid_group grid = cg::this_grid();
    if (threadIdx.x == 0) xb_words = make_uint4(0u, 0u, 0u, 0u);
    __syncthreads();
    XcdBarrier xb = xcd_barrier_post((unsigned*)(p.ws + O_CTL), (volatile LAS unsigned*)&xb_words);
    char* ws = p.ws;
    const int G = gridDim.x;
    const int pb = ((G & 7) == 0) ? ((int)(blockIdx.x & 7) * (G >> 3) + (int)(blockIdx.x >> 3)) : (int)blockIdx.x;
    float* xc = (float*)(ws + O_XC);
    bf16_t* hbuf = (bf16_t*)(ws + O_HBUF);

    phase_mod(p, smem);
    phase_wconv(p, 0, smem);
    grid.sync();
    for (int step = 0; step < 40; ++step) {
        const int l = step / 10, ph = step - l * 10;
        const float* modl = (const float*)(ws + O_MOD) + (size_t)l * 9 * 6144;
        const float* xl_src = (l == 0) ? p.in[I_X] : p.out;
        const float* xc_src = (l == 0) ? p.in[I_CTX] : xc;
        switch (ph) {
        case 0: {
            for (int rep = 0; rep < REP_EWA; ++rep) phase_norm(xl_src, xc_src, p.in[I_N1G] + l * 1024, modl, 0, 1, hbuf);
        } break;
        case 1: {
            {
                EpiIn e{(bf16_t*)(ws + O_NAQK), (bf16_t*)(ws + O_VTA), (bf16_t*)(ws + O_GQ), (bf16_t*)(ws + O_VTB), (bf16_t*)(ws + O_MLAR), (bf16_t*)(ws + O_RWR)};
                for (int rep = 0; rep < REP_GEMM; ++rep) for (int t = pb; t < 272 * 23; t += G) { int mt, nt; tile_mn(t, 23, mt, nt); gemm_tile(hbuf, LDH, (const bf16_t*)(ws + O_WIN), LDW1, 1024, mt * 128, nt * 128, smem, e); }
            }
        } break;
        case 2: {
            phase_post(p, l);
        } break;
        case 3: {
            {
                EpiUQ e1{(bf16_t*)(ws + O_QC), (const float*)(ws + O_RSM)};
                EpiUKV e2{(bf16_t*)(ws + O_KC), (bf16_t*)(ws + O_VTC), (const float*)(ws + O_RSM)};
                EpiAux e3{(bf16_t*)(ws + O_DEC), (bf16_t*)(ws + O_GATE), p.in[I_W0] + l * 512, p.in[I_A0] + l * 512};
                const bf16_t* mlar = (const bf16_t*)(ws + O_MLAR);
                for (int rep = 0; rep < REP_GEMM; ++rep) for (int t = pb; t < 272 * 17; t += G) {
                    const int mt = t / 17, j = t % 17;
                    if (j < 3) gemm_tile(mlar, 416, (const bf16_t*)(ws + O_WUQ), 256, 256, mt * 128, j * 128, smem, e1);
                    else if (j < 7) gemm_tile(mlar + 256, 416, (const bf16_t*)(ws + O_WUKV), 128, 128, mt * 128, (j - 3) * 128, smem, e2);
                    else {
                        const int n0 = (j - 7) * 128, blk = n0 >> 8;
                        if (blk < 4) {
                            gemm_tile(hbuf + blk * 64, 448, (const bf16_t*)(ws + O_WAUX) + (size_t)blk * 256 * 64 - (size_t)(blk * 256) * 64, 64, 64, mt * 128, n0, smem, e3);
                        } else {
                            gemm_tile(hbuf + 256, 448, (const bf16_t*)(ws + O_WG2) - (size_t)1024 * 192, 192, 192, mt * 128, n0, smem, e3);
                        }
                    }
                }
            }
        } break;
        case 4: {
            phase_mix(p, l, smem, &s_item);
        } break;
        case 5: {
            for (int rep = 0; rep < REP_EW; ++rep) phase_rwkv_fin(p, l);
        } break;
        case 6: {
            {
                EpiRes e{xl_src, xc_src, p.out, xc, modl + 2 * 1024};
                for (int t = pb; t < 272 * 8; t += G) { int mt, nt; tile_mn(t, 8, mt, nt); if (l == 3 && (mt % 34) < 2) continue;
                    gemm_tile(hbuf, LDH, (const bf16_t*)(ws + O_WOUT), LDW1, 1024, mt * 128, nt * 128, smem, e); }
            }
        } break;
        case 7: {
            for (int rep = 0; rep < REP_EW; ++rep) phase_norm(p.out, xc, p.in[I_N2G] + l * 1024, modl, 3, 4, hbuf);
        } break;
        case 8: {
            {
                EpiFc1 e{(bf16_t*)(ws + O_HID)};
                for (int rep = 0; rep < REP_GEMM; ++rep) for (int t = pb; t < 272 * 32; t += G) { int mt, nt; tile_mn(t, 32, mt, nt); if (l == 3 && (mt % 34) < 2) continue;
                    gemm_tile(hbuf, LDH, (const bf16_t*)(ws + O_WFC1), LDW1, 1024, mt * 128, nt * 128, smem, e); }
            }
        } break;
        case 9: {
            {
                EpiRes e{p.out, xc, p.out, xc, modl + 5 * 1024};
                for (int t = pb; t < 272 * 8; t += G) { int mt, nt; tile_mn(t, 8, mt, nt); if (l == 3 && (mt % 34) < 2) continue;
                    gemm_tile((const bf16_t*)(ws + O_HID), LDHID, (const bf16_t*)(ws + O_WFC2), LDW4, 4096, mt * 128, nt * 128, smem, e); }
            }
        } break;
        }
        for (int rep = 0; rep < REP_SYNC; ++rep) xcd_barrier(xb);
    }
    phase_final(p);
}

extern "C" void kernel_launch(void* const* d_in, const int* in_sizes, int n_in, void* d_out, int out_size, void* d_ws, size_t ws_size, hipStream_t stream) {
    static int grid_blocks = 0;
    if (n_in != 31 || ws_size < O_END) { fprintf(stderr, "kernel_launch: bad n_in %d or ws_size %zu < %zu\n", n_in, ws_size, (size_t)O_END); return; }
    if (!grid_blocks) {
        int dev = 0, cus = 0, per_cu = 0;
        hipGetDevice(&dev);
        hipDeviceGetAttribute(&cus, hipDeviceAttributeMultiprocessorCount, dev);
        hipOccupancyMaxActiveBlocksPerMultiprocessor(&per_cu, mega, 256, 0);
        if (per_cu > 3) per_cu = 3;
        if (per_cu < 1) per_cu = 1;
        grid_blocks = cus * per_cu;
    }
    Params p{};
    for (int i = 0; i < 31; ++i) p.in[i] = (const float*)d_in[i];
    p.out = (float*)d_out;
    p.ws = (char*)d_ws;
    (void)hipMemsetAsync(d_ws, 0, 16384, stream);
    void* args[] = {&p};
    hipError_t e = hipLaunchCooperativeKernel((void*)mega, dim3(grid_blocks), dim3(256), args, 0, stream);
    if (e != hipSuccess) fprintf(stderr, "cooperative launch failed: %s (grid %d)\n", hipGetErrorString(e), grid_blocks);
}
```
